# Optimizing an MI355X kernel written in HIP

```python
import math
import jax, jax.numpy as jnp
from jax import lax
import numpy as np

D_MODEL = 1024
BATCH = 8
SEQ = 4096
DEPTH = 2

PLE_DIM = 256
MIX_WIDTH = D_MODEL
HGRN_WIDTH = MIX_WIDTH // 2
HGRN_KEY_DIM = 128
HGRN_HEADS = HGRN_WIDTH // HGRN_KEY_DIM
HGRN_VAL_DIM = HGRN_WIDTH // HGRN_HEADS
HGRN_CHUNK = 64
DIFF_WIDTH = MIX_WIDTH - HGRN_WIDTH
DIFF_VAL_DIM = 128
DIFF_HEADS = DIFF_WIDTH // DIFF_VAL_DIM
DIFF_HEAD_DIM = DIFF_VAL_DIM // 2
Q_BLOCK = 128
IN_COLS = 4 * HGRN_WIDTH + 3 * DIFF_WIDTH
SPLITS = (HGRN_WIDTH, 2 * HGRN_WIDTH, 3 * HGRN_WIDTH, 4 * HGRN_WIDTH,
          4 * HGRN_WIDTH + DIFF_WIDTH, 4 * HGRN_WIDTH + 2 * DIFF_WIDTH)
N_EXPERTS = 16
N_GROUPS = 4
EXPERTS_PER_GROUP = N_EXPERTS // N_GROUPS
TOP_K = 2
D_FF_EXPERT = D_MODEL // 2
MOE_BLOCK = 128
EPS = 1e-6
MIN_FORGET = 1e-6
MASK_VALUE = -1e30

kernel_name = "hymba_hgrn2_diffattn_grouped_moe_ple"


def rms_norm(x, gain):
    xf = x.astype(jnp.float32)
    y = xf * lax.rsqrt(jnp.mean(xf * xf, axis=-1, keepdims=True) + EPS)
    return (y * gain.astype(jnp.float32)).astype(x.dtype)


def hgrn2_mixer(zq, zf, zi, zg, lb, out_gain):
    b, s, _ = zq.shape
    shp = (b, s, HGRN_HEADS, HGRN_KEY_DIM)
    q = jax.nn.silu(zq.astype(jnp.float32)).reshape(shp)
    f_logit = zf.astype(jnp.float32).reshape(shp)
    lb = lb.reshape(HGRN_HEADS, HGRN_KEY_DIM)
    forget = lb + (1.0 - lb) * jax.nn.sigmoid(f_logit)
    log_f = jnp.log(jnp.maximum(forget, MIN_FORGET))
    k = (1.0 - lb) * jax.nn.sigmoid(-f_logit)
    v = zi.astype(jnp.float32).reshape(b, s, HGRN_HEADS, HGRN_VAL_DIM)
    n_chunks = s // HGRN_CHUNK

    def to_chunks(t):
        return t.reshape(b, n_chunks, HGRN_CHUNK, HGRN_HEADS, t.shape[-1]).transpose(1, 0, 3, 2, 4)

    causal = jnp.tril(jnp.ones((HGRN_CHUNK, HGRN_CHUNK), dtype=bool))[:, :, None]

    def chunk_step(state, inp):
        qc, kc, vc, lfc = inp
        cum = jnp.cumsum(lfc, axis=2)
        o_inter = jnp.einsum("bhtd,bhdv->bhtv", qc * jnp.exp(cum), state)
        rel = jnp.where(causal, cum[:, :, :, None, :] - cum[:, :, None, :, :], MASK_VALUE)
        decay = jnp.where(causal, jnp.exp(rel), 0.0)
        scores = jnp.einsum("bhtd,bhsd,bhtsd->bhts", qc, kc, decay)
        o = o_inter + jnp.einsum("bhts,bhsv->bhtv", scores, vc)
        last = cum[:, :, -1:, :]
        state = (jnp.exp(last[:, :, 0, :])[..., None] * state
                 + jnp.einsum("bhsd,bhsv->bhdv", kc * jnp.exp(last - cum), vc))
        return state, o

    state0 = jnp.zeros((b, HGRN_HEADS, HGRN_KEY_DIM, HGRN_VAL_DIM), jnp.float32)
    _, o = lax.scan(chunk_step, state0,
                    (to_chunks(q), to_chunks(k), to_chunks(v), to_chunks(log_f)))
    o = o.transpose(1, 0, 3, 2, 4).reshape(b, s, HGRN_HEADS, HGRN_VAL_DIM)
    gate = jax.nn.silu(zg.astype(jnp.float32)).reshape(b, s, HGRN_HEADS, HGRN_VAL_DIM)
    o = rms_norm(o, out_gain) * gate
    return o.reshape(b, s, HGRN_WIDTH)


def diff_attention(zq, zk, zv, q_gain, k_gain, lam_q1, lam_k1, lam_q2, lam_k2, subln, lam_init):
    b, s, _ = zq.shape
    shp = (b, s, DIFF_HEADS, 2, DIFF_HEAD_DIM)
    q = rms_norm(zq.reshape(shp), q_gain).astype(jnp.float32) * (DIFF_HEAD_DIM ** -0.5)
    k = rms_norm(zk.reshape(shp), k_gain).astype(jnp.float32)
    v = zv.astype(jnp.float32).reshape(b, s, DIFF_HEADS, DIFF_VAL_DIM)
    lam = (jnp.exp(jnp.sum(lam_q1.astype(jnp.float32) * lam_k1.astype(jnp.float32)))
           - jnp.exp(jnp.sum(lam_q2.astype(jnp.float32) * lam_k2.astype(jnp.float32)))
           + lam_init)
    n_blocks = s // Q_BLOCK
    q_blocks = q.reshape(b, n_blocks, Q_BLOCK, DIFF_HEADS, 2, DIFF_HEAD_DIM).transpose(1, 0, 2, 3, 4, 5)
    key_pos = jnp.arange(s)

    def attend_block(args):
        qb, blk = args
        scores = jnp.einsum("bqhcd,bkhcd->bhcqk", qb, k)
        q_pos = blk * Q_BLOCK + jnp.arange(Q_BLOCK)
        mask = key_pos[None, :] <= q_pos[:, None]
        probs = jax.nn.softmax(jnp.where(mask, scores, MASK_VALUE), axis=-1)
        weights = probs[:, :, 0] - lam * probs[:, :, 1]
        return jnp.einsum("bhqk,bkhv->bqhv", weights, v)

    o = lax.map(attend_block, (q_blocks, jnp.arange(n_blocks)))
    o = o.transpose(1, 0, 2, 3, 4).reshape(b, s, DIFF_HEADS, DIFF_VAL_DIM)
    o = rms_norm(o, subln) * (1.0 - lam_init)
    return o.reshape(b, s, DIFF_WIDTH)


def grouped_moe(xn, w_router, w_gate, w_up, w_down):
    b, s, d = xn.shape
    t = b * s
    xt = xn.reshape(t, d)
    aff = jax.nn.softmax(xt.astype(jnp.float32) @ w_router.astype(jnp.float32), axis=-1)
    aff_g = aff.reshape(t, N_GROUPS, EXPERTS_PER_GROUP)
    group_score = lax.top_k(aff_g, TOP_K)[0].sum(-1)
    g_sel = jnp.argmax(group_score, axis=-1)
    in_group = jnp.take_along_axis(aff_g, g_sel[:, None, None], axis=1)[:, 0]
    top_w, top_local = lax.top_k(in_group, TOP_K)
    top_e = g_sel[:, None] * EXPERTS_PER_GROUP + top_local
    top_w = top_w / jnp.sum(top_w, axis=-1, keepdims=True)
    n_assign = t * TOP_K
    flat_e = top_e.reshape(n_assign)
    order = jnp.argsort(flat_e)
    sorted_e = flat_e[order]
    sorted_tok = (order // TOP_K).astype(jnp.int32)
    sorted_w = top_w.reshape(n_assign)[order]
    counts = jnp.bincount(flat_e, length=N_EXPERTS)
    starts = jnp.cumsum(counts) - counts
    padded = (counts + MOE_BLOCK - 1) // MOE_BLOCK * MOE_BLOCK
    padded_end = jnp.cumsum(padded)
    padded_start = padded_end - padded
    dest = padded_start[sorted_e] + jnp.arange(n_assign) - starts[sorted_e]
    n_rows = n_assign + N_EXPERTS * MOE_BLOCK
    n_blk = n_rows // MOE_BLOCK
    row_tok = jnp.full((n_rows,), t, jnp.int32).at[dest].set(sorted_tok)
    row_w = jnp.zeros((n_rows,), jnp.float32).at[dest].set(sorted_w)
    blk_e = jnp.minimum(jnp.searchsorted(padded_end, jnp.arange(n_blk) * MOE_BLOCK, side="right"),
                        N_EXPERTS - 1)
    x_rows = jnp.concatenate([xt, jnp.zeros((1, d), xt.dtype)], axis=0)[row_tok]
    x_rows = x_rows.reshape(n_blk, MOE_BLOCK, d)

    def expert_block(args):
        xb, e = args
        h = jax.nn.silu(xb @ w_gate[e]) * (xb @ w_up[e])
        return h @ w_down[e]

    y_rows = lax.map(expert_block, (x_rows, blk_e)).reshape(n_rows, d)
    y = jax.ops.segment_sum(y_rows * row_w[:, None].astype(y_rows.dtype), row_tok,
                            num_segments=t + 1)[:t]
    return y.reshape(b, s, d).astype(xn.dtype)


def setup_inputs(seed: int = 0) -> dict:
    key = jax.random.key(seed)
    ks = jax.random.split(key, 22)
    f32 = jnp.float32

    def nrm(k, shape, scale):
        return jax.random.normal(k, shape, f32) * scale

    def gain(k, shape):
        return 1.0 + 0.02 * jax.random.normal(k, shape, f32)

    res_scale = (2 * DEPTH) ** -0.5
    return {
        "x": nrm(ks[0], (BATCH, SEQ, D_MODEL), 1.0),
        "p": nrm(ks[1], (DEPTH, BATCH, SEQ, PLE_DIM), 1.0),
        "mix_norm": gain(ks[2], (DEPTH, D_MODEL)),
        "w_in": nrm(ks[3], (DEPTH, D_MODEL, IN_COLS), D_MODEL ** -0.5),
        "hgrn_lb": nrm(ks[4], (DEPTH, HGRN_WIDTH), 1.0),
        "hgrn_out_norm": gain(ks[5], (DEPTH, HGRN_VAL_DIM)),
        "q_norm": gain(ks[6], (DEPTH, DIFF_HEAD_DIM)),
        "k_norm": gain(ks[7], (DEPTH, DIFF_HEAD_DIM)),
        "lam_q1": nrm(ks[8], (DEPTH, DIFF_HEAD_DIM), 0.1),
        "lam_k1": nrm(ks[9], (DEPTH, DIFF_HEAD_DIM), 0.1),
        "lam_q2": nrm(ks[10], (DEPTH, DIFF_HEAD_DIM), 0.1),
        "lam_k2": nrm(ks[11], (DEPTH, DIFF_HEAD_DIM), 0.1),
        "diff_subln": gain(ks[12], (DEPTH, DIFF_VAL_DIM)),
        "w_out": nrm(ks[13], (DEPTH, MIX_WIDTH, D_MODEL), MIX_WIDTH ** -0.5 * res_scale),
        "ffn_norm": gain(ks[14], (DEPTH, D_MODEL)),
        "w_router": nrm(ks[15], (D_MODEL, N_EXPERTS), D_MODEL ** -0.5),
        "w_gate": nrm(ks[16], (DEPTH, N_EXPERTS, D_MODEL, D_FF_EXPERT), D_MODEL ** -0.5),
        "w_up": nrm(ks[17], (DEPTH, N_EXPERTS, D_MODEL, D_FF_EXPERT), D_MODEL ** -0.5),
        "w_down": nrm(ks[18], (DEPTH, N_EXPERTS, D_FF_EXPERT, D_MODEL), D_FF_EXPERT ** -0.5 * res_scale),
        "ple_proj": nrm(ks[19], (DEPTH, PLE_DIM, D_MODEL), PLE_DIM ** -0.5),
        "ple_norm": gain(ks[20], (DEPTH, D_MODEL)),
        "ple_gate": nrm(ks[21], (DEPTH, D_MODEL, D_MODEL), D_MODEL ** -0.5),
    }


def reference(x, p, mix_norm, w_in, hgrn_lb, hgrn_out_norm, q_norm, k_norm,
              lam_q1, lam_k1, lam_q2, lam_k2, diff_subln, w_out, ffn_norm, w_router,
              w_gate, w_up, w_down, ple_proj, ple_norm, ple_gate):
    lb_soft = jax.nn.softmax(hgrn_lb.astype(jnp.float32), axis=0)
    lower_bounds = jnp.cumsum(lb_soft, axis=0) - lb_soft[0]
    h = x
    for i in range(DEPTH):
        lam_init = 0.8 - 0.6 * math.exp(-0.3 * i)
        hn = rms_norm(h, mix_norm[i])
        z = hn @ w_in[i]
        zq, zf, zi, zg, dq, dk, dv = jnp.split(z, SPLITS, axis=-1)
        o_hgrn = hgrn2_mixer(zq, zf, zi, zg, lower_bounds[i], hgrn_out_norm[i])
        o_diff = diff_attention(dq, dk, dv, q_norm[i], k_norm[i], lam_q1[i], lam_k1[i],
                                lam_q2[i], lam_k2[i], diff_subln[i], lam_init)
        mix = jnp.concatenate([o_hgrn.astype(h.dtype), o_diff.astype(h.dtype)], axis=-1)
        h = h + mix @ w_out[i]
        h = h + grouped_moe(rms_norm(h, ffn_norm[i]), w_router, w_gate[i], w_up[i], w_down[i])
        ple = rms_norm(p[i] @ ple_proj[i], ple_norm[i])
        h = h + ple * jax.nn.sigmoid(h @ ple_gate[i])
    return h
```

```cpp
#include <hip/hip_runtime.h>
#include <cstdio>
#include <cstdint>
#include <cmath>

#include <hip/hip_runtime.h>
#include <cstdint>
namespace nv {
typedef unsigned short bf16s;
__device__ __forceinline__ float ldv(const float* p) { return *p; }
__device__ __forceinline__ float ldv(const bf16s* p) { return __uint_as_float(((unsigned)*p) << 16); }
__device__ __forceinline__ unsigned short f2bf_rne(float f) { unsigned u = __float_as_uint(f); return (unsigned short)((u + 0x7fffu + ((u >> 16) & 1u)) >> 16); }
__device__ __forceinline__ void stv(float* p, float v) { *p = v; }
__device__ __forceinline__ void stv(bf16s* p, float v) { *p = f2bf_rne(v); }
__device__ __forceinline__ float wsum(float v) {
#pragma unroll
    for (int o = 1; o < 64; o <<= 1) v += __shfl_xor(v, o);
    return v;
}
__device__ __forceinline__ float sigm(float x) { return 1.f / (1.f + __expf(-x)); }

constexpr int S_ = 4096, DM = 1024;
constexpr float EPSN = 1e-6f;

template <class TI, class TO>
__global__ void __launch_bounds__(256) k_rmsnorm(const TI* x, long ldx, const float* gain, TO* out, long ldo, long rows) {
    const int w = (blockIdx.x * 256 + threadIdx.x) >> 6, lane = threadIdx.x & 63;
    if (w >= rows) return;
    float v[16]; float s = 0.f;
#pragma unroll
    for (int i = 0; i < 16; ++i) { v[i] = ldv(x + (size_t)w * ldx + lane + 64 * i); s += v[i] * v[i]; }
    const float r = rsqrtf(wsum(s) * (1.f / 1024.f) + EPSN);
#pragma unroll
    for (int i = 0; i < 16; ++i) stv(out + (size_t)w * ldo + lane + 64 * i, v[i] * r * gain[lane + 64 * i]);
}
template <class TI, class TO>
__global__ void __launch_bounds__(256) k_copy(const TI* x, TO* out, size_t n) {
    for (size_t i = (size_t)blockIdx.x * 256 + threadIdx.x; i < n; i += (size_t)gridDim.x * 256) stv(out + i, ldv(x + i));
}

typedef float f32x16 __attribute__((ext_vector_type(16)));
struct GemmArgs {
    const void* A; long lda; const int* rowidx;
    const float* B; const float* B2; long ldb;
    const int* tile_e; size_t estride;
    long K;
};
template <class TA, bool DUAL, class Epi>
__global__ void __launch_bounds__(256) k_gemm(GemmArgs g, Epi epi) {
    __shared__ float As[16][130];
    __shared__ float Bs[16][132];
    __shared__ float Bs2[DUAL ? 16 : 1][132];
    const int tid = threadIdx.x, lane = tid & 63, w = tid >> 6, wm = w >> 1, wn = w & 1;
    const int m0 = blockIdx.y * 128, n0 = blockIdx.x * 128;
    const float* B = g.B; const float* B2 = g.B2;
    if (g.tile_e) { const int e = g.tile_e[blockIdx.y]; if (e < 0) return; B += (size_t)e * g.estride; if (DUAL) B2 += (size_t)e * g.estride; }
    const int arow = tid >> 1, akof = (tid & 1) * 8;
    long src = m0 + arow; if (g.rowidx) src = g.rowidx[m0 + arow];
    const TA* Ap = (const TA*)g.A + (src < 0 ? 0 : src) * (long)g.lda + akof;
    const int bk = tid >> 4, bn = (tid & 15) * 8;
    f32x16 acc[2][2], acc2[2][2];
#pragma unroll
    for (int i = 0; i < 2; ++i)
#pragma unroll
        for (int j = 0; j < 2; ++j) { acc[i][j] = f32x16{}; acc2[i][j] = f32x16{}; }
    for (int k0 = 0; k0 < g.K; k0 += 16) {
        float av[8];
#pragma unroll
        for (int j = 0; j < 8; ++j) av[j] = (src < 0) ? 0.f : ldv(Ap + k0 + j);
        float bv[8], bv2[8];
#pragma unroll
        for (int j = 0; j < 8; ++j) { bv[j] = B[(size_t)(k0 + bk) * g.ldb + n0 + bn + j]; if (DUAL) bv2[j] = B2[(size_t)(k0 + bk) * g.ldb + n0 + bn + j]; }
        __syncthreads();
#pragma unroll
        for (int j = 0; j < 8; ++j) As[akof + j][arow] = av[j];
#pragma unroll
        for (int j = 0; j < 8; ++j) { Bs[bk][bn + j] = bv[j]; if (DUAL) Bs2[bk][bn + j] = bv2[j]; }
        __syncthreads();
#pragma unroll
        for (int kk = 0; kk < 16; kk += 2) {
            const int kr = kk + (lane >> 5), c = lane & 31;
            float a[2], b[2], b2[2];
#pragma unroll
            for (int i = 0; i < 2; ++i) { a[i] = As[kr][wm * 64 + i * 32 + c]; b[i] = Bs[kr][wn * 64 + i * 32 + c]; if (DUAL) b2[i] = Bs2[kr][wn * 64 + i * 32 + c]; }
#pragma unroll
            for (int i = 0; i < 2; ++i)
#pragma unroll
                for (int j = 0; j < 2; ++j) {
                    acc[i][j] = __builtin_amdgcn_mfma_f32_32x32x2f32(a[i], b[j], acc[i][j], 0, 0, 0);
                    if (DUAL) acc2[i][j] = __builtin_amdgcn_mfma_f32_32x32x2f32(a[i], b2[j], acc2[i][j], 0, 0, 0);
                }
        }
    }
#pragma unroll
    for (int i = 0; i < 2; ++i)
#pragma unroll
        for (int j = 0; j < 2; ++j)
#pragma unroll
            for (int r = 0; r < 16; ++r) {
                const int row = m0 + wm * 64 + i * 32 + (r & 3) + 8 * (r >> 2) + 4 * (lane >> 5), col = n0 + wn * 64 + j * 32 + (lane & 31);
                epi(row, col, acc[i][j][r], DUAL ? acc2[i][j][r] : 0.f);
            }
}
template <class TO> struct EpiStore { TO* C; long ldc; __device__ void operator()(int r, int c, float v, float) const { stv(C + (size_t)r * ldc + c, v); } };
template <class TO> struct EpiSplit { TO* C; size_t stride; __device__ void operator()(int r, int c, float v, float) const { stv(C + (size_t)(c >> 9) * stride + (size_t)r * 512 + (c & 511), v); } };
struct EpiResAdd { float* H; long ld; __device__ void operator()(int r, int c, float v, float) const { H[(size_t)r * ld + c] += v; } };
template <class TO> struct EpiSiluMul { TO* C; long ldc; __device__ void operator()(int r, int c, float g, float u) const { stv(C + (size_t)r * ldc + c, g * sigm(g) * u); } };
struct EpiScatter { float* H; long ld; const int* row_tok; const float* row_w; __device__ void operator()(int r, int c, float v, float) const { const int t = row_tok[r]; if (t >= 0) atomicAdd(H + (size_t)t * ld + c, row_w[r] * v); } };
template <class TP> struct EpiPleGate { float* H; long ld; const TP* PN; __device__ void operator()(int r, int c, float v, float) const { H[(size_t)r * ld + c] += ldv(PN + (size_t)r * ld + c) * sigm(v); } };

template <class ST>
__global__ void __launch_bounds__(256) k_hgrn_rec(const ST* zq, const ST* zf, const ST* zi, const float* hgrn_lb, long layer, ST* o, long nb) {
    const int wv = (blockIdx.x * 256 + threadIdx.x) >> 6, lane = threadIdx.x & 63;
    if (wv >= nb * 512) return;
    const int b = wv >> 9, h = (wv >> 7) & 3, v = wv & 127;
    float lb[2];
#pragma unroll
    for (int j = 0; j < 2; ++j) { const int c = h * 128 + lane + 64 * j; const float a0 = hgrn_lb[c], a1 = hgrn_lb[512 + c]; const float mx = fmaxf(a0, a1); const float e0 = __expf(a0 - mx), e1 = __expf(a1 - mx);
        lb[j] = (layer == 0) ? 0.f : e1 / (e0 + e1); }
    float S0 = 0.f, S1 = 0.f;
    const size_t base = (size_t)b * S_ * 512 + h * 128;
#pragma unroll 4
    for (int t = 0; t < S_; ++t) {
        const size_t r = base + (size_t)t * 512;
        const float q0 = ldv(zq + r + lane), q1 = ldv(zq + r + lane + 64), f0 = ldv(zf + r + lane), f1 = ldv(zf + r + lane + 64), vv = ldv(zi + r + v);
        const float s0 = sigm(f0), s1 = sigm(f1);
        const float fe0 = fmaxf(lb[0] + (1.f - lb[0]) * s0, 1e-6f), fe1 = fmaxf(lb[1] + (1.f - lb[1]) * s1, 1e-6f);
        const float k0 = (1.f - lb[0]) * sigm(-f0), k1 = (1.f - lb[1]) * sigm(-f1);
        S0 = fe0 * S0 + k0 * vv; S1 = fe1 * S1 + k1 * vv;
        const float tot = wsum(q0 * sigm(q0) * S0 + q1 * sigm(q1) * S1);
        if (lane == 0) stv(o + r + v, tot);
    }
}
template <class ST>
__global__ void __launch_bounds__(256) k_hgrn_fin(const ST* o, const ST* zg, const float* out_gain, ST* mix, long ldm) {
    const int t = blockIdx.x, h = threadIdx.x >> 6, lane = threadIdx.x & 63;
    const size_t r = (size_t)t * 512 + h * 128;
    const float a = ldv(o + r + lane), b = ldv(o + r + lane + 64);
    const float rs = rsqrtf(wsum(a * a + b * b) * (1.f / 128.f) + EPSN);
    const float g0 = ldv(zg + r + lane), g1 = ldv(zg + r + lane + 64);
    stv(mix + (size_t)t * ldm + h * 128 + lane, a * rs * out_gain[lane] * (g0 * sigm(g0)));
    stv(mix + (size_t)t * ldm + h * 128 + lane + 64, b * rs * out_gain[lane + 64] * (g1 * sigm(g1)));
}

template <class ST, bool PRENORM>
__global__ void __launch_bounds__(256) k_attn(const ST* dq, const ST* dk, const ST* dv, const float* qg, const float* kg, ST* OA) {
    __shared__ float Ks[64][64];
    __shared__ float Vs[64][64];
    const int tid = threadIdx.x, qb = blockIdx.x, id = blockIdx.y, vh = id & 1, c = (id >> 1) & 1, h = (id >> 2) & 3, b = id >> 4;
    const int qpos = qb * 256 + tid;
    const size_t tq = (size_t)b * S_ + qpos;
    float q[64];
    {
        float ss = 0.f;
#pragma unroll
        for (int d = 0; d < 64; ++d) { q[d] = ldv(dq + tq * 512 + h * 128 + c * 64 + d); ss += q[d] * q[d]; }
        if (!PRENORM) { const float r = rsqrtf(ss * (1.f / 64.f) + EPSN) * 0.125f;
#pragma unroll
            for (int d = 0; d < 64; ++d) q[d] = q[d] * r * qg[d]; }
    }
    float acc[64];
#pragma unroll
    for (int e = 0; e < 64; ++e) acc[e] = 0.f;
    float m = -1e30f, l = 0.f;
    const int nkt = qb * 4 + 4;
    for (int kt = 0; kt < nkt; ++kt) {
        __syncthreads();
        {
            const int key = tid >> 2, part = (tid & 3) * 16; const size_t tk = (size_t)b * S_ + kt * 64 + key;
            float kv[16]; float ss = 0.f;
#pragma unroll
            for (int j = 0; j < 16; ++j) { kv[j] = ldv(dk + tk * 512 + h * 128 + c * 64 + part + j); ss += kv[j] * kv[j]; }
            ss += __shfl_xor(ss, 1); ss += __shfl_xor(ss, 2);
            const float r = PRENORM ? 1.f : rsqrtf(ss * (1.f / 64.f) + EPSN);
#pragma unroll
            for (int j = 0; j < 16; ++j) Ks[key][part + j] = PRENORM ? kv[j] : kv[j] * r * kg[part + j];
#pragma unroll
            for (int j = 0; j < 16; ++j) Vs[key][part + j] = ldv(dv + tk * 512 + h * 128 + vh * 64 + part + j);
        }
        __syncthreads();
        const int jmax = min(64, qpos - kt * 64 + 1);
        for (int j = 0; j < jmax; ++j) {
            float s = 0.f;
#pragma unroll
            for (int d = 0; d < 64; ++d) s += q[d] * Ks[j][d];
            const float mn = fmaxf(m, s), sc = __expf(m - mn), p = __expf(s - mn);
            l = l * sc + p; m = mn;
#pragma unroll
            for (int e = 0; e < 64; ++e) acc[e] = acc[e] * sc + p * Vs[j][e];
        }
    }
    const float il = 1.f / l;
#pragma unroll
    for (int e = 0; e < 64; ++e) stv(OA + tq * 1024 + c * 512 + h * 128 + vh * 64 + e, acc[e] * il);
}
__device__ __forceinline__ float lam_of(const float* q1, const float* k1, const float* q2, const float* k2, float lam_init, int lane) {
    const float a = wsum(q1[lane] * k1[lane]), b = wsum(q2[lane] * k2[lane]);
    return __expf(a) - __expf(b) + lam_init;
}
template <class ST>
__global__ void __launch_bounds__(256) k_diff_fin(const ST* OA, const float* q1, const float* k1, const float* q2, const float* k2, long layer, const float* subln, ST* mix, long ldm) {
    const float lam_init = 0.8f - 0.6f * __expf(-0.3f * (float)layer);
    const int t = blockIdx.x, h = threadIdx.x >> 6, lane = threadIdx.x & 63;
    const float lam = lam_of(q1, k1, q2, k2, lam_init, lane);
    const size_t r = (size_t)t * 1024 + h * 128;
    const float a = ldv(OA + r + lane) - lam * ldv(OA + r + 512 + lane), b = ldv(OA + r + lane + 64) - lam * ldv(OA + r + 512 + lane + 64);
    const float rs = rsqrtf(wsum(a * a + b * b) * (1.f / 128.f) + EPSN) * (1.f - lam_init);
    stv(mix + (size_t)t * ldm + 512 + h * 128 + lane, a * rs * subln[lane]);
    stv(mix + (size_t)t * ldm + 512 + h * 128 + lane + 64, b * rs * subln[lane + 64]);
}

template <class ST>
__global__ void __launch_bounds__(256) k_router(const ST* xn, const float* wr, int* tok_e, float* tok_w, long ntok) {
    const int t = (blockIdx.x * 256 + threadIdx.x) >> 6, lane = threadIdx.x & 63;
    if (t >= ntok) return;
    float acc[16];
#pragma unroll
    for (int e = 0; e < 16; ++e) acc[e] = 0.f;
    for (int i = 0; i < 16; ++i) { const int k = lane + 64 * i; const float x = ldv(xn + (size_t)t * 1024 + k);
#pragma unroll
        for (int e = 0; e < 16; ++e) acc[e] += x * wr[k * 16 + e]; }
#pragma unroll
    for (int e = 0; e < 16; ++e) acc[e] = wsum(acc[e]);
    float mx = acc[0];
#pragma unroll
    for (int e = 1; e < 16; ++e) mx = fmaxf(mx, acc[e]);
    float sum = 0.f;
#pragma unroll
    for (int e = 0; e < 16; ++e) { acc[e] = __expf(acc[e] - mx); sum += acc[e]; }
    const float inv = 1.f / sum;
#pragma unroll
    for (int e = 0; e < 16; ++e) acc[e] *= inv;
    float bestg = -1.f; int gs = 0, bi1 = 0, bi2 = 1; float bv1 = 0.f, bv2 = 0.f;
#pragma unroll
    for (int g = 0; g < 4; ++g) {
        int i1 = 0; float v1 = acc[4 * g];
#pragma unroll
        for (int j = 1; j < 4; ++j) if (acc[4 * g + j] > v1) { v1 = acc[4 * g + j]; i1 = j; }
        int i2 = -1; float v2 = -1.f;
#pragma unroll
        for (int j = 0; j < 4; ++j) if (j != i1 && acc[4 * g + j] > v2) { v2 = acc[4 * g + j]; i2 = j; }
        const float sc = v1 + v2;
        if (sc > bestg) { bestg = sc; gs = g; bi1 = i1; bi2 = i2; bv1 = v1; bv2 = v2; }
    }
    if (lane == 0) { tok_e[2 * t] = gs * 4 + bi1; tok_e[2 * t + 1] = gs * 4 + bi2; const float s = 1.f / (bv1 + bv2); tok_w[2 * t] = bv1 * s; tok_w[2 * t + 1] = bv2 * s; }
}
template <int PAD>
__global__ void __launch_bounds__(1024) k_sort(const int* tok_e, const float* tok_w, long ntok_, int* row_tok, float* row_w, int* tile_e, long nrows_) {
    __shared__ int cnt[16], pstart[17], cur[16];
    const int tid = threadIdx.x, ntok = (int)ntok_, nrows = (int)nrows_;
    if (tid < 16) { cnt[tid] = 0; cur[tid] = 0; }
    __syncthreads();
    for (int i = tid; i < 2 * ntok; i += 1024) atomicAdd(&cnt[tok_e[i]], 1);
    __syncthreads();
    if (tid == 0) { int s = 0; for (int e = 0; e < 16; ++e) { pstart[e] = s; s += (cnt[e] + PAD - 1) / PAD * PAD; } pstart[16] = s; }
    __syncthreads();
    for (int i = tid; i < nrows; i += 1024) { row_tok[i] = -1; row_w[i] = 0.f; }
    for (int i = tid; i < nrows / PAD; i += 1024) { int e = -1; for (int j = 0; j < 16; ++j) if (i * PAD >= pstart[j] && i * PAD < pstart[j + 1]) e = j; tile_e[i] = e; }
    __syncthreads();
    for (int i = tid; i < 2 * ntok; i += 1024) { const int e = tok_e[i]; const int pos = atomicAdd(&cur[e], 1); row_tok[pstart[e] + pos] = i >> 1; row_w[pstart[e] + pos] = tok_w[i]; }
}
}


extern "C" void kernel_launch(void* const* d_in, const int* in_sizes, int n_in, void* d_out, int out_size, void* d_ws, size_t ws_size, hipStream_t stream) {
    using namespace nv;
    const float* x = (const float*)d_in[0]; const float* p = (const float*)d_in[1]; const float* mix_norm = (const float*)d_in[2]; const float* w_in = (const float*)d_in[3];
    const float* hgrn_lb = (const float*)d_in[4]; const float* hgrn_on = (const float*)d_in[5]; const float* q_norm = (const float*)d_in[6]; const float* k_norm = (const float*)d_in[7];
    const float* lq1 = (const float*)d_in[8]; const float* lk1 = (const float*)d_in[9]; const float* lq2 = (const float*)d_in[10]; const float* lk2 = (const float*)d_in[11];
    const float* subln = (const float*)d_in[12]; const float* w_out = (const float*)d_in[13]; const float* ffn_norm = (const float*)d_in[14]; const float* w_router = (const float*)d_in[15];
    const float* w_gate = (const float*)d_in[16]; const float* w_up = (const float*)d_in[17]; const float* w_down = (const float*)d_in[18]; const float* ple_proj = (const float*)d_in[19];
    const float* ple_norm = (const float*)d_in[20]; const float* ple_gate = (const float*)d_in[21];
    float* out = (float*)d_out;
    constexpr int TB = 4096;
    constexpr int NR = 2 * TB + 16 * 128;
    float* ws = (float*)d_ws; size_t o = 0;
    auto take = [&](size_t n) { float* r = ws + o; o += (n + 63) / 64 * 64; return r; };
    float* XN = take((size_t)TB * 1024); float* Z = take((size_t)TB * 3584); float* OH = take((size_t)TB * 512); float* OA = take((size_t)TB * 1024);
    float* MIX = take((size_t)TB * 1024); float* H2 = take((size_t)TB * 1024); float* PN = take((size_t)TB * 1024); float* HM = take((size_t)NR * 512);
    int* tok_e = (int*)take(2 * TB); float* tok_w = take(2 * TB); int* row_tok = (int*)take(NR); float* row_w = take(NR); int* tile_e = (int*)take(NR / 128);
    const size_t ZS = (size_t)TB * 512;
    float *zq = Z, *zf = Z + ZS, *zi = Z + 2 * ZS, *zg = Z + 3 * ZS, *dq = Z + 4 * ZS, *dk = Z + 5 * ZS, *dv = Z + 6 * ZS;
    (void)hipMemcpyAsync(out, x, (size_t)8 * 4096 * 1024 * 4, hipMemcpyDeviceToDevice, stream);
    for (int b = 0; b < 8; ++b) {
        float* h = out + (size_t)b * TB * 1024;
        for (int i = 0; i < 2; ++i) {
            k_rmsnorm<float, float><<<TB / 4, 256, 0, stream>>>(h, 1024, mix_norm + i * 1024, XN, 1024, TB);
            { GemmArgs g{XN, 1024, nullptr, w_in + (size_t)i * 1024 * 3584, nullptr, 3584, nullptr, 0, 1024};
              k_gemm<float, false, EpiSplit<float>><<<dim3(28, TB / 128), 256, 0, stream>>>(g, EpiSplit<float>{Z, ZS}); }
            k_hgrn_rec<float><<<128, 256, 0, stream>>>(zq, zf, zi, hgrn_lb, i, OH, 1);
            k_hgrn_fin<float><<<TB, 256, 0, stream>>>(OH, zg, hgrn_on + i * 128, MIX, 1024);
            k_attn<float, false><<<dim3(16, 16), 256, 0, stream>>>(dq, dk, dv, q_norm + i * 64, k_norm + i * 64, OA);
            k_diff_fin<float><<<TB, 256, 0, stream>>>(OA, lq1 + i * 64, lk1 + i * 64, lq2 + i * 64, lk2 + i * 64, (long)i, subln + i * 128, MIX, 1024);
            { GemmArgs g{MIX, 1024, nullptr, w_out + (size_t)i * 1024 * 1024, nullptr, 1024, nullptr, 0, 1024};
              k_gemm<float, false, EpiResAdd><<<dim3(8, TB / 128), 256, 0, stream>>>(g, EpiResAdd{h, 1024}); }
            k_rmsnorm<float, float><<<TB / 4, 256, 0, stream>>>(h, 1024, ffn_norm + i * 1024, XN, 1024, TB);
            k_router<float><<<TB / 4, 256, 0, stream>>>(XN, w_router, tok_e, tok_w, TB);
            k_sort<128><<<1, 1024, 0, stream>>>(tok_e, tok_w, TB, row_tok, row_w, tile_e, NR);
            { GemmArgs g{XN, 1024, row_tok, w_gate + (size_t)i * 16 * 1024 * 512, w_up + (size_t)i * 16 * 1024 * 512, 512, tile_e, (size_t)1024 * 512, 1024};
              k_gemm<float, true, EpiSiluMul<float>><<<dim3(4, NR / 128), 256, 0, stream>>>(g, EpiSiluMul<float>{HM, 512}); }
            { GemmArgs g{HM, 512, nullptr, w_down + (size_t)i * 16 * 512 * 1024, nullptr, 1024, tile_e, (size_t)512 * 1024, 512};
              k_gemm<float, false, EpiScatter><<<dim3(8, NR / 128), 256, 0, stream>>>(g, EpiScatter{h, 1024, row_tok, row_w}); }
            { GemmArgs g{p + ((size_t)(i * 8 + b) * 4096) * 256, 256, nullptr, ple_proj + (size_t)i * 256 * 1024, nullptr, 1024, nullptr, 0, 256};
              k_gemm<float, false, EpiStore<float>><<<dim3(8, TB / 128), 256, 0, stream>>>(g, EpiStore<float>{OA, 1024}); }
            k_rmsnorm<float, float><<<TB / 4, 256, 0, stream>>>(OA, 1024, ple_norm + i * 1024, PN, 1024, TB);
            k_copy<float, float><<<2048, 256, 0, stream>>>(h, H2, (size_t)TB * 1024);
            { GemmArgs g{H2, 1024, nullptr, ple_gate + (size_t)i * 1024 * 1024, nullptr, 1024, nullptr, 0, 1024};
              k_gemm<float, false, EpiPleGate<float>><<<dim3(8, TB / 128), 256, 0, stream>>>(g, EpiPleGate<float>{h, 1024, PN}); }
        }
    }
}
```

```cpp
#include <hip/hip_runtime.h>
#include <hip/hip_bf16.h>
#include <cstdio>
#include <cstdint>
#include <cmath>

#include <hip/hip_runtime.h>
#include <cstdint>
#ifndef SEQ_TEST
#define SEQ_TEST 0
#endif
namespace nv {
typedef unsigned short bf16s;
__device__ __forceinline__ float ldv(const float* p) { return *p; }
__device__ __forceinline__ float ldv(const bf16s* p) { return __uint_as_float(((unsigned)*p) << 16); }
__device__ __forceinline__ unsigned short f2bf_rne(float f) { unsigned u = __float_as_uint(f); return (unsigned short)((u + 0x7fffu + ((u >> 16) & 1u)) >> 16); }
__device__ __forceinline__ void stv(float* p, float v) { *p = v; }
__device__ __forceinline__ void stv(bf16s* p, float v) { *p = f2bf_rne(v); }
__device__ __forceinline__ float wsum(float v) {
#pragma unroll
    for (int o = 1; o < 64; o <<= 1) v += __shfl_xor(v, o);
    return v;
}
__device__ __forceinline__ float sigm(float x) { return 1.f / (1.f + __expf(-x)); }

constexpr int S_ = 4096, DM = 1024;
constexpr float EPSN = 1e-6f;

template <class TI, class TO>
__global__ void __launch_bounds__(256) k_rmsnorm(const TI* x, long ldx, const float* gain, TO* out, long ldo, long rows) {
    const int w = (blockIdx.x * 256 + threadIdx.x) >> 6, lane = threadIdx.x & 63;
    if (w >= rows) return;
    float v[16]; float s = 0.f;
#pragma unroll
    for (int i = 0; i < 16; ++i) { v[i] = ldv(x + (size_t)w * ldx + lane + 64 * i); s += v[i] * v[i]; }
    const float r = rsqrtf(wsum(s) * (1.f / 1024.f) + EPSN);
#pragma unroll
    for (int i = 0; i < 16; ++i) stv(out + (size_t)w * ldo + lane + 64 * i, v[i] * r * gain[lane + 64 * i]);
}
template <class TI, class TO>
__global__ void __launch_bounds__(256) k_copy(const TI* x, TO* out, size_t n) {
    for (size_t i = (size_t)blockIdx.x * 256 + threadIdx.x; i < n; i += (size_t)gridDim.x * 256) stv(out + i, ldv(x + i));
}

typedef float f32x16 __attribute__((ext_vector_type(16)));
struct GemmArgs {
    const void* A; long lda; const int* rowidx;
    const float* B; const float* B2; long ldb;
    const int* tile_e; size_t estride;
    long K;
};
template <class TA, bool DUAL, class Epi>
__global__ void __launch_bounds__(256) k_gemm(GemmArgs g, Epi epi) {
    __shared__ float As[16][130];
    __shared__ float Bs[16][132];
    __shared__ float Bs2[DUAL ? 16 : 1][132];
    const int tid = threadIdx.x, lane = tid & 63, w = tid >> 6, wm = w >> 1, wn = w & 1;
    const int m0 = blockIdx.y * 128, n0 = blockIdx.x * 128;
    const float* B = g.B; const float* B2 = g.B2;
    if (g.tile_e) { const int e = g.tile_e[blockIdx.y]; if (e < 0) return; B += (size_t)e * g.estride; if (DUAL) B2 += (size_t)e * g.estride; }
    const int arow = tid >> 1, akof = (tid & 1) * 8;
    long src = m0 + arow; if (g.rowidx) src = g.rowidx[m0 + arow];
    const TA* Ap = (const TA*)g.A + (src < 0 ? 0 : src) * (long)g.lda + akof;
    const int bk = tid >> 4, bn = (tid & 15) * 8;
    f32x16 acc[2][2], acc2[2][2];
#pragma unroll
    for (int i = 0; i < 2; ++i)
#pragma unroll
        for (int j = 0; j < 2; ++j) { acc[i][j] = f32x16{}; acc2[i][j] = f32x16{}; }
    for (int k0 = 0; k0 < g.K; k0 += 16) {
        float av[8];
#pragma unroll
        for (int j = 0; j < 8; ++j) av[j] = (src < 0) ? 0.f : ldv(Ap + k0 + j);
        float bv[8], bv2[8];
#pragma unroll
        for (int j = 0; j < 8; ++j) { bv[j] = B[(size_t)(k0 + bk) * g.ldb + n0 + bn + j]; if (DUAL) bv2[j] = B2[(size_t)(k0 + bk) * g.ldb + n0 + bn + j]; }
        __syncthreads();
#pragma unroll
        for (int j = 0; j < 8; ++j) As[akof + j][arow] = av[j];
#pragma unroll
        for (int j = 0; j < 8; ++j) { Bs[bk][bn + j] = bv[j]; if (DUAL) Bs2[bk][bn + j] = bv2[j]; }
        __syncthreads();
#pragma unroll
        for (int kk = 0; kk < 16; kk += 2) {
            const int kr = kk + (lane >> 5), c = lane & 31;
            float a[2], b[2], b2[2];
#pragma unroll
            for (int i = 0; i < 2; ++i) { a[i] = As[kr][wm * 64 + i * 32 + c]; b[i] = Bs[kr][wn * 64 + i * 32 + c]; if (DUAL) b2[i] = Bs2[kr][wn * 64 + i * 32 + c]; }
#pragma unroll
            for (int i = 0; i < 2; ++i)
#pragma unroll
                for (int j = 0; j < 2; ++j) {
                    acc[i][j] = __builtin_amdgcn_mfma_f32_32x32x2f32(a[i], b[j], acc[i][j], 0, 0, 0);
                    if (DUAL) acc2[i][j] = __builtin_amdgcn_mfma_f32_32x32x2f32(a[i], b2[j], acc2[i][j], 0, 0, 0);
                }
        }
    }
#pragma unroll
    for (int i = 0; i < 2; ++i)
#pragma unroll
        for (int j = 0; j < 2; ++j)
#pragma unroll
            for (int r = 0; r < 16; ++r) {
                const int row = m0 + wm * 64 + i * 32 + (r & 3) + 8 * (r >> 2) + 4 * (lane >> 5), col = n0 + wn * 64 + j * 32 + (lane & 31);
                epi(row, col, acc[i][j][r], DUAL ? acc2[i][j][r] : 0.f);
            }
}
template <class TO> struct EpiStore { TO* C; long ldc; __device__ void operator()(int r, int c, float v, float) const { stv(C + (size_t)r * ldc + c, v); } };
template <class TO> struct EpiSplit { TO* C; size_t stride; __device__ void operator()(int r, int c, float v, float) const { stv(C + (size_t)(c >> 9) * stride + (size_t)r * 512 + (c & 511), v); } };
struct EpiResAdd { float* H; long ld; __device__ void operator()(int r, int c, float v, float) const { H[(size_t)r * ld + c] += v; } };
template <class TO> struct EpiSiluMul { TO* C; long ldc; __device__ void operator()(int r, int c, float g, float u) const { stv(C + (size_t)r * ldc + c, g * sigm(g) * u); } };
struct EpiScatter { float* H; long ld; const int* row_tok; const float* row_w; __device__ void operator()(int r, int c, float v, float) const { const int t = row_tok[r]; if (t >= 0) atomicAdd(H + (size_t)t * ld + c, row_w[r] * v); } };
template <class TP> struct EpiPleGate { float* H; long ld; const TP* PN; __device__ void operator()(int r, int c, float v, float) const { H[(size_t)r * ld + c] += ldv(PN + (size_t)r * ld + c) * sigm(v); } };

template <class ST>
__global__ void __launch_bounds__(256) k_hgrn_rec(const ST* zq, const ST* zf, const ST* zi, const float* hgrn_lb, long layer, ST* o, long nb) {
    const int wv = (blockIdx.x * 256 + threadIdx.x) >> 6, lane = threadIdx.x & 63;
    if (wv >= nb * 512) return;
    const int b = wv >> 9, h = (wv >> 7) & 3, v = wv & 127;
    float lb[2];
#pragma unroll
    for (int j = 0; j < 2; ++j) { const int c = h * 128 + lane + 64 * j; const float a0 = hgrn_lb[c], a1 = hgrn_lb[512 + c]; const float mx = fmaxf(a0, a1); const float e0 = __expf(a0 - mx), e1 = __expf(a1 - mx);
        lb[j] = (layer == 0) ? 0.f : e1 / (e0 + e1); }
    float S0 = 0.f, S1 = 0.f;
    const size_t base = (size_t)b * S_ * 512 + h * 128;
#pragma unroll 4
    for (int t = 0; t < S_; ++t) {
        const size_t r = base + (size_t)t * 512;
        const float q0 = ldv(zq + r + lane), q1 = ldv(zq + r + lane + 64), f0 = ldv(zf + r + lane), f1 = ldv(zf + r + lane + 64), vv = ldv(zi + r + v);
        const float s0 = sigm(f0), s1 = sigm(f1);
        const float fe0 = fmaxf(lb[0] + (1.f - lb[0]) * s0, 1e-6f), fe1 = fmaxf(lb[1] + (1.f - lb[1]) * s1, 1e-6f);
        const float k0 = (1.f - lb[0]) * sigm(-f0), k1 = (1.f - lb[1]) * sigm(-f1);
        S0 = fe0 * S0 + k0 * vv; S1 = fe1 * S1 + k1 * vv;
        const float tot = wsum(q0 * sigm(q0) * S0 + q1 * sigm(q1) * S1);
        if (lane == 0) stv(o + r + v, tot);
    }
}
template <class ST>
__global__ void __launch_bounds__(256) k_hgrn_fin(const ST* o, const ST* zg, const float* out_gain, ST* mix, long ldm) {
    const int t = blockIdx.x, h = threadIdx.x >> 6, lane = threadIdx.x & 63;
    const size_t r = (size_t)t * 512 + h * 128;
    const float a = ldv(o + r + lane), b = ldv(o + r + lane + 64);
    const float rs = rsqrtf(wsum(a * a + b * b) * (1.f / 128.f) + EPSN);
    const float g0 = ldv(zg + r + lane), g1 = ldv(zg + r + lane + 64);
    stv(mix + (size_t)t * ldm + h * 128 + lane, a * rs * out_gain[lane] * (g0 * sigm(g0)));
    stv(mix + (size_t)t * ldm + h * 128 + lane + 64, b * rs * out_gain[lane + 64] * (g1 * sigm(g1)));
}

template <class ST, bool PRENORM>
__global__ void __launch_bounds__(256) k_attn(const ST* dq, const ST* dk, const ST* dv, const float* qg, const float* kg, ST* OA) {
    __shared__ float Ks[64][64];
    __shared__ float Vs[64][64];
    const int tid = threadIdx.x, qb = blockIdx.x, id = blockIdx.y, vh = id & 1, c = (id >> 1) & 1, h = (id >> 2) & 3, b = id >> 4;
    const int qpos = qb * 256 + tid;
    const size_t tq = (size_t)b * S_ + qpos;
    float q[64];
    {
        float ss = 0.f;
#pragma unroll
        for (int d = 0; d < 64; ++d) { q[d] = ldv(dq + tq * 512 + h * 128 + c * 64 + d); ss += q[d] * q[d]; }
        if (!PRENORM) { const float r = rsqrtf(ss * (1.f / 64.f) + EPSN) * 0.125f;
#pragma unroll
            for (int d = 0; d < 64; ++d) q[d] = q[d] * r * qg[d]; }
    }
    float acc[64];
#pragma unroll
    for (int e = 0; e < 64; ++e) acc[e] = 0.f;
    float m = -1e30f, l = 0.f;
    const int nkt = qb * 4 + 4;
    for (int kt = 0; kt < nkt; ++kt) {
        __syncthreads();
        {
            const int key = tid >> 2, part = (tid & 3) * 16; const size_t tk = (size_t)b * S_ + kt * 64 + key;
            float kv[16]; float ss = 0.f;
#pragma unroll
            for (int j = 0; j < 16; ++j) { kv[j] = ldv(dk + tk * 512 + h * 128 + c * 64 + part + j); ss += kv[j] * kv[j]; }
            ss += __shfl_xor(ss, 1); ss += __shfl_xor(ss, 2);
            const float r = PRENORM ? 1.f : rsqrtf(ss * (1.f / 64.f) + EPSN);
#pragma unroll
            for (int j = 0; j < 16; ++j) Ks[key][part + j] = PRENORM ? kv[j] : kv[j] * r * kg[part + j];
#pragma unroll
            for (int j = 0; j < 16; ++j) Vs[key][part + j] = ldv(dv + tk * 512 + h * 128 + vh * 64 + part + j);
        }
        __syncthreads();
        const int jmax = min(64, qpos - kt * 64 + 1);
        for (int j = 0; j < jmax; ++j) {
            float s = 0.f;
#pragma unroll
            for (int d = 0; d < 64; ++d) s += q[d] * Ks[j][d];
            const float mn = fmaxf(m, s), sc = __expf(m - mn), p = __expf(s - mn);
            l = l * sc + p; m = mn;
#pragma unroll
            for (int e = 0; e < 64; ++e) acc[e] = acc[e] * sc + p * Vs[j][e];
        }
    }
    const float il = 1.f / l;
#pragma unroll
    for (int e = 0; e < 64; ++e) stv(OA + tq * 1024 + c * 512 + h * 128 + vh * 64 + e, acc[e] * il);
}
__device__ __forceinline__ float lam_of(const float* q1, const float* k1, const float* q2, const float* k2, float lam_init, int lane) {
    const float a = wsum(q1[lane] * k1[lane]), b = wsum(q2[lane] * k2[lane]);
    return __expf(a) - __expf(b) + lam_init;
}
template <class ST>
__global__ void __launch_bounds__(256) k_diff_fin(const ST* OA, const float* q1, const float* k1, const float* q2, const float* k2, long layer, const float* subln, ST* mix, long ldm) {
    const float lam_init = 0.8f - 0.6f * __expf(-0.3f * (float)layer);
    const int t = blockIdx.x, h = threadIdx.x >> 6, lane = threadIdx.x & 63;
    const float lam = lam_of(q1, k1, q2, k2, lam_init, lane);
    const size_t r = (size_t)t * 1024 + h * 128;
    const float a = ldv(OA + r + lane) - lam * ldv(OA + r + 512 + lane), b = ldv(OA + r + lane + 64) - lam * ldv(OA + r + 512 + lane + 64);
    const float rs = rsqrtf(wsum(a * a + b * b) * (1.f / 128.f) + EPSN) * (1.f - lam_init);
    stv(mix + (size_t)t * ldm + 512 + h * 128 + lane, a * rs * subln[lane]);
    stv(mix + (size_t)t * ldm + 512 + h * 128 + lane + 64, b * rs * subln[lane + 64]);
}

__global__ void __launch_bounds__(256) k_router(const float* hin, const float* gain, const float* wr, int* tok_e, float* tok_w, long ntok) {
    const int t = (blockIdx.x * 256 + threadIdx.x) >> 6, lane = threadIdx.x & 63;
    if (t >= ntok) return;
    float acc[16];
#pragma unroll
    for (int e = 0; e < 16; ++e) acc[e] = 0.f;
    float xv[16]; float ss = 0.f;
#pragma unroll
    for (int i = 0; i < 16; ++i) { xv[i] = hin[(size_t)t * 1024 + lane + 64 * i]; ss += xv[i] * xv[i]; }
    const float rr = rsqrtf(wsum(ss) * (1.f / 1024.f) + EPSN);
    for (int i = 0; i < 16; ++i) { const int k = lane + 64 * i; const float x = xv[i] * rr * gain[k];
#pragma unroll
        for (int e = 0; e < 16; ++e) acc[e] += x * wr[k * 16 + e]; }
#pragma unroll
    for (int e = 0; e < 16; ++e) acc[e] = wsum(acc[e]);
    float mx = acc[0];
#pragma unroll
    for (int e = 1; e < 16; ++e) mx = fmaxf(mx, acc[e]);
    float sum = 0.f;
#pragma unroll
    for (int e = 0; e < 16; ++e) { acc[e] = __expf(acc[e] - mx); sum += acc[e]; }
    const float inv = 1.f / sum;
#pragma unroll
    for (int e = 0; e < 16; ++e) acc[e] *= inv;
    float bestg = -1.f; int gs = 0, bi1 = 0, bi2 = 1; float bv1 = 0.f, bv2 = 0.f;
#pragma unroll
    for (int g = 0; g < 4; ++g) {
        int i1 = 0; float v1 = acc[4 * g];
#pragma unroll
        for (int j = 1; j < 4; ++j) if (acc[4 * g + j] > v1) { v1 = acc[4 * g + j]; i1 = j; }
        int i2 = -1; float v2 = -1.f;
#pragma unroll
        for (int j = 0; j < 4; ++j) if (j != i1 && acc[4 * g + j] > v2) { v2 = acc[4 * g + j]; i2 = j; }
        const float sc = v1 + v2;
        if (sc > bestg) { bestg = sc; gs = g; bi1 = i1; bi2 = i2; bv1 = v1; bv2 = v2; }
    }
    if (lane == 0) { tok_e[2 * t] = gs * 4 + bi1; tok_e[2 * t + 1] = gs * 4 + bi2; const float s = 1.f / (bv1 + bv2); tok_w[2 * t] = bv1 * s; tok_w[2 * t + 1] = bv2 * s; }
}
template <int PAD>
__global__ void __launch_bounds__(1024) k_sort(const int* tok_e, const float* tok_w, long ntok_, int* row_tok, float* row_w, int* tile_e, long nrows_) {
    __shared__ int cnt[16], pstart[17], cur[16];
    const int tid = threadIdx.x, ntok = (int)ntok_, nrows = (int)nrows_;
    if (tid < 16) { cnt[tid] = 0; cur[tid] = 0; }
    __syncthreads();
    for (int i = tid; i < 2 * ntok; i += 1024) atomicAdd(&cnt[tok_e[i]], 1);
    __syncthreads();
    if (tid == 0) { int s = 0; for (int e = 0; e < 16; ++e) { pstart[e] = s; s += (cnt[e] + PAD - 1) / PAD * PAD; } pstart[16] = s; }
    __syncthreads();
    for (int i = tid; i < nrows; i += 1024) { row_tok[i] = -1; row_w[i] = 0.f; }
    for (int i = tid; i < nrows / PAD; i += 1024) { int e = -1; for (int j = 0; j < 16; ++j) if (i * PAD >= pstart[j] && i * PAD < pstart[j + 1]) e = j; tile_e[i] = e; }
    __syncthreads();
    for (int i = tid; i < 2 * ntok; i += 1024) { const int e = tok_e[i]; const int pos = atomicAdd(&cur[e], 1); row_tok[pstart[e] + pos] = i >> 1; row_w[pstart[e] + pos] = tok_w[i]; }
}

__global__ void __launch_bounds__(256) k_hgrn_seq_naive(const bf16s* QE, bf16s* O, const bf16s* Lst, const float* dvec) {
    const int wv = (blockIdx.x * 256 + threadIdx.x) >> 6, lane = threadIdx.x & 63;
    const int b = wv >> 9, h = (wv >> 7) & 3, v = wv & 127, vs = v >> 4, v16 = v & 15;
    float S0 = 0.f, S1 = 0.f;
    for (int c = 0; c < 64; ++c) {
        const size_t bhc = ((size_t)b * 4 + h) * 64 + c;
        for (int t = 0; t < 64; ++t) {
            const size_t r = ((size_t)b * S_ + c * 64 + t) * 512 + h * 128;
#if SEQ_TEST == 1
            const float tot = wsum(S0 + S1);
#else
            const float tot = wsum(ldv(QE + r + lane) * S0 + ldv(QE + r + lane + 64) * S1);
#endif
            if (lane == 0) stv(O + r + v, tot + ldv(O + r + v));
        }
        const int d0 = lane, d1 = lane + 64;
        const bf16s* Lb = Lst + (bhc * 8 + vs) * 2048;
        const float L0 = ldv(Lb + ((((d0 & 15) >> 2) * 16 + v16) * 32 + (d0 >> 4) * 4 + (d0 & 3))), L1 = ldv(Lb + ((((d1 & 15) >> 2) * 16 + v16) * 32 + (d1 >> 4) * 4 + (d1 & 3)));
#if SEQ_TEST == 2
        S0 = 0.01f; S1 = 0.01f; (void)L0; (void)L1;
#elif SEQ_TEST == 3
        S0 = 0.5f * S0 + L0; S1 = 0.5f * S1 + L1;
#elif SEQ_TEST == 4
        S0 = dvec[bhc * 128 + d0] * S0 + 0.01f; S1 = dvec[bhc * 128 + d1] * S1 + 0.01f; (void)L0; (void)L1;
#else
        S0 = dvec[bhc * 128 + d0] * S0 + L0; S1 = dvec[bhc * 128 + d1] * S1 + L1;
#endif
    }
}
}


constexpr size_t MiB_ = 1u << 20;
constexpr size_t WS_CTL = 0, CTL_ZERO_BYTES = 1 * MiB_;
constexpr size_t WS_WIN = 1 * MiB_;
constexpr size_t WS_WOUT = 15 * MiB_;
constexpr size_t WS_WGU = 19 * MiB_;
constexpr size_t WS_WDN = 83 * MiB_;
constexpr size_t WS_WPP = 115 * MiB_;
constexpr size_t WS_WPG = 116 * MiB_;
constexpr size_t WS_Z = 120 * MiB_;
constexpr size_t ZSLOT = 32 * MiB_;
constexpr size_t WS_XN = 344 * MiB_;
constexpr size_t WS_OA = 408 * MiB_;
constexpr size_t WS_MISC = 472 * MiB_;
constexpr size_t WS_END = 512 * MiB_;


#ifndef NAIVE_SKIP
#define NAIVE_SKIP 0
#endif
namespace hy {
using namespace nv;
struct In {
    const float *x, *p, *mix_norm, *w_in, *hgrn_lb, *hgrn_on, *q_norm, *k_norm, *lq1, *lk1, *lq2, *lk2, *subln, *w_out, *ffn_norm, *w_router, *w_gate, *w_up, *w_down, *ple_proj, *ple_norm, *ple_gate;
};
enum { ST_XN = 0, ST_INPROJ = 1, ST_MIXERS = 2, ST_WOUT = 3, ST_MOE = 4, ST_PLE = 5, ST_END = 6 };
static void run_naive(const In& I, float* out, unsigned char* ws, hipStream_t stream, int cut_layer, int cut_stage) {
    constexpr int T = 32768;
    constexpr int NR = 2 * T + 16 * 128;
    bf16s* zq = (bf16s*)(ws + WS_Z); const size_t ZS = (size_t)T * 512;
    bf16s *zf = zq + ZS, *zi = zq + 2 * ZS, *zg = zq + 3 * ZS, *dq = zq + 4 * ZS, *dk = zq + 5 * ZS, *dv = zq + 6 * ZS;
    bf16s* XN = (bf16s*)(ws + WS_XN); bf16s* OA = (bf16s*)(ws + WS_OA); bf16s* MIX = dq; bf16s* HM = zq; bf16s* PN = dq; bf16s* H2 = XN;
    int* tok_e = (int*)(ws + WS_MISC); float* tok_w = (float*)(ws + WS_MISC + (1 << 20)); int* row_tok = (int*)(ws + WS_MISC + (2 << 20)); float* row_w = (float*)(ws + WS_MISC + (3 << 20)); int* tile_e = (int*)(ws + WS_MISC + (4 << 20));
    for (int i = cut_layer; i < 2; ++i) {
        const int s0 = (i == cut_layer) ? cut_stage : 0;
        const float* hbase = (i == 0) ? I.x : out;
        if (s0 <= ST_XN) k_rmsnorm<float, bf16s><<<T / 4, 256, 0, stream>>>(hbase, 1024, I.mix_norm + i * 1024, XN, 1024, T);
        if (s0 <= ST_INPROJ) { GemmArgs g{XN, 1024, nullptr, I.w_in + (size_t)i * 1024 * 3584, nullptr, 3584, nullptr, 0, 1024};
            k_gemm<bf16s, false, EpiSplit<bf16s>><<<dim3(28, T / 128), 256, 0, stream>>>(g, EpiSplit<bf16s>{zq, ZS}); }
        if (s0 <= ST_MIXERS) {
            if (i == cut_layer && (NAIVE_SKIP & 4)) k_hgrn_seq_naive<<<8 * 512 / 4, 256, 0, stream>>>(zq, zi, (const bf16s*)(ws + WS_XN), (const float*)(ws + WS_MISC + (4 << 20)));
            if (!(i == cut_layer && (NAIVE_SKIP & 1))) k_hgrn_rec<bf16s><<<8 * 512 / 4, 256, 0, stream>>>(zq, zf, zi, I.hgrn_lb, i, zi, 8);
            if (!(i == cut_layer && (NAIVE_SKIP & 2))) k_attn<bf16s, false><<<dim3(16, 8 * 16), 256, 0, stream>>>(dq, dk, dv, I.q_norm + i * 64, I.k_norm + i * 64, OA);
            k_hgrn_fin<bf16s><<<T, 256, 0, stream>>>(zi, zg, I.hgrn_on + i * 128, MIX, 1024);
            k_diff_fin<bf16s><<<T, 256, 0, stream>>>(OA, I.lq1 + i * 64, I.lk1 + i * 64, I.lq2 + i * 64, I.lk2 + i * 64, (long)i, I.subln + i * 128, MIX, 1024);
        }
        if (s0 <= ST_WOUT) {
            if (i == 0) (void)hipMemcpyAsync(out, I.x, (size_t)T * 1024 * 4, hipMemcpyDeviceToDevice, stream);
            GemmArgs g{MIX, 1024, nullptr, I.w_out + (size_t)i * 1024 * 1024, nullptr, 1024, nullptr, 0, 1024};
            k_gemm<bf16s, false, EpiResAdd><<<dim3(8, T / 128), 256, 0, stream>>>(g, EpiResAdd{out, 1024});
        }
        if (s0 <= ST_MOE) {
            k_rmsnorm<float, bf16s><<<T / 4, 256, 0, stream>>>(out, 1024, I.ffn_norm + i * 1024, XN, 1024, T);
            k_router<<<T / 4, 256, 0, stream>>>(out, I.ffn_norm + i * 1024, I.w_router, tok_e, tok_w, T);
            k_sort<128><<<1, 1024, 0, stream>>>(tok_e, tok_w, T, row_tok, row_w, tile_e, NR);
            { GemmArgs g{XN, 1024, row_tok, I.w_gate + (size_t)i * 16 * 1024 * 512, I.w_up + (size_t)i * 16 * 1024 * 512, 512, tile_e, (size_t)1024 * 512, 1024};
              k_gemm<bf16s, true, EpiSiluMul<bf16s>><<<dim3(4, NR / 128), 256, 0, stream>>>(g, EpiSiluMul<bf16s>{HM, 512}); }
            { GemmArgs g{HM, 512, nullptr, I.w_down + (size_t)i * 16 * 512 * 1024, nullptr, 1024, tile_e, (size_t)512 * 1024, 512};
              k_gemm<bf16s, false, EpiScatter><<<dim3(8, NR / 128), 256, 0, stream>>>(g, EpiScatter{out, 1024, row_tok, row_w}); }
        }
        if (s0 <= ST_PLE) {
            { GemmArgs g{I.p + (size_t)i * T * 256, 256, nullptr, I.ple_proj + (size_t)i * 256 * 1024, nullptr, 1024, nullptr, 0, 256};
              k_gemm<float, false, EpiStore<bf16s>><<<dim3(8, T / 128), 256, 0, stream>>>(g, EpiStore<bf16s>{OA, 1024}); }
            k_rmsnorm<bf16s, bf16s><<<T / 4, 256, 0, stream>>>(OA, 1024, I.ple_norm + i * 1024, PN, 1024, T);
            k_copy<float, bf16s><<<4096, 256, 0, stream>>>(out, H2, (size_t)T * 1024);
            { GemmArgs g{H2, 1024, nullptr, I.ple_gate + (size_t)i * 1024 * 1024, nullptr, 1024, nullptr, 0, 1024};
              k_gemm<bf16s, false, EpiPleGate<bf16s>><<<dim3(8, T / 128), 256, 0, stream>>>(g, EpiPleGate<bf16s>{out, 1024, PN}); }
        }
    }
}
}


__device__ __forceinline__ int opaque_tid() { int t = threadIdx.x; asm volatile("" : "+v"(t)); return t; }
namespace pg8 {
#define PG8_LAS __attribute__((address_space(3)))
typedef unsigned short bf16_t;
typedef short bf16x8 __attribute__((ext_vector_type(8)));
typedef float f32x4 __attribute__((ext_vector_type(4)));
typedef float f32x2 __attribute__((ext_vector_type(2)));
typedef unsigned u32x4 __attribute__((ext_vector_type(4)));
typedef unsigned u32x2 __attribute__((ext_vector_type(2)));
constexpr int BM = 256, BK = 64, HALF = 128, HTB = HALF * BK * 2  , STAGE_BYTES = 8 * HTB, NXCD = 8, WGM = 8;

__host__ __device__ __forceinline__ int lds_byte(int r, int c) { const int st = (r >> 4) * 2 + (c >> 5), rr = r & 15, cc = c & 31, ob = rr * 64 + cc * 2; return st * 1024 + (ob ^ (((ob >> 9) & 1) << 5)); }
__host__ __device__ __forceinline__ void stage_rc(int b, int& R, int& C) { const int st = b / 1024, sb = b % 1024, swz = sb ^ (((sb >> 9) & 1) << 5); R = (st >> 1) * 16 + swz / 64; C = (st & 1) * 32 + (swz % 64) / 2; }
__host__ __device__ __forceinline__ int perm32(int rho) { const int n = rho >> 4, i = rho & 15; return 8 * (i >> 2) + 4 * n + (i & 3); }

struct Unit { int pm, pn, e; };
struct Gemm { const bf16_t* A; const bf16_t* Bt; int K; size_t estride; };

struct StaticOrder {
    int nM, nN, nwg, G, c;
    __device__ void init(int M, int N, int G_, int c_) { nM = M / BM; nN = N / BM; nwg = nM * nN; G = G_; c = c_; }
    __device__ bool next(int i, Unit& u) const {
        const long L = (long)i * G + c; if (L >= nwg) return false;
        int wgid = (int)L; { const int q = nwg / NXCD, r = nwg % NXCD, xcd = wgid % NXCD, off = wgid / NXCD; wgid = (xcd < r ? xcd * (q + 1) : r * (q + 1) + (xcd - r) * q) + off; }
        const int nig = WGM * nN, gid = wgid / nig, fm = gid * WGM, gsz = (nM - fm) < WGM ? (nM - fm) : WGM;
        u.pm = fm + ((wgid % nig) % gsz); u.pn = (wgid % nig) / gsz; u.e = 0; return true;
    }
};
struct RowIdent { __device__ __forceinline__ unsigned operator()(const Unit& u, int r) const { return (unsigned)(u.pm * BM + r); } };

typedef __bf16 bf16x2_t __attribute__((ext_vector_type(2)));
__device__ __forceinline__ unsigned cvt_pk_bf16(float lo, float hi) { f32x2 v = {lo, hi}; bf16x2_t b = __builtin_convertvector(v, bf16x2_t); return __builtin_bit_cast(unsigned, b); }
__device__ __forceinline__ float bf_lo(unsigned w) { return __uint_as_float(w << 16); }
__device__ __forceinline__ float bf_hi(unsigned w) { return __uint_as_float(w & 0xffff0000u); }
__device__ __forceinline__ float fsigm(float x) { return __builtin_amdgcn_rcpf(1.f + __builtin_amdgcn_exp2f(-1.4426950408889634f * x)); }

struct EpiBf16 {
    static constexpr bool PERM = true;
    bf16_t* O; int ldc; int split_cols; size_t split_stride;
    __device__ __forceinline__ void operator()(const f32x4 (&acc)[2][2][4][2], const Unit& u, int wr, int wc, int fr, int fq) const {
        const int row0 = u.pm * BM + wr * 64 + fr; int colt = u.pn * BM; bf16_t* base = O;
        if (split_cols) { const int t = colt / split_cols; base += (size_t)t * split_stride; colt -= t * split_cols; }
        const int col0 = colt + wc * 32 + 8 * fq;
#pragma unroll
        for (int ai = 0; ai < 2; ++ai)
#pragma unroll
            for (int m = 0; m < 4; ++m) { bf16_t* rowp = base + (size_t)(row0 + ai * HALF + m * 16) * ldc + col0;
#pragma unroll
                for (int bj = 0; bj < 2; ++bj) { const f32x4 v0 = acc[ai][bj][m][0], v1 = acc[ai][bj][m][1];
                    u32x4 w; w.x = cvt_pk_bf16(v0[0], v0[1]); w.y = cvt_pk_bf16(v0[2], v0[3]); w.z = cvt_pk_bf16(v1[0], v1[1]); w.w = cvt_pk_bf16(v1[2], v1[3]);
                    *(u32x4*)(rowp + bj * HALF) = w; } }
    }
};
struct EpiBf16RowSS {
    static constexpr bool PERM = true;
    bf16_t* O; int ldc; float* rowss;
    __device__ __forceinline__ void operator()(const f32x4 (&acc)[2][2][4][2], const Unit& u, int wr, int wc, int fr, int fq) const {
        const int row0 = u.pm * BM + wr * 64 + fr; const int col0 = u.pn * BM + wc * 32 + 8 * fq;
#pragma unroll
        for (int ai = 0; ai < 2; ++ai)
#pragma unroll
            for (int m = 0; m < 4; ++m) { const int row = row0 + ai * HALF + m * 16; bf16_t* rowp = O + (size_t)row * ldc + col0; float ss = 0.f;
#pragma unroll
                for (int bj = 0; bj < 2; ++bj) { const f32x4 v0 = acc[ai][bj][m][0], v1 = acc[ai][bj][m][1];
                    ss += (v0[0] * v0[0] + v0[1] * v0[1]) + (v0[2] * v0[2] + v0[3] * v0[3]) + (v1[0] * v1[0] + v1[1] * v1[1]) + (v1[2] * v1[2] + v1[3] * v1[3]);
                    u32x4 w; w.x = cvt_pk_bf16(v0[0], v0[1]); w.y = cvt_pk_bf16(v0[2], v0[3]); w.z = cvt_pk_bf16(v1[0], v1[1]); w.w = cvt_pk_bf16(v1[2], v1[3]);
                    *(u32x4*)(rowp + bj * HALF) = w; }
                ss += __shfl_xor(ss, 16); ss += __shfl_xor(ss, 32);
                if (fq == 0) atomicAdd(rowss + row, ss); }
    }
};
struct EpiSiluMul {
    static constexpr bool PERM = true;
    bf16_t* O;
    __device__ __forceinline__ void operator()(const f32x4 (&acc)[2][2][4][2], const Unit& u, int wr, int wc, int fr, int fq) const {
        const int row0 = u.pm * BM + wr * 64 + fr; const int col0 = u.pn * HALF + wc * 32 + 8 * fq;
#pragma unroll
        for (int ai = 0; ai < 2; ++ai)
#pragma unroll
            for (int m = 0; m < 4; ++m) { bf16_t* rowp = O + (size_t)(row0 + ai * HALF + m * 16) * 512 + col0; float h[8];
#pragma unroll
                for (int n = 0; n < 2; ++n)
#pragma unroll
                    for (int i = 0; i < 4; ++i) { const float g = acc[ai][0][m][n][i], up = acc[ai][1][m][n][i]; h[n * 4 + i] = g * fsigm(g) * up; }
                u32x4 w; w.x = cvt_pk_bf16(h[0], h[1]); w.y = cvt_pk_bf16(h[2], h[3]); w.z = cvt_pk_bf16(h[4], h[5]); w.w = cvt_pk_bf16(h[6], h[7]);
                *(u32x4*)rowp = w; }
    }
};
struct EpiResF32 {
    static constexpr bool PERM = false;
    const float* base; float* out;
    __device__ __forceinline__ void operator()(const f32x4 (&acc)[2][2][4][2], const Unit& u, int wr, int wc, int fr, int fq) const {
        const int col0 = u.pn * BM + wc * 32 + 4 * fq;
#pragma unroll
        for (int ai = 0; ai < 2; ++ai)
#pragma unroll
            for (int m = 0; m < 4; ++m) { const size_t off = (size_t)(u.pm * BM + ai * HALF + wr * 64 + m * 16 + fr) * 1024 + col0;
#pragma unroll
                for (int bj = 0; bj < 2; ++bj)
#pragma unroll
                    for (int n = 0; n < 2; ++n) { const f32x4 bs = *(const f32x4*)(base + off + bj * HALF + n * 16); *(f32x4*)(out + off + bj * HALF + n * 16) = bs + acc[ai][bj][m][n]; }
                if (m & 1) asm volatile("" ::: "memory"); }
    }
};
struct EpiScatter {
    static constexpr bool PERM = false;
    float* H; const int* row_tok; const float* row_w;
    __device__ __forceinline__ void operator()(const f32x4 (&acc)[2][2][4][2], const Unit& u, int wr, int wc, int fr, int fq) const {
        const int col0 = u.pn * BM + wc * 32 + 4 * fq;
#pragma unroll
        for (int ai = 0; ai < 2; ++ai)
#pragma unroll
            for (int m = 0; m < 4; ++m) { const int sr = u.pm * BM + ai * HALF + wr * 64 + m * 16 + fr; const int tok = row_tok[sr]; const float w = row_w[sr];
                if (tok >= 0) { float* hp = H + (size_t)tok * 1024 + col0;
#pragma unroll
                    for (int bj = 0; bj < 2; ++bj)
#pragma unroll
                        for (int n = 0; n < 2; ++n)
#pragma unroll
                            for (int i = 0; i < 4; ++i) __hip_atomic_fetch_add(hp + bj * HALF + n * 16 + i, w * acc[ai][bj][m][n][i], __ATOMIC_RELAXED, __HIP_MEMORY_SCOPE_AGENT); } }
    }
};
struct EpiPleGate {
    static constexpr bool PERM = false;
    float* H; const bf16_t* P; const float* rowss; const float* gain;
    __device__ __forceinline__ void operator()(const f32x4 (&acc)[2][2][4][2], const Unit& u, int wr, int wc, int fr, int fq) const {
        const int col0 = u.pn * BM + wc * 32 + 4 * fq;
#pragma unroll
        for (int ai = 0; ai < 2; ++ai)
#pragma unroll
            for (int m = 0; m < 4; ++m) { const int row = u.pm * BM + ai * HALF + wr * 64 + m * 16 + fr; const size_t off = (size_t)row * 1024 + col0;
                const float rstd = rsqrtf(rowss[row] * (1.f / 1024.f) + 1e-6f);
#pragma unroll
                for (int bj = 0; bj < 2; ++bj)
#pragma unroll
                    for (int n = 0; n < 2; ++n) { const int co = bj * HALF + n * 16; const f32x4 hv = *(const f32x4*)(H + off + co); const u32x2 pw = *(const u32x2*)(P + off + co); const f32x4 gv = *(const f32x4*)(gain + col0 + co);
                        const f32x4 a = acc[ai][bj][m][n]; f32x4 o;
                        o[0] = hv[0] + bf_lo(pw.x) * rstd * gv[0] * fsigm(a[0]); o[1] = hv[1] + bf_hi(pw.x) * rstd * gv[1] * fsigm(a[1]);
                        o[2] = hv[2] + bf_lo(pw.y) * rstd * gv[2] * fsigm(a[2]); o[3] = hv[3] + bf_hi(pw.y) * rstd * gv[3] * fsigm(a[3]);
                        *(f32x4*)(H + off + co) = o; }
                if (m & 1) asm volatile("" ::: "memory"); }
    }
};

template <class Epi, class Sched, class RowMap, bool ALIGN_EPI>
__device__ __forceinline__ void gemm_phase(PG8_LAS unsigned char* lds, const Gemm g, const Sched& S, const Epi& E, const RowMap& RM) {
    const int tid = opaque_tid(), wid = __builtin_amdgcn_readfirstlane(tid >> 6), lane = tid & 63, wr = wid >> 2, wc = wid & 3, fr = lane & 15, fq = lane >> 4;
    const int K = g.K, nt = K / BK;
    int Ra[2], Ca[2]; unsigned voffB[2];
#pragma unroll
    for (int i = 0; i < 2; ++i) { int R, C; stage_rc(tid * 16 + i * 8192, R, C); const int Rb = Epi::PERM ? ((R & ~31) + perm32(R & 31)) : R; Ra[i] = R; Ca[i] = C; voffB[i] = (unsigned)(Rb * K + C) * 2u; }
    const size_t kstep = (size_t)(BK * 2);
    const size_t hstep = (size_t)HALF * K * 2;
    const size_t tstep = 2 * hstep;
    const unsigned ldsw = (unsigned)wid * 1024u;
    const int aoff = lds_byte(wr * 64 + fr, fq * 8), boff = lds_byte(wc * 32 + fr, fq * 8);
#define PG8_SA(b, h) (((b) * 2 + (h)) * HTB)
#define PG8_SB(b, h) ((4 + (b) * 2 + (h)) * HTB)
#define PG8_STAGE(bufoff, gbase, voff) do { _Pragma("unroll") for (int _i = 0; _i < 2; ++_i) \
        __builtin_amdgcn_global_load_lds((const unsigned*)((const char*)(gbase) + (voff)[_i]), (PG8_LAS unsigned*)(lds + (bufoff) + ldsw + _i * 8192), 16, 0, 0); } while (0)
#define PG8_MKOFF(dst, U) do { _Pragma("unroll") for (int _h = 0; _h < 2; ++_h) _Pragma("unroll") for (int _i = 0; _i < 2; ++_i) dst[_h][_i] = (RM(U, _h * HALF + Ra[_i]) * (unsigned)K + (unsigned)Ca[_i]) * 2u; } while (0)
#define PG8_LDA(dst, b, h) do { _Pragma("unroll") for (int m = 0; m < 4; ++m) _Pragma("unroll") for (int k = 0; k < 2; ++k) dst[m][k] = *(const PG8_LAS bf16x8*)(lds + PG8_SA(b, h) + aoff + m * 2048 + k * 1024); } while (0)
#define PG8_LDB(dst, b, h) do { _Pragma("unroll") for (int n = 0; n < 2; ++n) _Pragma("unroll") for (int k = 0; k < 2; ++k) dst[n][k] = *(const PG8_LAS bf16x8*)(lds + PG8_SB(b, h) + boff + n * 2048 + k * 1024); } while (0)
#define PG8_MMA(ai, bj, At, Bt) do { __builtin_amdgcn_s_setprio(1); _Pragma("unroll") for (int m = 0; m < 4; ++m) _Pragma("unroll") for (int n = 0; n < 2; ++n) _Pragma("unroll") for (int k = 0; k < 2; ++k) \
        acc[ai][bj][m][n] = __builtin_amdgcn_mfma_f32_16x16x32_bf16(Bt[n][k], At[m][k], acc[ai][bj][m][n], 0, 0, 0); __builtin_amdgcn_s_setprio(0); } while (0)
#define PG8_WAIT_V(n) asm volatile("s_waitcnt vmcnt(" #n ")" ::: "memory")
#define PG8_WAIT_L(n) asm volatile("s_waitcnt lgkmcnt(" #n ")" ::: "memory")
#define PG8_BAR __builtin_amdgcn_s_barrier()
#define PG8_SCHED __builtin_amdgcn_sched_barrier(0)
    Unit cur, nxt; int ui = 0;
    if (!S.next(0, cur)) return;
    f32x4 acc[2][2][4][2];
#pragma unroll
    for (int a = 0; a < 2; ++a)
#pragma unroll
        for (int b = 0; b < 2; ++b)
#pragma unroll
            for (int m = 0; m < 4; ++m)
#pragma unroll
                for (int n = 0; n < 2; ++n) acc[a][b][m][n] = (f32x4){0.f, 0.f, 0.f, 0.f};
    bf16x8 At[4][2], B0[2][2], B1[2][2];
    unsigned ao[2][2], no[2][2];
    PG8_MKOFF(ao, cur);
    const char* const gA = (const char*)g.A;
    const char* cB = (const char*)g.Bt + (size_t)cur.e * g.estride + (size_t)cur.pn * tstep;
    PG8_STAGE(PG8_SB(0, 0), cB, voffB); PG8_STAGE(PG8_SB(0, 1), cB + hstep, voffB); PG8_STAGE(PG8_SA(0, 0), gA, ao[0]); PG8_STAGE(PG8_SA(0, 1), gA, ao[1]);
    if (wr == 1) PG8_BAR;
    PG8_WAIT_V(2); PG8_BAR;
    PG8_STAGE(PG8_SB(1, 0), cB + kstep, voffB); PG8_STAGE(PG8_SA(1, 0), gA + kstep, ao[0]); PG8_STAGE(PG8_SB(1, 1), cB + hstep + kstep, voffB);
    PG8_WAIT_V(6); PG8_BAR;
    for (;;) {
        const bool has_next = S.next(ui + 1, nxt);
        if (has_next) { PG8_MKOFF(no, nxt); } else {
#pragma unroll
            for (int h = 0; h < 2; ++h)
#pragma unroll
                for (int i = 0; i < 2; ++i) no[h][i] = ao[h][i]; }
        const char* nB = has_next ? (const char*)g.Bt + (size_t)nxt.e * g.estride + (size_t)nxt.pn * tstep : cB;
        for (int t = 0; t < nt; t += 2) {
            const bool last = (t == nt - 2);
            const char* a1 = gA + (size_t)(t + 1) * kstep;
            const char* a2 = last ? gA : gA + (size_t)(t + 2) * kstep; const char* b2 = last ? nB : cB + (size_t)(t + 2) * kstep;
            const char* a3 = a2 + kstep; const char* b3 = b2 + kstep;
            PG8_LDB(B0, 0, 0); PG8_LDB(B1, 0, 1); PG8_SCHED; PG8_LDA(At, 0, 0); PG8_STAGE(PG8_SA(1, 1), a1, ao[1]);
            if (last) { _Pragma("unroll") for (int h = 0; h < 2; ++h) _Pragma("unroll") for (int i = 0; i < 2; ++i) ao[h][i] = no[h][i]; }
            PG8_WAIT_V(8); PG8_WAIT_L(0); PG8_BAR; PG8_MMA(0, 0, At, B0); PG8_MMA(0, 1, At, B1); PG8_BAR; PG8_SCHED;
            PG8_LDA(At, 0, 1); PG8_STAGE(PG8_SB(0, 0), b2, voffB); PG8_STAGE(PG8_SB(0, 1), b2 + hstep, voffB); PG8_STAGE(PG8_SA(0, 0), a2, ao[0]);
            PG8_WAIT_V(8); PG8_WAIT_L(0); PG8_BAR; PG8_MMA(1, 0, At, B0); PG8_MMA(1, 1, At, B1); PG8_BAR; PG8_SCHED;
            PG8_LDB(B0, 1, 0); PG8_LDB(B1, 1, 1); PG8_SCHED; PG8_LDA(At, 1, 0); PG8_STAGE(PG8_SA(0, 1), a2, ao[1]);
            PG8_WAIT_V(8); PG8_WAIT_L(0); PG8_BAR; PG8_MMA(0, 0, At, B0); PG8_MMA(0, 1, At, B1); PG8_BAR; PG8_SCHED;
            PG8_LDA(At, 1, 1); PG8_STAGE(PG8_SB(1, 0), b3, voffB); PG8_STAGE(PG8_SB(1, 1), b3 + hstep, voffB); PG8_STAGE(PG8_SA(1, 0), a3, ao[0]);
            PG8_WAIT_V(8); PG8_WAIT_L(0); PG8_BAR; PG8_MMA(1, 0, At, B0); PG8_MMA(1, 1, At, B1); PG8_BAR; PG8_SCHED;
        }
        if constexpr (ALIGN_EPI) { if (wr == 0) PG8_BAR; }
        E(acc, cur, wr, wc, fr, fq);
        if (!has_next) break;
#pragma unroll
        for (int a = 0; a < 2; ++a)
#pragma unroll
            for (int b = 0; b < 2; ++b)
#pragma unroll
                for (int m = 0; m < 4; ++m)
#pragma unroll
                    for (int n = 0; n < 2; ++n) acc[a][b][m][n] = (f32x4){0.f, 0.f, 0.f, 0.f};
        cur = nxt; cB = nB; ++ui;
        if constexpr (ALIGN_EPI) { if (wr == 1) PG8_BAR; }
    }
    PG8_WAIT_V(0);
    if constexpr (!ALIGN_EPI) { if (wr == 0) PG8_BAR; }
    PG8_BAR;
#undef PG8_SA
#undef PG8_SB
#undef PG8_STAGE
#undef PG8_MKOFF
#undef PG8_LDA
#undef PG8_LDB
#undef PG8_MMA
#undef PG8_WAIT_V
#undef PG8_WAIT_L
#undef PG8_BAR
#undef PG8_SCHED
}
}


#include <hip/hip_bf16.h>
#include <cmath>
namespace attn_body {
using bf16=__hip_bfloat16;
using bf16x8=__attribute__((ext_vector_type(8)))short;
using s16x4=__attribute__((ext_vector_type(4)))short;
using f32x16=__attribute__((ext_vector_type(16)))float;
using u32x4=__attribute__((ext_vector_type(4)))unsigned;
constexpr int BATCH=8,SEQ=4096,D=64;
constexpr int PQ=512,PK=512,PV=512,PO=1024;
constexpr int NW=8,QBLK=32,QB=QBLK*NW,KVBLK=64,NQB=SEQ/QB;
constexpr int ATTN_UNIT_ROWS=QB;
__device__ __forceinline__ int crow(int r,int hi){return (r&3)+8*(r>>2)+4*hi;}
#define SBAR() __builtin_amdgcn_sched_barrier(0)
__device__ __forceinline__ void cmask(f32x16&p0,f32x16&p1,int jb,int qrel,int hi){
  const float NEG=-INFINITY; int kb=64*jb+4*hi;
  #pragma unroll
  for(int r=0;r<16;++r){int kv=kb+(r&3)+8*(r>>2); if(kv>qrel)p0[r]=NEG; if(kv+32>qrel)p1[r]=NEG;}
}

constexpr int NSLOT=3, SLOTB=8192;
constexpr int LDS_K=0, LDS_V=NSLOT*SLOTB, LDS_WS=2*NSLOT*SLOTB, LDS_OST=LDS_WS+NW*64*4, LDS_BYTES=LDS_OST+NW*4096;
constexpr float C2=0.125f*1.4426950408889634f;
__device__ __forceinline__ void glds16(const void*gsrc,unsigned lds_dst){unsigned keep;
  asm volatile("s_mov_b32 %0, m0\n\ts_mov_b32 m0, %2\n\ts_nop 0\n\tglobal_load_lds_dwordx4 %1, off\n\ts_mov_b32 m0, %0":"=&s"(keep):"v"(gsrc),"s"(lds_dst):"memory");}
__device__ __forceinline__ float max3f(float a,float b,float c){float r;asm("v_max3_f32 %0, %1, %2, %3":"=v"(r):"v"(a),"v"(b),"v"(c));return r;}
__device__ __forceinline__ float max2f(float a,float b){float r;asm("v_max_f32_e32 %0, %1, %2":"=v"(r):"v"(a),"v"(b));return r;}
__device__ __forceinline__ float fadd_s(float a,float b){float r;asm("v_add_f32_e32 %0, %1, %2":"=v"(r):"v"(a),"v"(b));return r;}
__device__ __forceinline__ float fsub_s(float a,float b){float r;asm("v_sub_f32_e32 %0, %1, %2":"=v"(r):"v"(a),"v"(b));return r;}
typedef float f32x2_t __attribute__((ext_vector_type(2))); typedef __bf16 bf16x2_t __attribute__((ext_vector_type(2)));
__device__ __forceinline__ unsigned cvtpk_s(float lo,float hi){f32x2_t v={lo,hi};bf16x2_t b=__builtin_convertvector(v,bf16x2_t);return __builtin_bit_cast(unsigned,b);}
#define WAIT_BAR(N) asm volatile("s_waitcnt vmcnt(" #N ") lgkmcnt(0)\n\ts_barrier":::"memory")

__device__ __forceinline__ void qkt(f32x16&p0,f32x16&p1,const char*Kslot,const bf16x8*qr,const f32x16&negm,int r32,int hi){
  const char*kb=Kslot+hi*1024+r32*16;
  #pragma unroll
  for(int d0=0;d0<4;++d0){
    const bf16x8 b0=*reinterpret_cast<const bf16x8*>(kb+d0*2048);
    const bf16x8 b1=*reinterpret_cast<const bf16x8*>(kb+d0*2048+512);
    if(d0==0){p0=__builtin_amdgcn_mfma_f32_32x32x16_bf16(b0,qr[0],negm,0,0,0);p1=__builtin_amdgcn_mfma_f32_32x32x16_bf16(b1,qr[0],negm,0,0,0);}
    else{p0=__builtin_amdgcn_mfma_f32_32x32x16_bf16(b0,qr[d0],p0,0,0,0);p1=__builtin_amdgcn_mfma_f32_32x32x16_bf16(b1,qr[d0],p1,0,0,0);}}
}
typedef __attribute__((address_space(3))) const char* lds_cptr;
typedef short v4i16_t __attribute__((ext_vector_type(4)));
__device__ __forceinline__ void kload8(bf16x8*kf,lds_cptr kp){
  kf[0]=*(const __attribute__((address_space(3))) bf16x8*)(kp);      kf[1]=*(const __attribute__((address_space(3))) bf16x8*)(kp+512);
  kf[2]=*(const __attribute__((address_space(3))) bf16x8*)(kp+2048); kf[3]=*(const __attribute__((address_space(3))) bf16x8*)(kp+2560);
  kf[4]=*(const __attribute__((address_space(3))) bf16x8*)(kp+4096); kf[5]=*(const __attribute__((address_space(3))) bf16x8*)(kp+4608);
  kf[6]=*(const __attribute__((address_space(3))) bf16x8*)(kp+6144); kf[7]=*(const __attribute__((address_space(3))) bf16x8*)(kp+6656);
}
__device__ __forceinline__ void kload2(bf16x8*kf,lds_cptr kp,int j){ kf[2*j]=*(const __attribute__((address_space(3))) bf16x8*)(kp+j*2048); kf[2*j+1]=*(const __attribute__((address_space(3))) bf16x8*)(kp+j*2048+512); }
__device__ __forceinline__ s16x4 vtr(lds_cptr p){ return __builtin_bit_cast(s16x4,__builtin_amdgcn_ds_read_tr16_b64_v4i16((__attribute__((address_space(3))) v4i16_t*)p)); }
__device__ __forceinline__ float rowmax(const f32x16&p0,const f32x16&p1){
  float a=max3f(p0[0],p0[1],p1[0]),b=max3f(p0[2],p0[3],p1[1]);a=max3f(a,p1[2],p1[3]);
  #pragma unroll
  for(int r=4;r<16;r+=4){a=max3f(a,p0[r],p0[r+1]);b=max3f(b,p0[r+2],p0[r+3]);a=max3f(a,p1[r],p1[r+1]);b=max3f(b,p1[r+2],p1[r+3]);}
  const float m=max2f(a,b);
  auto rr=__builtin_amdgcn_permlane32_swap(__float_as_uint(m),__float_as_uint(m),false,false);
  return max2f(__uint_as_float(rr[0]),__uint_as_float(rr[1]));
}
__device__ __forceinline__ void pv(f32x16*o,int vb,bf16x8 pa0,bf16x8 pa1,bf16x8 pa2,bf16x8 pa3){
  #pragma unroll
  for(int d0=0;d0<2;++d0){s16x4 lo[4],hi[4];
    #pragma unroll
    for(int ks=0;ks<4;++ks){
      asm volatile("ds_read_b64_tr_b16 %0,%1 offset:%c2":"=&v"(lo[ks]):"v"(vb),"i"(d0*4096+ks*1024):"memory");
      asm volatile("ds_read_b64_tr_b16 %0,%1 offset:%c2":"=&v"(hi[ks]):"v"(vb),"i"(d0*4096+ks*1024+512):"memory");}
    asm volatile("s_waitcnt lgkmcnt(0)":::"memory");SBAR();
    #define PK(k) (bf16x8){lo[k][0],lo[k][1],lo[k][2],lo[k][3],hi[k][0],hi[k][1],hi[k][2],hi[k][3]}
    o[d0]=__builtin_amdgcn_mfma_f32_32x32x16_bf16(pa0,PK(0),o[d0],0,0,0);
    o[d0]=__builtin_amdgcn_mfma_f32_32x32x16_bf16(pa1,PK(1),o[d0],0,0,0);
    o[d0]=__builtin_amdgcn_mfma_f32_32x32x16_bf16(pa2,PK(2),o[d0],0,0,0);
    o[d0]=__builtin_amdgcn_mfma_f32_32x32x16_bf16(pa3,PK(3),o[d0],0,0,0);
    #undef PK
  }
}

#ifndef ATTN_STORE16
#define ATTN_STORE16(p,v) (*(u32x4*)(p)=(v))
#endif
template<int THRL> __device__ __forceinline__ void attn_unit(int b,int qcol,int kcol,int vcol,int ocol,int qb,const bf16*Q,const bf16*__restrict__ K,const bf16*__restrict__ V,bf16*O,char*shm){
  const int tid=opaque_tid(),lane=tid&63,r32=lane&31,hi=lane>>5; const int wid=__builtin_amdgcn_readfirstlane(tid>>6);
  const long rowbase=(long)b*SEQ; const int q0=qb*QB;
  const bf16*Qw=Q+(rowbase+q0+wid*QBLK)*PQ+qcol;
  const bf16*Kh=K+rowbase*PK+kcol,*Vh=V+rowbase*PV+vcol;
  const unsigned lds0=(unsigned)(uintptr_t)shm;
  float*wsf=(float*)(shm+LDS_WS)+wid*64;
  const bf16*ksrc=Kh+(long)lane*PK+wid*8;
  const bf16*vsrc=Vh+(long)(16*(wid&3)+(lane>>2))*PV+(wid>>2)*32+(lane&3)*8;
  const unsigned kdst=lds0+LDS_K+wid*1024, vdst=lds0+LDS_V+wid*1024;
  #define DMA_K(t,slot) glds16(ksrc+(long)(t)*KVBLK*PK,(unsigned)__builtin_amdgcn_readfirstlane(kdst+(slot)))
  #define DMA_V(t,slot) glds16(vsrc+(long)(t)*KVBLK*PV,(unsigned)__builtin_amdgcn_readfirstlane(vdst+(slot)))
  const int vb0=(int)(lds0+LDS_V)+((lane>>4)&1)*32+(lane&3)*8+(4*hi+((lane&15)>>2))*64;
  const char*Kbase=shm+LDS_K; bf16x8 kf[8];
  const lds_cptr shm3=(lds_cptr)shm; const lds_cptr kp0=shm3+LDS_K+hi*1024+r32*16; const lds_cptr vp0=shm3+LDS_V+((lane>>4)&1)*32+(lane&3)*8+(4*hi+((lane&15)>>2))*64;
  const int NT=(q0+QB)/KVBLK;
  DMA_K(0,0);DMA_V(0,0);DMA_K(1,SLOTB);
  bf16x8 qr[4];
  #pragma unroll
  for(int d0=0;d0<4;++d0)qr[d0]=*reinterpret_cast<const bf16x8*>(&Qw[(long)r32*PQ+d0*16+hi*8]);
  float mhat=0.f,l_reg=0.f;f32x16 o[2];o[0]=f32x16{};o[1]=f32x16{};f32x16 negm=f32x16{};asm volatile("":"+v"(negm));
  const int qrel=wid*QBLK+r32;
  #define CMASK(P0,P1,t) do{int jb_=(t)-(NT-4); if(jb_>=0)cmask(P0,P1,jb_,qrel,hi);}while(0)
  bool resc=false;
  #define START(P0,P1) do{ const float rm=rowmax(P0,P1); resc=false; \
    { const float dl=rm; mhat=fadd_s(mhat,dl); \
      _Pragma("unroll") for(int r=0;r<16;++r){P0[r]=fsub_s(P0[r],dl);P1[r]=fsub_s(P1[r],dl);} \
      _Pragma("unroll") for(int r=0;r<16;++r)negm[r]=-mhat; asm volatile("":"+v"(negm)); } \
    _Pragma("unroll") for(int r=0;r<16;++r)P0[r]=__builtin_amdgcn_exp2f(P0[r]); }while(0)
  #define RESC() do{ if(resc){ asm volatile("s_waitcnt lgkmcnt(0)":::"memory"); \
      _Pragma("unroll") for(int d_=0;d_<2;++d_) _Pragma("unroll") for(int r=0;r<16;++r)o[d_][r]*=wsf[crow(r,hi)]; } }while(0)
  f32x16 pA0,pA1,pB0,pB1;
  int sl_prev=0,sl_cur=0,sl_next=SLOTB;
  #define ROT() do{sl_prev=sl_cur;sl_cur=sl_next;sl_next=(sl_next==(NSLOT-1)*SLOTB)?0:sl_next+SLOTB;}while(0)
  DMA_K(2,2*SLOTB);
  WAIT_BAR(3);
  qkt(pA0,pA1,Kbase,qr,negm,r32,hi);asm volatile("s_nop 15\n\ts_nop 7":"+v"(pA0),"+v"(pA1));CMASK(pA0,pA1,0);
  START(pA0,pA1);
  _Pragma("unroll") for(int r=0;r<16;++r)pA1[r]=__builtin_amdgcn_exp2f(pA1[r]);
  WAIT_BAR(0);
  DMA_K(3,0);DMA_V(1,SLOTB);
  ROT();
  kload8(kf,kp0+sl_cur);
  WAIT_BAR(2);
  s16x4 vlo[8],vhi[8]; u32x4 pw0,pw1,pw2,pw3;
  #define PKW(P,B) cvtpk_s(P[B],P[B+1])
  #define PAF(k) __builtin_bit_cast(bf16x8,pw##k)
  #define VFR(i) (bf16x8){vlo[i][0],vlo[i][1],vlo[i][2],vlo[i][3],vhi[i][0],vhi[i][1],vhi[i][2],vhi[i][3]}
  #define PIN(x) asm volatile("":"+v"(x))
  #define MX3(a,b,c) __builtin_fmaxf(__builtin_fmaxf((a),(b)),(c))
  #define GAPA(MF,A0,A1,A2,A3,W0,W1,PW) do{ MF; sacc+=A0; sacc+=A1; sacc+=A2; sacc+=A3; PIN(sacc); W0; W1; PIN(PW); SBAR(); }while(0)
  #define EX(v) __builtin_amdgcn_exp2f(v)
  #define GAPB(MF,X,B) do{ MF; X[B]=EX(X[B]); X[B+1]=EX(X[B+1]); X[B+2]=EX(X[B+2]); X[B+3]=EX(X[B+3]); PIN(X); SBAR(); }while(0)
  #define VRD(i) do{ vlo[i]=vtr(vp_+(((i)>>2)*4096+((i)&3)*1024)); vhi[i]=vtr(vp_+(((i)>>2)*4096+((i)&3)*1024+512)); }while(0)
  #define KRD(G,j) do{ if(G){ kload2(kf,kp0+sl_next,j); SBAR(); } }while(0)
  #define STEP(C0,C1,P0,P1,t,GK,GV,GL) do{ SBAR(); \
    const lds_cptr vp_=vp0+sl_prev; \
    VRD(0); SBAR(); float sacc=(P0[0]+P0[1]); \
    GAPA(C0=__builtin_amdgcn_mfma_f32_32x32x16_bf16(kf[0],qr[0],negm,0,0,0), P0[2],P0[3],P0[4],P0[5],     pw0[0]=PKW(P0,0), pw0[1]=PKW(P0,2), pw0); \
    VRD(4); SBAR(); GAPA(C1=__builtin_amdgcn_mfma_f32_32x32x16_bf16(kf[1],qr[0],negm,0,0,0), P0[6],P0[7],P0[8],P0[9],     pw0[2]=PKW(P0,4), pw0[3]=PKW(P0,6), pw0); \
    VRD(1); SBAR(); GAPA(C0=__builtin_amdgcn_mfma_f32_32x32x16_bf16(kf[2],qr[1],C0,0,0,0),   P0[10],P0[11],P0[12],P0[13], pw1[0]=PKW(P0,8), pw1[1]=PKW(P0,10), pw1); \
    VRD(5); SBAR(); GAPA(C1=__builtin_amdgcn_mfma_f32_32x32x16_bf16(kf[3],qr[1],C1,0,0,0),   P0[14],P0[15],P1[0],P1[1],   pw1[2]=PKW(P0,12),pw1[3]=PKW(P0,14), pw1); \
    VRD(2); SBAR(); GAPA(C0=__builtin_amdgcn_mfma_f32_32x32x16_bf16(kf[4],qr[2],C0,0,0,0),   P1[2],P1[3],P1[4],P1[5],     pw2[0]=PKW(P1,0), pw2[1]=PKW(P1,2), pw2); \
    VRD(6); SBAR(); GAPA(C1=__builtin_amdgcn_mfma_f32_32x32x16_bf16(kf[5],qr[2],C1,0,0,0),   P1[6],P1[7],P1[8],P1[9],     pw2[2]=PKW(P1,4), pw2[3]=PKW(P1,6), pw2); \
    VRD(3); SBAR(); GAPA(C0=__builtin_amdgcn_mfma_f32_32x32x16_bf16(kf[6],qr[3],C0,0,0,0),   P1[10],P1[11],P1[12],P1[13], pw3[0]=PKW(P1,8), pw3[1]=PKW(P1,10), pw3); \
    VRD(7); SBAR(); GAPA(C1=__builtin_amdgcn_mfma_f32_32x32x16_bf16(kf[7],qr[3],C1,0,0,0),   P1[14],P1[15],0.f,0.f,       pw3[2]=PKW(P1,12),pw3[3]=PKW(P1,14), pw3); \
    l_reg+=sacc; \
    if(GK){DMA_K((t)+3,sl_cur);} if(GV){DMA_V((t)+1,sl_next);} \
    CMASK(C0,C1,t); \
    { float a=MX3(C0[0],C0[1],C1[0]),b=MX3(C0[2],C0[3],C1[1]); a=MX3(a,C1[2],C1[3]); \
      _Pragma("unroll") for(int r=4;r<16;r+=4){a=MX3(a,C0[r],C0[r+1]);b=MX3(b,C0[r+2],C0[r+3]);a=MX3(a,C1[r],C1[r+1]);b=MX3(b,C1[r+2],C1[r+3]);} \
      float rm=__builtin_fmaxf(a,b); { auto rr=__builtin_amdgcn_permlane32_swap(__float_as_uint(rm),__float_as_uint(rm),false,false); rm=__builtin_fmaxf(__uint_as_float(rr[0]),__uint_as_float(rr[1])); } \
      resc=false; \
      if(__builtin_expect(__any(rm>(float)THRL),0)){ const float dl=__builtin_fmaxf(rm,0.f); mhat+=dl; \
        _Pragma("unroll") for(int r=0;r<16;++r){C0[r]-=dl;C1[r]-=dl;} \
        _Pragma("unroll") for(int r=0;r<16;++r)negm[r]=-mhat; asm volatile("":"+v"(negm)); \
        const float f=__builtin_amdgcn_exp2f(-dl); l_reg*=f; if(hi==0)wsf[r32]=f; resc=true; } } \
    SBAR(); \
    GAPB(o[0]=__builtin_amdgcn_mfma_f32_32x32x16_bf16(PAF(0),VFR(0),o[0],0,0,0), C0,0); \
    GAPB(o[1]=__builtin_amdgcn_mfma_f32_32x32x16_bf16(PAF(0),VFR(4),o[1],0,0,0), C0,4); \
    KRD(GL,0); GAPB(o[0]=__builtin_amdgcn_mfma_f32_32x32x16_bf16(PAF(1),VFR(1),o[0],0,0,0), C0,8); \
    KRD(GL,1); GAPB(o[1]=__builtin_amdgcn_mfma_f32_32x32x16_bf16(PAF(1),VFR(5),o[1],0,0,0), C0,12); \
    KRD(GL,2); GAPB(o[0]=__builtin_amdgcn_mfma_f32_32x32x16_bf16(PAF(2),VFR(2),o[0],0,0,0), C1,0); \
    KRD(GL,3); GAPB(o[1]=__builtin_amdgcn_mfma_f32_32x32x16_bf16(PAF(2),VFR(6),o[1],0,0,0), C1,4); \
    GAPB(o[0]=__builtin_amdgcn_mfma_f32_32x32x16_bf16(PAF(3),VFR(3),o[0],0,0,0), C1,8); \
    GAPB(o[1]=__builtin_amdgcn_mfma_f32_32x32x16_bf16(PAF(3),VFR(7),o[1],0,0,0), C1,12); \
    }while(0)
  int t=1;
  #undef CMASK
  #define CMASK(P0,P1,t) do{}while(0)
  for(;t+5<NT;t+=2){
    STEP(pB0,pB1,pA0,pA1,t,true,true,true);     WAIT_BAR(2); RESC(); ROT();
    STEP(pA0,pA1,pB0,pB1,t+1,true,true,true);   WAIT_BAR(2); RESC(); ROT();
  }
  #undef CMASK
  #define CMASK(P0,P1,t) do{int jb_=(t)-(NT-4); if(jb_>=0)cmask(P0,P1,jb_,qrel,hi);}while(0)
  #define ENDW(tt) do{ if((tt)+3<NT){WAIT_BAR(2);} else if((tt)+2<NT){WAIT_BAR(1);} else {WAIT_BAR(0);} }while(0)
  for(;t+1<NT;t+=2){
    STEP(pB0,pB1,pA0,pA1,t,(t+3<NT),(t+1<NT),(t+1<NT));       ENDW(t);   RESC(); ROT();
    STEP(pA0,pA1,pB0,pB1,t+1,(t+4<NT),(t+2<NT),(t+2<NT));     ENDW(t+1); RESC(); ROT();
  }
  STEP(pB0,pB1,pA0,pA1,NT-1,false,false,false); RESC();
  { float sacc=pB0[0]+pB0[1]; _Pragma("unroll") for(int r=2;r<16;++r)sacc+=pB0[r]; _Pragma("unroll") for(int r=0;r<16;++r)sacc+=pB1[r]; l_reg+=sacc;
    pw0=(u32x4){PKW(pB0,0),PKW(pB0,2),PKW(pB0,4),PKW(pB0,6)};pw1=(u32x4){PKW(pB0,8),PKW(pB0,10),PKW(pB0,12),PKW(pB0,14)};pw2=(u32x4){PKW(pB1,0),PKW(pB1,2),PKW(pB1,4),PKW(pB1,6)};pw3=(u32x4){PKW(pB1,8),PKW(pB1,10),PKW(pB1,12),PKW(pB1,14)};
    SBAR(); pv(o,vb0+sl_cur,PAF(0),PAF(1),PAF(2),PAF(3)); }
  #undef PKW
  #undef PAF
  #undef VFR
  #undef PIN
  #undef MX3
  #undef GAPA
  #undef GAPB
  #undef EX
  #undef VRD
  #undef KRD
  #undef STEP
  #undef ENDW
  {auto rr=__builtin_amdgcn_permlane32_swap(__float_as_uint(l_reg),__float_as_uint(l_reg),false,false);l_reg=__uint_as_float(rr[0])+__uint_as_float(rr[1]);}
  if(hi==0)wsf[32+r32]=l_reg;asm volatile("s_waitcnt lgkmcnt(0)":::"memory");
  float rli[16];
  #pragma unroll
  for(int r=0;r<16;++r)rli[r]=__builtin_amdgcn_rcpf(wsf[32+crow(r,hi)]);
  bf16*Ow=O+(rowbase+q0+wid*QBLK)*PO+ocol;
  { bf16*stg=(bf16*)(shm+LDS_OST)+wid*2048;
    #pragma unroll
    for(int r=0;r<16;++r){const int orow=crow(r,hi);
      #pragma unroll
      for(int d0=0;d0<2;++d0)stg[orow*64+d0*32+r32]=__float2bfloat16(o[d0][r]*rli[r]);}
    asm volatile("s_waitcnt lgkmcnt(0)":::"memory");
    #pragma unroll
    for(int i=0;i<4;++i){const int row=i*8+(lane>>3),ch=lane&7; const u32x4 v=*(const u32x4*)(stg+row*64+ch*8); ATTN_STORE16(Ow+(long)row*PO+ch*8,v);} }
  asm volatile("s_waitcnt lgkmcnt(0)\n\ts_barrier":::"memory");
  #undef DMA_K
  #undef DMA_V
  #undef CMASK
  #undef START
  #undef RESC
  #undef ROT
}
constexpr int ATTN_LDS_BYTES=LDS_BYTES;
struct AttnTensors { const bf16* Q; const bf16* K; const bf16* V; bf16* O; };
template<int THRL=8> __device__ __forceinline__ void attn_phase(char*lds,const AttnTensors&T,int vcu,int ncu){
  for(int w=vcu;w<256;w+=ncu){ const int s=w&1,bv=w>>1,b=bv>>4,v=bv&15,h=v>>2,c=(v>>1)&1,vh=v&1;
    for(int i=0;i<8;++i){ const int p=i>>1,qb=(i&1)?15-(2*p+s):(2*p+s);
      attn_unit<THRL>(b,h*128+c*64,h*128+c*64,h*128+vh*64,c*512+h*128+vh*64,qb,T.Q,T.K,T.V,T.O,lds); } }
}
#undef SBAR
#undef WAIT_BAR
}


namespace mk {
#define GAS __attribute__((address_space(1)))
#define LAS __attribute__((address_space(3)))
typedef unsigned short bf16;
typedef unsigned v4u __attribute__((ext_vector_type(4)));
typedef unsigned v2u __attribute__((ext_vector_type(2)));
typedef float f32x4 __attribute__((ext_vector_type(4)));
typedef float f32x16 __attribute__((ext_vector_type(16)));
typedef short bf16x8 __attribute__((ext_vector_type(8)));
typedef short s16x4 __attribute__((ext_vector_type(4)));
typedef GAS unsigned gu32;
#define RLX_AGENT __ATOMIC_RELAXED, __HIP_MEMORY_SCOPE_AGENT
#define LDS_WAIT() asm volatile("s_waitcnt lgkmcnt(0)" ::: "memory")
#define VM_WAIT() asm volatile("s_waitcnt vmcnt(0)" ::: "memory")

constexpr int NWAVES = 8, NTHR = 512;
constexpr int T = 32768, SEQ = 4096, D = 1024, NCH = 64;
constexpr float EPSN = 1e-6f;
constexpr int RING_OFF = 0, RING_BYTES = 131072, LDSCTL_OFF = RING_BYTES, MISC_OFF = LDSCTL_OFF + 320, LDS_BYTES = 147456;
constexpr int CW_BAR = 4096;
constexpr int CW_ECNT = 8192;
constexpr int CW_ROWSS = 131072;
constexpr size_t WS_YOFF = 72 * MiB_;
constexpr size_t MS_ETOK = 0, MS_EW = 2 * MiB_, MS_DVEC = 4 * MiB_, MS_TPOS = 5 * MiB_, MS_TW = 6 * MiB_, MS_PB = 8 * MiB_;

__device__ __forceinline__ unsigned f2bf(float f) { unsigned u = __builtin_bit_cast(unsigned, f); return (u + 0x7fffu + ((u >> 16) & 1u)) >> 16; }
__device__ __forceinline__ unsigned pk2(float lo, float hi) { return pg8::cvt_pk_bf16(lo, hi); }
__device__ __forceinline__ float bflo(unsigned w) { return __uint_as_float(w << 16); }
__device__ __forceinline__ float bfhi(unsigned w) { return __uint_as_float(w & 0xffff0000u); }
__device__ __forceinline__ float bf1(bf16 v) { return __uint_as_float(((unsigned)v) << 16); }
__device__ __forceinline__ float wave_sum(float v) {
#pragma unroll
    for (int o = 1; o < 64; o <<= 1) v += __shfl_xor(v, o);
    return v;
}
__device__ __forceinline__ float ex2(float x) { return __builtin_amdgcn_exp2f(x); }
__device__ __forceinline__ float fexp(float x) { return __builtin_amdgcn_exp2f(1.4426950408889634f * x); }
__device__ __forceinline__ float frcp(float x) { return __builtin_amdgcn_rcpf(x); }

#define XB_TMO      128
#define XB_XCNT(j)  (256  + 64 * (j))
#define XB_XSUB(j)  (1280 + 64 * (j))
#define XB_XGEN(j)  (2304 + 64 * (j))
#define XB_TOP      3328
#define XB_TOPGEN   3392
#define XCD_BAR_WORDS 3456
#define XB_SPIN_CAP (1u << 18)
__device__ __forceinline__ unsigned xb_ld(unsigned* p)              { return __hip_atomic_load(p, __ATOMIC_RELAXED, __HIP_MEMORY_SCOPE_AGENT); }
__device__ __forceinline__ unsigned xb_add(unsigned* p, unsigned v) { return __hip_atomic_fetch_add(p, v, __ATOMIC_RELAXED, __HIP_MEMORY_SCOPE_AGENT); }
__device__ __forceinline__ unsigned xb_xcc_id() { return (unsigned)__builtin_amdgcn_s_getreg((3 << 11) | 20) & 0xFu; }
#define XB_SPIN(cond, bar) do { unsigned _sp = 0; while (cond) { __builtin_amdgcn_s_sleep(1); \
    if ((++_sp & 255u) == 0u) { if (xb_ld(&(bar)[XB_TMO])) break; if (_sp > XB_SPIN_CAP) { atomicAdd(&(bar)[XB_TMO], 1u); break; } } } } while (0)
struct XcdBarrier { unsigned* bar; unsigned x; volatile LAS unsigned* st; };
__device__ __forceinline__ XcdBarrier xcd_barrier_post(unsigned* bar, volatile LAS unsigned* st) {
    XcdBarrier b; b.bar = bar; b.x = xb_xcc_id(); b.st = st;
    if (threadIdx.x == 0) (void)xb_add(&bar[XB_XCNT(b.x)], 1u);
    return b;
}
__device__ __forceinline__ void xcd_barrier_complete(unsigned* bar, unsigned x, unsigned& nloc, unsigned& nx) {
    const unsigned G = gridDim.x * gridDim.y * gridDim.z;
    unsigned sum, cnt, mine, sp = 0u;
    for (;;) {
        sum = 0u; cnt = 0u; mine = 0u;
#pragma unroll
        for (unsigned j = 0; j < 16; ++j) { const unsigned c = xb_ld(&bar[XB_XCNT(j)]); sum += c; cnt += (c > 0u) ? 1u : 0u; mine = (j == x) ? c : mine; }
        if (sum == G) break;
        __builtin_amdgcn_s_sleep(1);
        if ((++sp & 255u) == 0u) { if (xb_ld(&bar[XB_TMO])) break; if (sp > XB_SPIN_CAP) { atomicAdd(&bar[XB_TMO], 1u); break; } }
    }
    nloc = mine > 0u ? mine : 1u; nx = cnt > 0u ? cnt : 1u;
}
__device__ __forceinline__ void xcd_barrier(const XcdBarrier& b) {
    asm volatile("s_waitcnt vmcnt(0)" ::: "memory");
    __syncthreads();
    if (threadIdx.x == 0) {
        unsigned* bar = b.bar;
        __builtin_amdgcn_s_waitcnt(0);
        unsigned nloc = b.st[0], nx = b.st[1];
        if (nloc == 0u) { xcd_barrier_complete(bar, b.x, nloc, nx); b.st[0] = nloc; b.st[1] = nx; }
        const unsigned old = xb_add(&bar[XB_XSUB(b.x)], 1u);
        const unsigned gen = old / nloc;
        if (old + 1u == (gen + 1u) * nloc) {
            __builtin_amdgcn_fence(__ATOMIC_RELEASE, "agent");
            asm volatile("s_waitcnt vmcnt(0)" ::: "memory");
            const unsigned og = xb_add(&bar[XB_TOP], 1u);
            const unsigned tg = og / nx;
            if (og + 1u == (tg + 1u) * nx) xb_add(&bar[XB_TOPGEN], 1u);
            else XB_SPIN(xb_ld(&bar[XB_TOPGEN]) == tg, bar);
            __builtin_amdgcn_fence(__ATOMIC_ACQUIRE, "agent");
            xb_add(&bar[XB_XGEN(b.x)], 1u);
            asm volatile("s_waitcnt vmcnt(0)" ::: "memory");
        } else {
            XB_SPIN(xb_ld(&bar[XB_XGEN(b.x)]) == gen, bar);
            __builtin_amdgcn_fence(__ATOMIC_ACQUIRE, "agent");
            asm volatile("s_waitcnt vmcnt(0)" ::: "memory");
        }
    }
    __syncthreads();
}

struct Args { const float* in[22]; float* out; unsigned char* ws; int ph_lo, ph_hi; };
struct Frame {
    LAS unsigned char* lds; volatile LAS unsigned* MISC; unsigned* ctl; int tid, lane, wave, vcu, G;
};
enum { I_X = 0, I_P, I_MIXN, I_WIN, I_LB, I_HON, I_QN, I_KN, I_LQ1, I_LK1, I_LQ2, I_LK2, I_SUBLN, I_WOUT, I_FFNN, I_WR, I_WG, I_WU, I_WD, I_PP, I_PLEN, I_PG };

__device__ __forceinline__ void p0_transpose_item(const float* W, int K, int N, bf16* WT, int row_off, LAS float* scr, int item, int lane) {
    const int nblk = N / 32, kb = item / nblk, nb = item % nblk, k0 = 64 * kb, n0 = 32 * nb;
#pragma unroll 8
    for (int i = 0; i < 32; ++i) { const int kk = 2 * i + (lane >> 5); scr[kk * 33 + (lane & 31)] = W[(size_t)(k0 + kk) * N + n0 + (lane & 31)]; }
    LDS_WAIT(); asm volatile("" ::: "memory");
    const int c = lane & 7;
#pragma unroll
    for (int j = 0; j < 4; ++j) { const int n = (lane >> 3) + 8 * j; const LAS float* s = scr + (8 * c) * 33 + n;
        v4u o; o.x = pk2(s[0 * 33], s[1 * 33]); o.y = pk2(s[2 * 33], s[3 * 33]); o.z = pk2(s[4 * 33], s[5 * 33]); o.w = pk2(s[6 * 33], s[7 * 33]);
        *(GAS v4u*)(WT + (size_t)(row_off + n0 + n) * K + k0 + 8 * c) = o; }
    LDS_WAIT(); asm volatile("" ::: "memory");
}
__device__ __forceinline__ void rms_row_to_bf16(const float* xrow, const float* gain, bf16* orow, int lane) {
    const GAS f32x4* xr = (const GAS f32x4*)xrow + lane; const f32x4* gr = (const f32x4*)gain + lane;
    f32x4 v[4]; float s = 0.f;
#pragma unroll
    for (int j = 0; j < 4; ++j) { v[j] = xr[64 * j]; s += (v[j].x * v[j].x + v[j].y * v[j].y) + (v[j].z * v[j].z + v[j].w * v[j].w); }
    const float r = rsqrtf(wave_sum(s) * (1.f / 1024.f) + EPSN);
    GAS v2u* o8 = (GAS v2u*)orow + lane;
#pragma unroll
    for (int j = 0; j < 4; ++j) { const f32x4 g = gr[64 * j]; v2u w; w.x = pk2(v[j].x * r * g.x, v[j].y * r * g.y); w.y = pk2(v[j].z * r * g.z, v[j].w * r * g.w); o8[64 * j] = w; }
}
__device__ __forceinline__ void p0_prologue(Frame& F, const Args& a) {
    LAS float* scr = (LAS float*)(F.lds + RING_OFF + F.wave * 16384);
    const int gw = F.vcu * NWAVES + F.wave, NGW = F.G * NWAVES;
    unsigned char* ws = a.ws;
    constexpr int I_IN = 1792, I_OUT = 512, I_G = 4096, I_PPJ = 128, I_PGT = 512, PER_L = I_IN + I_OUT + 3 * I_G + I_PPJ + I_PGT;
    for (int it = gw; it < 2 * PER_L; it += NGW) {
        const int l = it / PER_L; int r = it % PER_L;
        if (r < I_IN) { p0_transpose_item(a.in[I_WIN] + (size_t)l * 1024 * 3584, 1024, 3584, (bf16*)(ws + WS_WIN) + (size_t)l * 3584 * 1024, 0, scr, r, F.lane); continue; } r -= I_IN;
        if (r < I_OUT) { p0_transpose_item(a.in[I_WOUT] + (size_t)l * 1024 * 1024, 1024, 1024, (bf16*)(ws + WS_WOUT) + (size_t)l * 1024 * 1024, 0, scr, r, F.lane); continue; } r -= I_OUT;
        if (r < 2 * I_G) { const int up = r / I_G; r %= I_G; const int e = r >> 8, it2 = r & 255, nb = it2 % 16, n0 = nb * 32;
            const int roff = (n0 >> 7) * 256 + (n0 & 127) + up * 128 - n0;
            p0_transpose_item(a.in[up ? I_WU : I_WG] + ((size_t)l * 16 + e) * 1024 * 512, 1024, 512, (bf16*)(ws + WS_WGU) + ((size_t)l * 16 + e) * 1024 * 1024, roff, scr, it2, F.lane); continue; } r -= 2 * I_G;
        if (r < I_G) { const int e = r >> 8, it2 = r & 255;
            p0_transpose_item(a.in[I_WD] + ((size_t)l * 16 + e) * 512 * 1024, 512, 1024, (bf16*)(ws + WS_WDN) + ((size_t)l * 16 + e) * 1024 * 512, 0, scr, it2, F.lane); continue; } r -= I_G;
        if (r < I_PPJ) { p0_transpose_item(a.in[I_PP] + (size_t)l * 256 * 1024, 256, 1024, (bf16*)(ws + WS_WPP) + (size_t)l * 1024 * 256, 0, scr, r, F.lane); continue; } r -= I_PPJ;
        p0_transpose_item(a.in[I_PG] + (size_t)l * 1024 * 1024, 1024, 1024, (bf16*)(ws + WS_WPG) + (size_t)l * 1024 * 1024, 0, scr, r, F.lane);
    }
    for (int m = gw; m < T; m += NGW) rms_row_to_bf16(a.in[I_X] + (size_t)m * D, a.in[I_MIXN], (bf16*)(ws + WS_XN) + (size_t)m * D, F.lane);
}

__device__ __forceinline__ void qk_norm_rows(Frame& F, bf16* dq, bf16* dk, const float* qg, const float* kg) {
    const int gw = F.vcu * NWAVES + F.wave, NGW = F.G * NWAVES, lane = F.lane;
    const int c0 = (lane & 7) * 8;
    float gq[8], gk[8];
#pragma unroll
    for (int j = 0; j < 8; ++j) { gq[j] = qg[c0 + j] * (0.125f * 1.4426950408889634f); gk[j] = kg[c0 + j]; }
    for (int m = gw; m < T; m += NGW) {
#pragma unroll
        for (int w = 0; w < 2; ++w) {
            GAS v4u* p = (GAS v4u*)((w ? dk : dq) + (size_t)m * 512) + lane;
            const v4u x = *p; float v[8] = {bflo(x.x), bfhi(x.x), bflo(x.y), bfhi(x.y), bflo(x.z), bfhi(x.z), bflo(x.w), bfhi(x.w)};
            float s = 0.f;
#pragma unroll
            for (int j = 0; j < 8; ++j) s += v[j] * v[j];
            s += __shfl_xor(s, 1); s += __shfl_xor(s, 2); s += __shfl_xor(s, 4);
            const float r = rsqrtf(s * (1.f / 64.f) + EPSN);
            v4u o;
            if (w == 0) { o.x = pk2(v[0] * r * gq[0], v[1] * r * gq[1]); o.y = pk2(v[2] * r * gq[2], v[3] * r * gq[3]); o.z = pk2(v[4] * r * gq[4], v[5] * r * gq[5]); o.w = pk2(v[6] * r * gq[6], v[7] * r * gq[7]); }
            else        { o.x = pk2(v[0] * r * gk[0], v[1] * r * gk[1]); o.y = pk2(v[2] * r * gk[2], v[3] * r * gk[3]); o.z = pk2(v[4] * r * gk[4], v[5] * r * gk[5]); o.w = pk2(v[6] * r * gk[6], v[7] * r * gk[7]); }
            *p = o;
        }
    }
}

constexpr int HB_QM = 0, HB_KM = 17408, HB_KET = 34816, HB_VT = 53248, HB_PART = 71680;
__device__ __forceinline__ void hgrn_b1_unit(Frame& F, int b, int h, int c, bf16* zq, bf16* zf, bf16* zi, bf16* Lst, float* dvec, float lbv) {
    const int tid = F.tid, lane = F.lane, wave = F.wave;
    LAS unsigned char* lds = F.lds + RING_OFF;
    const int d = tid & 127, rg = tid >> 7, s0 = rg * 16;
    const size_t rowbase = (size_t)b * SEQ + c * 64;
    const size_t gcol = (size_t)h * 128 + d;
    float q[16], kk[16], g[16];
    unsigned vraw[16];
#pragma unroll
    for (int j = 0; j < 16; ++j) {
        const size_t off = (rowbase + s0 + j) * 512 + gcol;
        const float xq = bf1(zq[off]), xf = bf1(zf[off]); vraw[j] = zi[off];
        const float eq = fexp(-xq); q[j] = xq * frcp(1.f + eq);
        const float ef = fexp(-xf), sg = frcp(1.f + ef);
        const float fo = fmaxf(lbv + (1.f - lbv) * sg, 1e-6f);
        g[j] = __builtin_amdgcn_logf(fo) * 0.6931471805599453f;
        kk[j] = (1.f - lbv) * ef * sg;
    }
    float run = 0.f;
#pragma unroll
    for (int j = 0; j < 16; ++j) { run += g[j]; g[j] = run; }
    LAS float* part = (LAS float*)(lds + HB_PART);
    part[rg * 128 + d] = run;
    LDS_WAIT(); __syncthreads();
    const float p0 = part[d], p1 = part[128 + d], p2 = part[256 + d], p3 = part[384 + d];
    const float offs = (rg > 0 ? p0 : 0.f) + (rg > 1 ? p1 : 0.f) + (rg > 2 ? p2 : 0.f);
    const float last = (p0 + p1) + (p2 + p3), ref = p0 + p1;
    unsigned ket[8], vt[8];
#pragma unroll
    for (int j = 0; j < 16; ++j) {
        const float cum = g[j] + offs;
        const float qe = q[j] * fexp(cum), ke = kk[j] * fexp(last - cum);
        const float qm = q[j] * fexp(fminf(cum - ref, 80.f)), km = kk[j] * fexp(fminf(ref - cum, 80.f));
        zq[(rowbase + s0 + j) * 512 + gcol] = (bf16)f2bf(qe);
        *(LAS bf16*)(lds + HB_QM + ((s0 + j) * 136 + d) * 2) = (bf16)f2bf(qm);
        *(LAS bf16*)(lds + HB_KM + ((s0 + j) * 136 + d) * 2) = (bf16)f2bf(km);
        const unsigned keb = f2bf(ke);
        if (j & 1) { ket[j >> 1] |= keb << 16; vt[j >> 1] |= vraw[j] << 16; } else { ket[j >> 1] = keb; vt[j >> 1] = vraw[j]; }
    }
    { LAS v4u* pk = (LAS v4u*)(lds + HB_KET + (d * 72 + s0) * 2); pk[0] = (v4u){ket[0], ket[1], ket[2], ket[3]}; pk[1] = (v4u){ket[4], ket[5], ket[6], ket[7]};
      LAS v4u* pv = (LAS v4u*)(lds + HB_VT + (d * 72 + s0) * 2); pv[0] = (v4u){vt[0], vt[1], vt[2], vt[3]}; pv[1] = (v4u){vt[4], vt[5], vt[6], vt[7]}; }
    if (rg == 0) dvec[(((size_t)b * 4 + h) * NCH + c) * 128 + d] = fexp(last);
    LDS_WAIT(); __syncthreads();
    const int r32 = lane & 31, hh = lane >> 5;
    {
        const int ti = wave >> 2, vb = wave & 3;
        f32x16 o = f32x16{};
        for (int si = 0; si <= ti; ++si) {
            f32x16 xt = f32x16{};
#pragma unroll
            for (int ks = 0; ks < 8; ++ks) {
                const bf16x8 af = *(const LAS bf16x8*)(lds + HB_KM + ((si * 32 + r32) * 136 + ks * 16 + hh * 8) * 2);
                const bf16x8 bfr = *(const LAS bf16x8*)(lds + HB_QM + ((ti * 32 + r32) * 136 + ks * 16 + hh * 8) * 2);
                xt = __builtin_amdgcn_mfma_f32_32x32x16_bf16(af, bfr, xt, 0, 0, 0);
            }
            if (si == ti) {
#pragma unroll
                for (int r = 0; r < 16; ++r) { const int sl = (r & 3) + 8 * (r >> 2) + 4 * hh; if (sl > r32) xt[r] = 0.f; }
            }
#pragma unroll
            for (int ks = 0; ks < 2; ++ks) {
                v4u aw; aw.x = pk2(xt[8 * ks + 0], xt[8 * ks + 1]); aw.y = pk2(xt[8 * ks + 2], xt[8 * ks + 3]); aw.z = pk2(xt[8 * ks + 4], xt[8 * ks + 5]); aw.w = pk2(xt[8 * ks + 6], xt[8 * ks + 7]);
                const LAS unsigned char* vp = lds + HB_VT + ((vb * 32 + r32) * 72 + si * 32 + ks * 16 + 4 * hh) * 2;
                const v2u b0 = *(const LAS v2u*)vp, b1 = *(const LAS v2u*)(vp + 16);
                const v4u bw = (v4u){b0.x, b0.y, b1.x, b1.y};
                o = __builtin_amdgcn_mfma_f32_32x32x16_bf16(__builtin_bit_cast(bf16x8, aw), __builtin_bit_cast(bf16x8, bw), o, 0, 0, 0);
            }
        }
#pragma unroll
        for (int r = 0; r < 16; ++r) { const int tl = ti * 32 + (r & 3) + 8 * (r >> 2) + 4 * hh;
            zi[(rowbase + tl) * 512 + h * 128 + vb * 32 + r32] = (bf16)f2bf(o[r]); }
    }
#pragma unroll
    for (int tt = 0; tt < 2; ++tt) {
        const int tile = wave * 2 + tt, di = tile >> 2, vi = tile & 3;
        f32x16 L = f32x16{};
#pragma unroll
        for (int ks = 0; ks < 4; ++ks) {
            const bf16x8 af = *(const LAS bf16x8*)(lds + HB_KET + ((di * 32 + r32) * 72 + ks * 16 + hh * 8) * 2);
            const bf16x8 bfr = *(const LAS bf16x8*)(lds + HB_VT + ((vi * 32 + r32) * 72 + ks * 16 + hh * 8) * 2);
            L = __builtin_amdgcn_mfma_f32_32x32x16_bf16(af, bfr, L, 0, 0, 0);
        }
        const int v = vi * 32 + r32, vs = v >> 4, v16 = v & 15;
        bf16* Lb = Lst + ((((size_t)b * 4 + h) * NCH + c) * 8 + vs) * 2048;
#pragma unroll
        for (int qd = 0; qd < 4; ++qd) { const int gg = 2 * (qd & 1) + hh, dt = 2 * di + (qd >> 1);
            v2u w; w.x = pk2(L[4 * qd + 0], L[4 * qd + 1]); w.y = pk2(L[4 * qd + 2], L[4 * qd + 3]);
            *(GAS v2u*)(Lb + (gg * 16 + v16) * 32 + dt * 4) = w; }
    }
    VM_WAIT(); LDS_WAIT(); __syncthreads();
}
__device__ __forceinline__ void hgrn_b1_phase(Frame& F, const Args& a, int layer) {
    bf16* zq = (bf16*)(a.ws + WS_Z); bf16* zf = zq + (size_t)T * 512; bf16* zi = zq + (size_t)2 * T * 512;
    bf16* Lst = (bf16*)(a.ws + WS_XN); float* dvec = (float*)(a.ws + WS_MISC + MS_DVEC);
    for (int u = F.vcu; u < 8 * 4 * NCH; u += F.G) {
        const int c = u & 63, h = (u >> 6) & 3, b = u >> 8;
        const int col = h * 128 + (F.tid & 127);
        float lbv = 0.f;
        if (layer == 1) { const float a0 = a.in[I_LB][col], a1 = a.in[I_LB][512 + col]; const float mx = fmaxf(a0, a1); const float e0 = fexp(a0 - mx), e1 = fexp(a1 - mx); lbv = e1 / (e0 + e1); }
        hgrn_b1_unit(F, b, h, c, zq, zf, zi, Lst, dvec, lbv);
    }
}
typedef float f32x4v __attribute__((ext_vector_type(4)));
__device__ __forceinline__ void hgrn_seq_unit(Frame& F, int b, int h, int vs, const bf16* QE, bf16* O, const bf16* Lst, const float* dvec) {
    const int lane = F.lane, wave = F.wave;
    if (wave >= 4) return;
    const int v16 = lane & 15, g = lane >> 4, tb = wave;
    float S[32];
#pragma unroll
    for (int i = 0; i < 32; ++i) S[i] = 0.f;
    const size_t bh = (size_t)b * 4 + h;
    for (int c = 0; c < NCH; ++c) {
        const size_t row = (size_t)b * SEQ + c * 64 + tb * 16;
        v2u qa[4][2];
        const bf16* qrow = QE + (row + v16) * 512 + h * 128;
#pragma unroll
        for (int ks = 0; ks < 4; ++ks) { qa[ks][0] = *(const GAS v2u*)(qrow + ks * 32 + 4 * g); qa[ks][1] = *(const GAS v2u*)(qrow + ks * 32 + 16 + 4 * g); }
        const bf16* Lb = Lst + ((bh * NCH + c) * 8 + vs) * 2048 + lane * 32;
        v4u lw[4];
#pragma unroll
        for (int i = 0; i < 4; ++i) lw[i] = *(const GAS v4u*)(Lb + i * 8);
        const float* dv = dvec + (bh * NCH + c) * 128;
        f32x4v dd[8];
#pragma unroll
        for (int dt = 0; dt < 8; ++dt) dd[dt] = *(const GAS f32x4v*)(dv + dt * 16 + 4 * g);
        bf16 oin[4];
        bf16* op = O + (row + 4 * g) * 512 + h * 128 + vs * 16 + v16;
#pragma unroll
        for (int r = 0; r < 4; ++r) oin[r] = op[(size_t)r * 512];
        f32x4v acc = (f32x4v){0.f, 0.f, 0.f, 0.f};
#pragma unroll
        for (int ks = 0; ks < 4; ++ks) {
            v4u bw; bw.x = pk2(S[8 * ks + 0], S[8 * ks + 1]); bw.y = pk2(S[8 * ks + 2], S[8 * ks + 3]); bw.z = pk2(S[8 * ks + 4], S[8 * ks + 5]); bw.w = pk2(S[8 * ks + 6], S[8 * ks + 7]);
            const v4u aw = (v4u){qa[ks][0].x, qa[ks][0].y, qa[ks][1].x, qa[ks][1].y};
            acc = __builtin_amdgcn_mfma_f32_16x16x32_bf16(__builtin_bit_cast(bf16x8, aw), __builtin_bit_cast(bf16x8, bw), acc, 0, 0, 0);
        }
#pragma unroll
        for (int r = 0; r < 4; ++r) op[(size_t)r * 512] = (bf16)f2bf(acc[r] + bf1(oin[r]));
#pragma unroll
        for (int dt = 0; dt < 8; ++dt) {
            const unsigned w0 = lw[dt >> 1][(dt & 1) * 2], w1 = lw[dt >> 1][(dt & 1) * 2 + 1];
            S[4 * dt + 0] = dd[dt][0] * S[4 * dt + 0] + bflo(w0); S[4 * dt + 1] = dd[dt][1] * S[4 * dt + 1] + bfhi(w0);
            S[4 * dt + 2] = dd[dt][2] * S[4 * dt + 2] + bflo(w1); S[4 * dt + 3] = dd[dt][3] * S[4 * dt + 3] + bfhi(w1);
        }
    }
}
__device__ __forceinline__ void hgrn_seq_phase(Frame& F, const Args& a) {
    const bf16* zq = (const bf16*)(a.ws + WS_Z); bf16* zi = (bf16*)(a.ws + WS_Z) + (size_t)2 * T * 512;
    const bf16* Lst = (const bf16*)(a.ws + WS_XN); const float* dvec = (const float*)(a.ws + WS_MISC + MS_DVEC);
    for (int u = F.vcu; u < 256; u += F.G) hgrn_seq_unit(F, u >> 5, (u >> 3) & 3, u & 7, zq, zi, Lst, dvec);
}

__device__ __forceinline__ void mix_finalize(Frame& F, const Args& a, int layer) {
    const int gw = F.vcu * NWAVES + F.wave, NGW = F.G * NWAVES, lane = F.lane;
    const bf16* oh = (const bf16*)(a.ws + WS_Z) + (size_t)2 * T * 512; const bf16* zg = (const bf16*)(a.ws + WS_Z) + (size_t)3 * T * 512;
    const bf16* OA = (const bf16*)(a.ws + WS_OA); bf16* mix = (bf16*)(a.ws + WS_Z) + (size_t)4 * T * 512;
    const float lam_init = 0.8f - 0.6f * fexp(-0.3f * (float)layer);
    const float la = wave_sum(a.in[I_LQ1][layer * 64 + lane] * a.in[I_LK1][layer * 64 + lane]), lb = wave_sum(a.in[I_LQ2][layer * 64 + lane] * a.in[I_LK2][layer * 64 + lane]);
    const float lam = fexp(la) - fexp(lb) + lam_init;
    const int c0 = (lane & 15) * 8;
    float gh[8], gs[8];
#pragma unroll
    for (int j = 0; j < 8; ++j) { gh[j] = a.in[I_HON][layer * 128 + c0 + j]; gs[j] = a.in[I_SUBLN][layer * 128 + c0 + j] * (1.f - lam_init); }
    for (int m = gw; m < T; m += NGW) {
        const v4u xo = *((const GAS v4u*)(oh + (size_t)m * 512) + lane), xg = *((const GAS v4u*)(zg + (size_t)m * 512) + lane);
        const v4u x0 = *((const GAS v4u*)(OA + (size_t)m * 1024) + lane), x1 = *((const GAS v4u*)(OA + (size_t)m * 1024 + 512) + lane);
        float o[8] = {bflo(xo.x), bfhi(xo.x), bflo(xo.y), bfhi(xo.y), bflo(xo.z), bfhi(xo.z), bflo(xo.w), bfhi(xo.w)};
        float gt[8] = {bflo(xg.x), bfhi(xg.x), bflo(xg.y), bfhi(xg.y), bflo(xg.z), bfhi(xg.z), bflo(xg.w), bfhi(xg.w)};
        float d0[8] = {bflo(x0.x), bfhi(x0.x), bflo(x0.y), bfhi(x0.y), bflo(x0.z), bfhi(x0.z), bflo(x0.w), bfhi(x0.w)};
        float d1[8] = {bflo(x1.x), bfhi(x1.x), bflo(x1.y), bfhi(x1.y), bflo(x1.z), bfhi(x1.z), bflo(x1.w), bfhi(x1.w)};
        float s = 0.f, s2 = 0.f;
#pragma unroll
        for (int j = 0; j < 8; ++j) { s += o[j] * o[j]; d0[j] -= lam * d1[j]; s2 += d0[j] * d0[j]; }
#pragma unroll
        for (int k = 1; k < 16; k <<= 1) { s += __shfl_xor(s, k); s2 += __shfl_xor(s2, k); }
        const float r = rsqrtf(s * (1.f / 128.f) + EPSN), r2 = rsqrtf(s2 * (1.f / 128.f) + EPSN);
        float y[8], z[8];
#pragma unroll
        for (int j = 0; j < 8; ++j) { y[j] = o[j] * r * gh[j] * (gt[j] * frcp(1.f + fexp(-gt[j]))); z[j] = d0[j] * r2 * gs[j]; }
        *((GAS v4u*)(mix + (size_t)m * 1024) + lane) = (v4u){pk2(y[0], y[1]), pk2(y[2], y[3]), pk2(y[4], y[5]), pk2(y[6], y[7])};
        *((GAS v4u*)(mix + (size_t)m * 1024 + 512) + lane) = (v4u){pk2(z[0], z[1]), pk2(z[2], z[3]), pk2(z[4], z[5]), pk2(z[6], z[7])};
    }
}

__device__ __forceinline__ void router_phase(Frame& F, const Args& a, int layer) {
    const int tid = F.tid, lane = F.lane, wave = F.wave;
    LAS unsigned char* lds = F.lds + RING_OFF;
    LAS float* wrt = (LAS float*)lds; LAS int* le = (LAS int*)(lds + 65536); LAS float* lw = (LAS float*)(lds + 66560); LAS int* lrank = (LAS int*)(lds + 67584);
    LAS int* lcnt = (LAS int*)(lds + 68608); LAS int* lbase = (LAS int*)(lds + 68672);
    const float* h = a.out; bf16* xn2 = (bf16*)(a.ws + WS_XN); const float* gain = a.in[I_FFNN] + layer * 1024;
    int* etok = (int*)(a.ws + WS_MISC + MS_ETOK); int* tpos = (int*)(a.ws + WS_MISC + MS_TPOS); float* tw = (float*)(a.ws + WS_MISC + MS_TW);
    unsigned* gcnt = F.ctl + CW_ECNT + layer * 16 * 64;
    for (int i = tid; i < 16384; i += NTHR) wrt[(i & 15) * 1024 + (i >> 4)] = a.in[I_WR][i];
    f32x4 gv[4];
#pragma unroll
    for (int j = 0; j < 4; ++j) gv[j] = *((const f32x4*)gain + lane + 64 * j);
    for (int tb0 = F.vcu * 128; tb0 < T; tb0 += F.G * 128) {
        if (tid < 16) lcnt[tid] = 0;
        LDS_WAIT(); __syncthreads();
        for (int j = 0; j < 16; ++j) {
            const int tok = tb0 + wave * 16 + j;
            const GAS f32x4* xr = (const GAS f32x4*)(h + (size_t)tok * 1024) + lane;
            f32x4 v[4]; float s = 0.f;
#pragma unroll
            for (int i = 0; i < 4; ++i) { v[i] = xr[64 * i]; s += (v[i].x * v[i].x + v[i].y * v[i].y) + (v[i].z * v[i].z + v[i].w * v[i].w); }
            const float r = rsqrtf(wave_sum(s) * (1.f / 1024.f) + EPSN);
            GAS v2u* o8 = (GAS v2u*)(xn2 + (size_t)tok * 1024) + lane;
#pragma unroll
            for (int i = 0; i < 4; ++i) { v[i].x *= r * gv[i].x; v[i].y *= r * gv[i].y; v[i].z *= r * gv[i].z; v[i].w *= r * gv[i].w; v2u w; w.x = pk2(v[i].x, v[i].y); w.y = pk2(v[i].z, v[i].w); o8[64 * i] = w; }
            float acc[16];
#pragma unroll
            for (int e = 0; e < 16; ++e) { float t = 0.f;
#pragma unroll
                for (int i = 0; i < 4; ++i) { const f32x4 w4 = *((const LAS f32x4*)(wrt + e * 1024) + lane + 64 * i); t += (v[i].x * w4.x + v[i].y * w4.y) + (v[i].z * w4.z + v[i].w * w4.w); }
                acc[e] = wave_sum(t); }
            float mx = acc[0];
#pragma unroll
            for (int e = 1; e < 16; ++e) mx = fmaxf(mx, acc[e]);
            float sum = 0.f;
#pragma unroll
            for (int e = 0; e < 16; ++e) { acc[e] = __expf(acc[e] - mx); sum += acc[e]; }
            const float inv = 1.f / sum;
#pragma unroll
            for (int e = 0; e < 16; ++e) acc[e] *= inv;
            float bestg = -1.f; int gs = 0, bi1 = 0, bi2 = 1; float bv1 = 0.f, bv2 = 0.f;
#pragma unroll
            for (int gq = 0; gq < 4; ++gq) {
                int i1 = 0; float v1 = acc[4 * gq];
#pragma unroll
                for (int jj = 1; jj < 4; ++jj) if (acc[4 * gq + jj] > v1) { v1 = acc[4 * gq + jj]; i1 = jj; }
                int i2 = -1; float v2 = -1.f;
#pragma unroll
                for (int jj = 0; jj < 4; ++jj) if (jj != i1 && acc[4 * gq + jj] > v2) { v2 = acc[4 * gq + jj]; i2 = jj; }
                const float sc = v1 + v2;
                if (sc > bestg) { bestg = sc; gs = gq; bi1 = i1; bi2 = i2; bv1 = v1; bv2 = v2; }
            }
            if (lane == 0) { const float si = 1.f / (bv1 + bv2); const int aidx = (wave * 16 + j) * 2;
                le[aidx] = gs * 4 + bi1; le[aidx + 1] = gs * 4 + bi2; lw[aidx] = bv1 * si; lw[aidx + 1] = bv2 * si; }
        }
        LDS_WAIT(); __syncthreads();
        if (tid < 256) lrank[tid] = atomicAdd((int*)&lcnt[le[tid]], 1);
        LDS_WAIT(); __syncthreads();
        if (tid < 16) lbase[tid] = (int)__hip_atomic_fetch_add(gcnt + tid * 64, (unsigned)lcnt[tid], RLX_AGENT);
        LDS_WAIT(); __syncthreads();
        if (tid < 256) { const int e = le[tid], pos = lbase[e] + lrank[tid]; etok[(size_t)e * T + pos] = tb0 + (tid >> 1); tpos[(size_t)tb0 * 2 + tid] = (e << 20) | pos; tw[(size_t)tb0 * 2 + tid] = lw[tid]; }
        __syncthreads();
    }
    { const GAS f32x4* ps = (const GAS f32x4*)(a.in[I_P] + (size_t)layer * T * 256); GAS v2u* pd = (GAS v2u*)(a.ws + WS_MISC + MS_PB);
      for (size_t i = (size_t)F.vcu * NTHR + tid; i < (size_t)T * 64; i += (size_t)F.G * NTHR) { const f32x4 v = ps[i]; v2u w; w.x = pk2(v.x, v.y); w.y = pk2(v.z, v.w); pd[i] = w; } }
}

struct MoeTab { const LAS int* tb; const LAS int* cnt; };
__device__ __forceinline__ void moe_table(Frame& F, int layer) {
    LAS int* tb = (LAS int*)(F.lds + LDSCTL_OFF); LAS int* cnt = tb + 20;
    if (F.tid == 0) { int s = 0; for (int e = 0; e < 16; ++e) { const int c = (int)__hip_atomic_load(F.ctl + CW_ECNT + (layer * 16 + e) * 64, RLX_AGENT); cnt[e] = c; tb[e] = s; s += (c + 255) >> 8; } tb[16] = s; }
    LDS_WAIT(); __syncthreads();
}
struct MoeOrder {
    const LAS int* tb; int G, c;
    __device__ __forceinline__ bool next(int i, pg8::Unit& u) const {
        const int L = i * G + c, nt = tb[16]; if (L >= nt * 4) return false;
        const int tile = L >> 2; int e = 0;
#pragma unroll
        for (int j = 1; j < 16; ++j) e += (tile >= tb[j]) ? 1 : 0;
        u.pm = tile; u.pn = L & 3; u.e = __builtin_amdgcn_readfirstlane(e); return true;
    }
};
struct MoeGather {
    const LAS int* tb; const LAS int* cnt; const int* etok;
    __device__ __forceinline__ unsigned operator()(const pg8::Unit& u, int r) const {
        const int pos = (u.pm - tb[u.e]) * 256 + r; return (pos < cnt[u.e]) ? (unsigned)etok[(size_t)u.e * T + pos] : 0u;
    }
};
struct EpiMoeScatter {
    static constexpr bool PERM = false;
    float* H; const LAS int* tb; const LAS int* cnt; const int* etok; const float* ew;
    __device__ __forceinline__ void operator()(const pg8::f32x4 (&acc)[2][2][4][2], const pg8::Unit& u, int wr, int wc, int fr, int fq) const {
        const int col0 = u.pn * 256 + wc * 32 + 4 * fq; const int p0 = (u.pm - tb[u.e]) * 256, n = cnt[u.e];
#pragma unroll
        for (int ai = 0; ai < 2; ++ai)
#pragma unroll
            for (int m = 0; m < 4; ++m) { const int pos = p0 + ai * 128 + wr * 64 + m * 16 + fr;
                if (pos < n) { const int tok = etok[(size_t)u.e * T + pos]; const float w = ew[(size_t)u.e * T + pos]; float* hp = H + (size_t)tok * 1024 + col0;
#pragma unroll
                    for (int bj = 0; bj < 2; ++bj)
#pragma unroll
                        for (int nn = 0; nn < 2; ++nn)
#pragma unroll
                            for (int i = 0; i < 4; ++i) __hip_atomic_fetch_add(hp + bj * 128 + nn * 16 + i, w * acc[ai][bj][m][nn][i], RLX_AGENT); } }
    }
};

__device__ __forceinline__ void rows_to_bf16(Frame& F, const float* src, bf16* dst) {
    const GAS f32x4* ps = (const GAS f32x4*)src; GAS v2u* pd = (GAS v2u*)dst;
    for (size_t i = (size_t)F.vcu * NTHR + F.tid; i < (size_t)T * 256; i += (size_t)F.G * NTHR) { const f32x4 v = ps[i]; v2u w; w.x = pk2(v.x, v.y); w.y = pk2(v.z, v.w); pd[i] = w; }
}
__device__ __forceinline__ void moe_combine(Frame& F, const Args& a) {
    const int gw = F.vcu * NWAVES + F.wave, NGW = F.G * NWAVES, lane = F.lane;
    const LAS int* tb = (const LAS int*)(F.lds + LDSCTL_OFF);
    const int* tpos = (const int*)(a.ws + WS_MISC + MS_TPOS); const float* tw = (const float*)(a.ws + WS_MISC + MS_TW);
    const bf16* Y = (const bf16*)(a.ws + WS_Z + WS_YOFF); bf16* h2b = (bf16*)(a.ws + WS_XN);
    for (int m = gw; m < T; m += NGW) {
        const int p0 = tpos[2 * m], p1 = tpos[2 * m + 1]; const float w0 = tw[2 * m], w1 = tw[2 * m + 1];
        const size_t r0 = (size_t)tb[p0 >> 20] * 256 + (p0 & 0xfffff), r1 = (size_t)tb[p1 >> 20] * 256 + (p1 & 0xfffff);
        GAS f32x4* hp = (GAS f32x4*)(a.out + (size_t)m * 1024);
#pragma unroll
        for (int j = 0; j < 2; ++j) {
            const v4u y0 = *((const GAS v4u*)(Y + r0 * 1024) + lane + 64 * j), y1 = *((const GAS v4u*)(Y + r1 * 1024) + lane + 64 * j);
            f32x4 ha = hp[2 * (lane + 64 * j)], hb = hp[2 * (lane + 64 * j) + 1];
            ha.x = (ha.x + w0 * bflo(y0.x)) + w1 * bflo(y1.x); ha.y = (ha.y + w0 * bfhi(y0.x)) + w1 * bfhi(y1.x); ha.z = (ha.z + w0 * bflo(y0.y)) + w1 * bflo(y1.y); ha.w = (ha.w + w0 * bfhi(y0.y)) + w1 * bfhi(y1.y);
            hb.x = (hb.x + w0 * bflo(y0.z)) + w1 * bflo(y1.z); hb.y = (hb.y + w0 * bfhi(y0.z)) + w1 * bfhi(y1.z); hb.z = (hb.z + w0 * bflo(y0.w)) + w1 * bflo(y1.w); hb.w = (hb.w + w0 * bfhi(y0.w)) + w1 * bfhi(y1.w);
            hp[2 * (lane + 64 * j)] = ha; hp[2 * (lane + 64 * j) + 1] = hb;
            *((GAS v4u*)(h2b + (size_t)m * 1024) + lane + 64 * j) = (v4u){pk2(ha.x, ha.y), pk2(ha.z, ha.w), pk2(hb.x, hb.y), pk2(hb.z, hb.w)};
        }
    }
}
__device__ __forceinline__ void rows_sumsq(Frame& F, const bf16* P, float* rowss) {
    const int gw = F.vcu * NWAVES + F.wave, NGW = F.G * NWAVES;
    for (int m = gw; m < T; m += NGW) { float s = 0.f;
#pragma unroll
        for (int j = 0; j < 2; ++j) { const v4u x = *((const GAS v4u*)(P + (size_t)m * 1024) + F.lane + 64 * j);
            const float a0 = bflo(x.x), a1 = bfhi(x.x), a2 = bflo(x.y), a3 = bfhi(x.y), a4 = bflo(x.z), a5 = bfhi(x.z), a6 = bflo(x.w), a7 = bfhi(x.w);
            s += (a0 * a0 + a1 * a1) + (a2 * a2 + a3 * a3) + (a4 * a4 + a5 * a5) + (a6 * a6 + a7 * a7); }
        s = wave_sum(s); if (F.lane == 0) rowss[m] = s; }
}
__device__ __forceinline__ void rows_rms_to_bf16(Frame& F, const float* src, const float* gain, bf16* dst) {
    const int gw = F.vcu * NWAVES + F.wave, NGW = F.G * NWAVES;
    for (int m = gw; m < T; m += NGW) rms_row_to_bf16(src + (size_t)m * D, gain, dst + (size_t)m * D, F.lane);
}

enum { PH_A = 0, PH_B, PH_C, PH_D, PH_E, PH_F, PH_H, PH_I, PH_J, PH_K, PH_L, NPH };
#ifndef MK_PHMASK
#define MK_PHMASK 0xFFFF
#endif
#define PHON(p) ((MK_PHMASK >> (p)) & 1)
#ifndef MK_SKIP_SEQ
#define MK_SKIP_SEQ 0
#endif
#ifndef MK_H_PART
#define MK_H_PART 3
#endif
#ifndef MK_SKIP_ATTN
#define MK_SKIP_ATTN 0
#endif
#ifndef MK_SKIP_HGRN
#define MK_SKIP_HGRN 0
#endif
__global__ void __launch_bounds__(NTHR, 2) mk_fwd(Args args) {
    extern __shared__ __attribute__((aligned(16))) unsigned char lds_raw[];
    Frame F;
    F.lds = (LAS unsigned char*)lds_raw; F.MISC = (volatile LAS unsigned*)(F.lds + MISC_OFF);
    F.tid = threadIdx.x; F.lane = F.tid & 63; F.wave = __builtin_amdgcn_readfirstlane(F.tid >> 6);
    F.G = gridDim.x; { const int bx = blockIdx.x; F.vcu = (F.G % 8 == 0) ? (bx % 8) * (F.G / 8) + bx / 8 : bx; }
    unsigned char* ws = args.ws;
    F.ctl = (unsigned*)(ws + WS_CTL);
    for (int u = F.tid; u < (LDS_BYTES - LDSCTL_OFF) / 4; u += NTHR) ((LAS unsigned*)(F.lds + LDSCTL_OFF))[u] = 0u;
    __syncthreads();
    XcdBarrier bar = xcd_barrier_post(F.ctl + CW_BAR, F.MISC + 8);
    const int lo = args.ph_lo, hi = args.ph_hi;
#define IN(k) (lo <= (k) && (k) < hi)
#define PHB() do { const int t_ = opaque_tid(); F.tid = t_; F.lane = t_ & 63; F.wave = __builtin_amdgcn_readfirstlane(t_ >> 6); } while (0)
#define SEAM(k) do { if ((k) + 1 < hi) xcd_barrier(bar); } while (0)
    if (PHON(15) && IN(0)) { PHB(); p0_prologue(F, args); SEAM(0); }
    for (int layer = 0; layer < 2; ++layer) {
        const int g0 = 1 + layer * NPH;
        bf16* zbase = (bf16*)(ws + WS_Z);
        if (PHON(PH_A) && IN(g0 + PH_A)) { PHB();
            pg8::Gemm g{(const pg8::bf16_t*)(ws + WS_XN), (const pg8::bf16_t*)(ws + WS_WIN) + (size_t)layer * 3584 * 1024, 1024, 0};
            pg8::StaticOrder S; S.init(T, 3584, F.G, (int)blockIdx.x);
            pg8::EpiBf16 E{zbase, 512, 512, (size_t)T * 512};
            pg8::gemm_phase<pg8::EpiBf16, pg8::StaticOrder, pg8::RowIdent, true>(F.lds + RING_OFF, g, S, E, pg8::RowIdent{});
            SEAM(g0 + PH_A);
        }
        if (PHON(PH_B) && IN(g0 + PH_B)) { PHB();
            if (!MK_SKIP_ATTN) qk_norm_rows(F, zbase + (size_t)4 * T * 512, zbase + (size_t)5 * T * 512, args.in[I_QN] + layer * 64, args.in[I_KN] + layer * 64);
            if (!MK_SKIP_HGRN) hgrn_b1_phase(F, args, layer);
            SEAM(g0 + PH_B);
        }
        if (PHON(PH_C) && IN(g0 + PH_C)) { PHB();
            if (!MK_SKIP_HGRN && !MK_SKIP_SEQ) { hgrn_seq_phase(F, args); VM_WAIT(); __syncthreads(); }
            if (!MK_SKIP_ATTN) {
                const attn_body::AttnTensors AT{(const attn_body::bf16*)(zbase + (size_t)4 * T * 512), (const attn_body::bf16*)(zbase + (size_t)5 * T * 512), (const attn_body::bf16*)(zbase + (size_t)6 * T * 512), (attn_body::bf16*)(ws + WS_OA)};
                attn_body::attn_phase<8>((char*)lds_raw + RING_OFF, AT, F.vcu, F.G);
            }
            SEAM(g0 + PH_C);
        }
        if (PHON(PH_D) && IN(g0 + PH_D)) { PHB(); mix_finalize(F, args, layer); SEAM(g0 + PH_D); }
        if (PHON(PH_E) && IN(g0 + PH_E)) { PHB();
            pg8::Gemm g{(const pg8::bf16_t*)(zbase + (size_t)4 * T * 512), (const pg8::bf16_t*)(ws + WS_WOUT) + (size_t)layer * 1024 * 1024, 1024, 0};
            pg8::StaticOrder S; S.init(T, 1024, F.G, (int)blockIdx.x);
            pg8::EpiResF32 E{layer == 0 ? args.in[I_X] : args.out, args.out};
            pg8::gemm_phase<pg8::EpiResF32, pg8::StaticOrder, pg8::RowIdent, true>(F.lds + RING_OFF, g, S, E, pg8::RowIdent{});
            SEAM(g0 + PH_E);
        }
        if (PHON(PH_F) && IN(g0 + PH_F)) { PHB(); router_phase(F, args, layer); SEAM(g0 + PH_F); }
        if (PHON(PH_H) && IN(g0 + PH_H)) { PHB();
            moe_table(F, layer);
            const LAS int* tb = (const LAS int*)(F.lds + LDSCTL_OFF);
            if (MK_H_PART & 1) {
                pg8::Gemm g{(const pg8::bf16_t*)(ws + WS_XN), (const pg8::bf16_t*)(ws + WS_WGU) + (size_t)layer * 16 * 1024 * 1024, 1024, (size_t)1024 * 1024 * 2};
                MoeOrder S{tb, F.G, F.vcu}; MoeGather RM{tb, tb + 20, (const int*)(ws + WS_MISC + MS_ETOK)};
                pg8::EpiSiluMul E{(pg8::bf16_t*)zbase};
                pg8::gemm_phase<pg8::EpiSiluMul, MoeOrder, MoeGather, true>(F.lds + RING_OFF, g, S, E, RM);
            }
            if (MK_H_PART & 2) {
                pg8::Gemm g{(const pg8::bf16_t*)(ws + WS_MISC + MS_PB), (const pg8::bf16_t*)(ws + WS_WPP) + (size_t)layer * 1024 * 256, 256, 0};
                pg8::StaticOrder S; S.init(T, 1024, F.G, (int)blockIdx.x);
                pg8::EpiBf16 E{(pg8::bf16_t*)(ws + WS_OA), 1024, 0, 0};
                pg8::gemm_phase<pg8::EpiBf16, pg8::StaticOrder, pg8::RowIdent, true>(F.lds + RING_OFF, g, S, E, pg8::RowIdent{});
            }
            SEAM(g0 + PH_H);
        }
        if (PHON(PH_I) && IN(g0 + PH_I)) { PHB();
            moe_table(F, layer);
            const LAS int* tb = (const LAS int*)(F.lds + LDSCTL_OFF);
            pg8::Gemm g{(const pg8::bf16_t*)zbase, (const pg8::bf16_t*)(ws + WS_WDN) + (size_t)layer * 16 * 1024 * 512, 512, (size_t)1024 * 512 * 2};
            MoeOrder S{tb, F.G, F.vcu};
            pg8::EpiBf16 E{(pg8::bf16_t*)(ws + WS_Z + WS_YOFF), 1024, 0, 0};
            pg8::gemm_phase<pg8::EpiBf16, MoeOrder, pg8::RowIdent, true>(F.lds + RING_OFF, g, S, E, pg8::RowIdent{});
            SEAM(g0 + PH_I);
        }
        if (PHON(PH_J) && IN(g0 + PH_J)) { PHB(); moe_table(F, layer);
            moe_combine(F, args); rows_sumsq(F, (const bf16*)(ws + WS_OA), (float*)(F.ctl + CW_ROWSS) + (size_t)layer * T); SEAM(g0 + PH_J); }
        if (PHON(PH_K) && IN(g0 + PH_K)) { PHB();
            pg8::Gemm g{(const pg8::bf16_t*)(ws + WS_XN), (const pg8::bf16_t*)(ws + WS_WPG) + (size_t)layer * 1024 * 1024, 1024, 0};
            pg8::StaticOrder S; S.init(T, 1024, F.G, (int)blockIdx.x);
            pg8::EpiPleGate E{args.out, (const pg8::bf16_t*)(ws + WS_OA), (const float*)(F.ctl + CW_ROWSS) + (size_t)layer * T, args.in[I_PLEN] + layer * 1024};
            pg8::gemm_phase<pg8::EpiPleGate, pg8::StaticOrder, pg8::RowIdent, true>(F.lds + RING_OFF, g, S, E, pg8::RowIdent{});
            SEAM(g0 + PH_K);
        }
        if (PHON(PH_L) && IN(g0 + PH_L)) { PHB(); if (layer == 0) rows_rms_to_bf16(F, args.out, args.in[I_MIXN] + 1024, (bf16*)(ws + WS_XN)); SEAM(g0 + PH_L); }
    }
#undef IN
#undef SEAM
}
constexpr int N_PHASES = 1 + 2 * NPH;

static int launch_mk(void* const* d_in, void* d_out, void* d_ws, size_t ws_size, hipStream_t stream, int ph_lo, int ph_hi, bool do_memset) {
    static int grid = 0;
    if (grid == 0) {
        if (ws_size < WS_END) { fprintf(stderr, "kernel_launch: workspace too small (%zu < %zu)\n", ws_size, (size_t)WS_END); grid = -1; return -1; }
        int dev = 0, cus = 0, per_cu = 0;
        if (hipGetDevice(&dev) != hipSuccess || hipDeviceGetAttribute(&cus, hipDeviceAttributeMultiprocessorCount, dev) != hipSuccess) { grid = -1; return -1; }
        if (hipFuncSetAttribute((const void*)mk_fwd, hipFuncAttributeMaxDynamicSharedMemorySize, LDS_BYTES) != hipSuccess) { fprintf(stderr, "kernel_launch: hipFuncSetAttribute failed\n"); grid = -1; return -1; }
        if (hipOccupancyMaxActiveBlocksPerMultiprocessor(&per_cu, (const void*)mk_fwd, NTHR, LDS_BYTES) != hipSuccess || per_cu < 1) fprintf(stderr, "kernel_launch: occupancy query reports %d blocks per CU\n", per_cu);
        (void)hipGetLastError();
        grid = cus;
    }
    if (grid < 0) return -1;
    if (do_memset) (void)hipMemsetAsync((char*)d_ws + WS_CTL, 0, CTL_ZERO_BYTES, stream);
    Args a{};
    for (int i = 0; i < 22; ++i) a.in[i] = (const float*)d_in[i];
    a.out = (float*)d_out; a.ws = (unsigned char*)d_ws; a.ph_lo = ph_lo; a.ph_hi = ph_hi;
    hipLaunchKernelGGL(mk_fwd, dim3(grid), dim3(NTHR), LDS_BYTES, stream, a);
    return 0;
}
}

#ifndef CUT_LAYER
#define CUT_LAYER 2
#endif
#ifndef CUT_STAGE
#define CUT_STAGE 0
#endif
#ifndef PH_HI
#define PH_HI 23
#endif
extern "C" void kernel_launch(void* const* d_in, const int* in_sizes, int n_in, void* d_out, int out_size, void* d_ws, size_t ws_size, hipStream_t stream) {
    if (ws_size < WS_END) { fprintf(stderr, "ws too small: %zu\n", ws_size); return; }
    hy::In I; const float** pp = (const float**)&I; for (int i = 0; i < 22; ++i) pp[i] = (const float*)d_in[i];
    if (mk::launch_mk(d_in, d_out, d_ws, ws_size, stream, 0, PH_HI, true) != 0) return;
    hy::run_naive(I, (float*)d_out, (unsigned char*)d_ws, stream, CUT_LAYER, CUT_STAGE);
}
```

```cpp
#include <hip/hip_runtime.h>
#include <hip/hip_bf16.h>
#include <cstdio>
#include <cstdint>
#include <cmath>

constexpr size_t MiB_ = 1u << 20;
constexpr size_t WS_CTL = 0, CTL_ZERO_BYTES = 64 * 1024;
constexpr size_t WS_WIN = 1 * MiB_;
constexpr size_t WS_WOUT = 15 * MiB_;
constexpr size_t WS_WGU = 19 * MiB_;
constexpr size_t WS_WDN = 83 * MiB_;
constexpr size_t WS_WPP = 115 * MiB_;
constexpr size_t WS_WPG = 116 * MiB_;
constexpr int MK_T = 16384, MK_NB = 4, MK_TFULL = 32768;
constexpr size_t WS_GSTRIDE = 196 * MiB_;
constexpr size_t WS_Z = 120 * MiB_;
constexpr size_t ZSLOT = 16 * MiB_;
constexpr size_t WS_XN = 232 * MiB_;
constexpr size_t WS_OA = 264 * MiB_;
constexpr size_t WS_MISC = 296 * MiB_;
constexpr size_t WS_END = 512 * MiB_;


__device__ __forceinline__ int opaque_tid() { int t = threadIdx.x; asm volatile("" : "+v"(t)); return t; }
namespace pg8 {
#define PG8_LAS __attribute__((address_space(3)))
typedef unsigned short bf16_t;
typedef short bf16x8 __attribute__((ext_vector_type(8)));
typedef float f32x4 __attribute__((ext_vector_type(4)));
typedef float f32x2 __attribute__((ext_vector_type(2)));
typedef unsigned u32x4 __attribute__((ext_vector_type(4)));
typedef unsigned u32x2 __attribute__((ext_vector_type(2)));
constexpr int BM = 256, BK = 64, HALF = 128, HTB = HALF * BK * 2  , STAGE_BYTES = 8 * HTB, NXCD = 8, WGM = 2;

__host__ __device__ __forceinline__ int lds_byte(int r, int c) { const int st = (r >> 4) * 2 + (c >> 5), rr = r & 15, cc = c & 31, ob = rr * 64 + cc * 2; return st * 1024 + (ob ^ (((ob >> 9) & 1) << 5)); }
__host__ __device__ __forceinline__ void stage_rc(int b, int& R, int& C) { const int st = b / 1024, sb = b % 1024, swz = sb ^ (((sb >> 9) & 1) << 5); R = (st >> 1) * 16 + swz / 64; C = (st & 1) * 32 + (swz % 64) / 2; }
__host__ __device__ __forceinline__ int perm32(int rho) { const int n = rho >> 4, i = rho & 15; return 8 * (i >> 2) + 4 * n + (i & 3); }

struct Unit { int pm, pn, e; };
struct Gemm { const bf16_t* A; const bf16_t* Bt; int K; size_t estride; };

struct StaticOrder {
    int nM, nN, nwg, G, c;
    __device__ void init(int M, int N, int G_, int c_) { nM = M / BM; nN = N / BM; nwg = nM * nN; G = G_; c = c_; }
    __device__ bool next(int i, Unit& u) const {
        const long L = (long)i * G + c; if (L >= nwg) return false;
        int wgid = (int)L; { const int q = nwg / NXCD, r = nwg % NXCD, xcd = wgid % NXCD, off = wgid / NXCD; wgid = (xcd < r ? xcd * (q + 1) : r * (q + 1) + (xcd - r) * q) + off; }
        const int nig = WGM * nN, gid = wgid / nig, fm = gid * WGM, gsz = (nM - fm) < WGM ? (nM - fm) : WGM;
        u.pm = fm + ((wgid % nig) % gsz); u.pn = (wgid % nig) / gsz; u.e = 0; return true;
    }
};
struct RowIdent { __device__ __forceinline__ unsigned operator()(const Unit& u, int r) const { return (unsigned)(u.pm * BM + r); } };

typedef __bf16 bf16x2_t __attribute__((ext_vector_type(2)));
__device__ __forceinline__ unsigned cvt_pk_bf16(float lo, float hi) { f32x2 v = {lo, hi}; bf16x2_t b = __builtin_convertvector(v, bf16x2_t); return __builtin_bit_cast(unsigned, b); }
__device__ __forceinline__ float bf_lo(unsigned w) { return __uint_as_float(w << 16); }
__device__ __forceinline__ float bf_hi(unsigned w) { return __uint_as_float(w & 0xffff0000u); }
__device__ __forceinline__ float fsigm(float x) { return __builtin_amdgcn_rcpf(1.f + __builtin_amdgcn_exp2f(-1.4426950408889634f * x)); }

struct EpiBf16 {
    static constexpr bool PERM = true;
    bf16_t* O; int ldc; int split_cols; size_t split_stride;
    __device__ __forceinline__ void operator()(const f32x4 (&acc)[2][2][4][2], const Unit& u, int wr, int wc, int fr, int fq) const {
        const int row0 = u.pm * BM + wr * 64 + fr; int colt = u.pn * BM; bf16_t* base = O;
        if (split_cols) { const int t = colt / split_cols; base += (size_t)t * split_stride; colt -= t * split_cols; }
        const int col0 = colt + wc * 32 + 8 * fq;
#pragma unroll
        for (int ai = 0; ai < 2; ++ai)
#pragma unroll
            for (int m = 0; m < 4; ++m) { bf16_t* rowp = base + (size_t)(row0 + ai * HALF + m * 16) * ldc + col0;
#pragma unroll
                for (int bj = 0; bj < 2; ++bj) { const f32x4 v0 = acc[ai][bj][m][0], v1 = acc[ai][bj][m][1];
                    u32x4 w; w.x = cvt_pk_bf16(v0[0], v0[1]); w.y = cvt_pk_bf16(v0[2], v0[3]); w.z = cvt_pk_bf16(v1[0], v1[1]); w.w = cvt_pk_bf16(v1[2], v1[3]);
                    __builtin_nontemporal_store(w, (u32x4*)(rowp + bj * HALF)); } }
    }
};
struct EpiInProjQK {
    static constexpr bool PERM = true;
    bf16_t* O; size_t split_stride; PG8_LAS float* xch;
    __device__ __forceinline__ void operator()(f32x4 (&acc)[2][2][4][2], const Unit& u, int wr, int wc, int fr, int fq) const {
        const int row0 = u.pm * BM + wr * 64 + fr; int colt = u.pn * BM; const int t = colt >> 9; bf16_t* base = O + (size_t)t * split_stride; colt -= t << 9;
        const int col0 = colt + wc * 32 + 8 * fq;
        if (t == 4 || t == 5) {
            const PG8_LAS float* gsrc = xch + 2048 + (t - 4) * 64 + (wc & 1) * 32 + 8 * fq; const float sc = (t == 4) ? 0.125f * 1.4426950408889634f : 1.f;
#pragma unroll
            for (int ai = 0; ai < 2; ++ai)
#pragma unroll
                for (int m = 0; m < 4; ++m) {
#pragma unroll
                    for (int bj = 0; bj < 2; ++bj) { const f32x4 v0 = acc[ai][bj][m][0], v1 = acc[ai][bj][m][1];
                        float ss = ((v0[0] * v0[0] + v0[1] * v0[1]) + (v0[2] * v0[2] + v0[3] * v0[3])) + ((v1[0] * v1[0] + v1[1] * v1[1]) + (v1[2] * v1[2] + v1[3] * v1[3]));
                        ss += __shfl_xor(ss, 16); ss += __shfl_xor(ss, 32);
                        if (fq == 0) xch[((ai * HALF + wr * 64 + m * 16 + fr) * 2 + bj) * 4 + wc] = ss; }
                    asm volatile("" ::: "memory"); }
            asm volatile("s_waitcnt lgkmcnt(0)" ::: "memory"); __builtin_amdgcn_s_barrier(); asm volatile("" ::: "memory");
#pragma unroll
            for (int ai = 0; ai < 2; ++ai)
#pragma unroll
                for (int m = 0; m < 4; ++m) {
#pragma unroll
                    for (int bj = 0; bj < 2; ++bj) { const PG8_LAS float* xp = xch + ((ai * HALF + wr * 64 + m * 16 + fr) * 2 + bj) * 4 + (wc & 2);
                        const float r = rsqrtf((xp[0] + xp[1]) * (1.f / 64.f) + 1e-6f) * sc; const f32x4 g0 = *(const PG8_LAS f32x4*)gsrc, g1 = *(const PG8_LAS f32x4*)(gsrc + 4);
                        acc[ai][bj][m][0] *= g0 * r; acc[ai][bj][m][1] *= g1 * r; }
                    asm volatile("" ::: "memory"); }
        }
#pragma unroll
        for (int ai = 0; ai < 2; ++ai)
#pragma unroll
            for (int m = 0; m < 4; ++m) { bf16_t* rowp = base + (size_t)(row0 + ai * HALF + m * 16) * 512 + col0;
#pragma unroll
                for (int bj = 0; bj < 2; ++bj) { const f32x4 v0 = acc[ai][bj][m][0], v1 = acc[ai][bj][m][1];
                    u32x4 w; w.x = cvt_pk_bf16(v0[0], v0[1]); w.y = cvt_pk_bf16(v0[2], v0[3]); w.z = cvt_pk_bf16(v1[0], v1[1]); w.w = cvt_pk_bf16(v1[2], v1[3]);
                    __builtin_nontemporal_store(w, (u32x4*)(rowp + bj * HALF)); }
                asm volatile("" ::: "memory"); }
    }
};
struct EpiBf16RowSS {
    static constexpr bool PERM = true;
    bf16_t* O; int ldc; float* rowss;
    __device__ __forceinline__ void operator()(const f32x4 (&acc)[2][2][4][2], const Unit& u, int wr, int wc, int fr, int fq) const {
        const int row0 = u.pm * BM + wr * 64 + fr; const int col0 = u.pn * BM + wc * 32 + 8 * fq;
#pragma unroll
        for (int ai = 0; ai < 2; ++ai)
#pragma unroll
            for (int m = 0; m < 4; ++m) { const int row = row0 + ai * HALF + m * 16; bf16_t* rowp = O + (size_t)row * ldc + col0; float ss = 0.f;
#pragma unroll
                for (int bj = 0; bj < 2; ++bj) { const f32x4 v0 = acc[ai][bj][m][0], v1 = acc[ai][bj][m][1];
                    ss += (v0[0] * v0[0] + v0[1] * v0[1]) + (v0[2] * v0[2] + v0[3] * v0[3]) + (v1[0] * v1[0] + v1[1] * v1[1]) + (v1[2] * v1[2] + v1[3] * v1[3]);
                    u32x4 w; w.x = cvt_pk_bf16(v0[0], v0[1]); w.y = cvt_pk_bf16(v0[2], v0[3]); w.z = cvt_pk_bf16(v1[0], v1[1]); w.w = cvt_pk_bf16(v1[2], v1[3]);
                    *(u32x4*)(rowp + bj * HALF) = w; }
                ss += __shfl_xor(ss, 16); ss += __shfl_xor(ss, 32);
                if (fq == 0) rowss[(size_t)row * 16 + u.pn * 4 + wc] = ss;
                asm volatile("" ::: "memory"); }
    }
};
struct EpiSiluMul {
    static constexpr bool PERM = true;
    bf16_t* O;
    const PG8_LAS int* tb; const PG8_LAS int* cnt; const float* er;
    __device__ __forceinline__ void operator()(const f32x4 (&acc)[2][2][4][2], const Unit& u, int wr, int wc, int fr, int fq) const {
        const int row0 = u.pm * BM + wr * 64 + fr; const int col0 = u.pn * HALF + wc * 32 + 8 * fq; const int p0 = (u.pm - tb[u.e]) * BM + wr * 64 + fr, n = cnt[u.e];
        float rs[2][4];
#pragma unroll
        for (int ai = 0; ai < 2; ++ai)
#pragma unroll
            for (int m = 0; m < 4; ++m) { const int pos = p0 + ai * HALF + m * 16; const float rl = er[(size_t)u.e * MK_T + pos]; rs[ai][m] = (pos < n) ? rl : 0.f; }
#pragma unroll
        for (int ai = 0; ai < 2; ++ai)
#pragma unroll
            for (int m = 0; m < 4; ++m) { bf16_t* rowp = O + (size_t)(row0 + ai * HALF + m * 16) * 512 + col0; float h[8]; const float r = rs[ai][m];
#pragma unroll
                for (int nn = 0; nn < 2; ++nn)
#pragma unroll
                    for (int i = 0; i < 4; ++i) { const float g = r * acc[ai][0][m][nn][i], up = r * acc[ai][1][m][nn][i]; h[nn * 4 + i] = g * fsigm(g) * up; }
                u32x4 w; w.x = cvt_pk_bf16(h[0], h[1]); w.y = cvt_pk_bf16(h[2], h[3]); w.z = cvt_pk_bf16(h[4], h[5]); w.w = cvt_pk_bf16(h[6], h[7]);
                *(u32x4*)rowp = w; }
    }
};
struct EpiResB {
    static constexpr bool PERM = true;
    const float* basef; const bf16_t* baseb; bf16_t* out;
    __device__ __forceinline__ void operator()(const f32x4 (&acc)[2][2][4][2], const Unit& u, int wr, int wc, int fr, int fq) const {
        const int col0 = u.pn * BM + wc * 32 + 8 * fq;
#pragma unroll
        for (int ai = 0; ai < 2; ++ai) {
            const size_t off0 = (size_t)(u.pm * BM + ai * HALF + wr * 64 + fr) * 1024 + col0;
            f32x4 b0[4][2], b1[4][2];
            if (basef) {
#pragma unroll
                for (int m = 0; m < 4; ++m)
#pragma unroll
                    for (int bj = 0; bj < 2; ++bj) { b0[m][bj] = *(const f32x4*)(basef + off0 + (size_t)m * 16 * 1024 + bj * HALF); b1[m][bj] = *(const f32x4*)(basef + off0 + (size_t)m * 16 * 1024 + bj * HALF + 4); }
            } else {
                u32x4 w[4][2];
#pragma unroll
                for (int m = 0; m < 4; ++m)
#pragma unroll
                    for (int bj = 0; bj < 2; ++bj) w[m][bj] = *(const u32x4*)(baseb + off0 + (size_t)m * 16 * 1024 + bj * HALF);
#pragma unroll
                for (int m = 0; m < 4; ++m)
#pragma unroll
                    for (int bj = 0; bj < 2; ++bj) { b0[m][bj] = (f32x4){bf_lo(w[m][bj].x), bf_hi(w[m][bj].x), bf_lo(w[m][bj].y), bf_hi(w[m][bj].y)}; b1[m][bj] = (f32x4){bf_lo(w[m][bj].z), bf_hi(w[m][bj].z), bf_lo(w[m][bj].w), bf_hi(w[m][bj].w)}; }
            }
#pragma unroll
            for (int m = 0; m < 4; ++m)
#pragma unroll
                for (int bj = 0; bj < 2; ++bj) { const f32x4 v0 = b0[m][bj] + acc[ai][bj][m][0], v1 = b1[m][bj] + acc[ai][bj][m][1];
                    u32x4 o; o.x = cvt_pk_bf16(v0[0], v0[1]); o.y = cvt_pk_bf16(v0[2], v0[3]); o.z = cvt_pk_bf16(v1[0], v1[1]); o.w = cvt_pk_bf16(v1[2], v1[3]);
                    *(u32x4*)(out + off0 + (size_t)m * 16 * 1024 + bj * HALF) = o; }
            asm volatile("" ::: "memory");
        }
    }
};
struct EpiScatter {
    static constexpr bool PERM = false;
    float* H; const int* row_tok; const float* row_w;
    __device__ __forceinline__ void operator()(const f32x4 (&acc)[2][2][4][2], const Unit& u, int wr, int wc, int fr, int fq) const {
        const int col0 = u.pn * BM + wc * 32 + 4 * fq;
#pragma unroll
        for (int ai = 0; ai < 2; ++ai)
#pragma unroll
            for (int m = 0; m < 4; ++m) { const int sr = u.pm * BM + ai * HALF + wr * 64 + m * 16 + fr; const int tok = row_tok[sr]; const float w = row_w[sr];
                if (tok >= 0) { float* hp = H + (size_t)tok * 1024 + col0;
#pragma unroll
                    for (int bj = 0; bj < 2; ++bj)
#pragma unroll
                        for (int n = 0; n < 2; ++n)
#pragma unroll
                            for (int i = 0; i < 4; ++i) __hip_atomic_fetch_add(hp + bj * HALF + n * 16 + i, w * acc[ai][bj][m][n][i], __ATOMIC_RELAXED, __HIP_MEMORY_SCOPE_AGENT); } }
    }
};
struct EpiPleGate {
    static constexpr bool PERM = true;
    float* outf; bf16_t* outb; const bf16_t* B2; const bf16_t* P; const float* rowss; const float* gain;
    __device__ __forceinline__ void operator()(const f32x4 (&acc)[2][2][4][2], const Unit& u, int wr, int wc, int fr, int fq) const {
        const int col0 = u.pn * BM + wc * 32 + 8 * fq;
        f32x4 g0[2], g1[2];
#pragma unroll
        for (int bj = 0; bj < 2; ++bj) { g0[bj] = *(const f32x4*)(gain + col0 + bj * HALF); g1[bj] = *(const f32x4*)(gain + col0 + bj * HALF + 4); }
#pragma unroll
        for (int ai = 0; ai < 2; ++ai) {
            const int row0 = u.pm * BM + ai * HALF + wr * 64 + fr; const size_t off0 = (size_t)row0 * 1024 + col0;
            u32x4 hw[4][2], pw[4][2]; float rq[4];
#pragma unroll
            for (int m = 0; m < 4; ++m) { rq[m] = rowss[row0 + m * 16];
#pragma unroll
                for (int bj = 0; bj < 2; ++bj) { hw[m][bj] = *(const u32x4*)(B2 + off0 + (size_t)m * 16 * 1024 + bj * HALF); pw[m][bj] = *(const u32x4*)(P + off0 + (size_t)m * 16 * 1024 + bj * HALF); } }
#pragma unroll
            for (int m = 0; m < 4; ++m) { const float rstd = rsqrtf(rq[m] * (1.f / 1024.f) + 1e-6f);
#pragma unroll
                for (int bj = 0; bj < 2; ++bj) { const size_t off = off0 + (size_t)m * 16 * 1024 + bj * HALF; const u32x4 h = hw[m][bj], p = pw[m][bj]; const f32x4 a0 = acc[ai][bj][m][0], a1 = acc[ai][bj][m][1];
                    f32x4 o0, o1;
                    o0[0] = bf_lo(h.x) + bf_lo(p.x) * rstd * g0[bj][0] * fsigm(a0[0]); o0[1] = bf_hi(h.x) + bf_hi(p.x) * rstd * g0[bj][1] * fsigm(a0[1]);
                    o0[2] = bf_lo(h.y) + bf_lo(p.y) * rstd * g0[bj][2] * fsigm(a0[2]); o0[3] = bf_hi(h.y) + bf_hi(p.y) * rstd * g0[bj][3] * fsigm(a0[3]);
                    o1[0] = bf_lo(h.z) + bf_lo(p.z) * rstd * g1[bj][0] * fsigm(a1[0]); o1[1] = bf_hi(h.z) + bf_hi(p.z) * rstd * g1[bj][1] * fsigm(a1[1]);
                    o1[2] = bf_lo(h.w) + bf_lo(p.w) * rstd * g1[bj][2] * fsigm(a1[2]); o1[3] = bf_hi(h.w) + bf_hi(p.w) * rstd * g1[bj][3] * fsigm(a1[3]);
                    if (outf) { __builtin_nontemporal_store(o0, (f32x4*)(outf + off)); __builtin_nontemporal_store(o1, (f32x4*)(outf + off + 4)); }
                    else { u32x4 w; w.x = cvt_pk_bf16(o0[0], o0[1]); w.y = cvt_pk_bf16(o0[2], o0[3]); w.z = cvt_pk_bf16(o1[0], o1[1]); w.w = cvt_pk_bf16(o1[2], o1[3]); *(u32x4*)(outb + off) = w; } } }
            asm volatile("" ::: "memory");
        }
    }
};

template <class Epi, class Sched, class RowMap, bool ALIGN_EPI>
__device__ __forceinline__ void gemm_phase(PG8_LAS unsigned char* lds, const Gemm g, const Sched& S, const Epi& E, const RowMap& RM) {
    const int tid = opaque_tid(), wid = __builtin_amdgcn_readfirstlane(tid >> 6), lane = tid & 63, wr = wid >> 2, wc = wid & 3, fr = lane & 15, fq = lane >> 4;
    const int K = g.K, nt = K / BK;
    int Ra[2], Ca[2]; unsigned voffB[2];
#pragma unroll
    for (int i = 0; i < 2; ++i) { int R, C; stage_rc(tid * 16 + i * 8192, R, C); const int Rb = Epi::PERM ? ((R & ~31) + perm32(R & 31)) : R; Ra[i] = R; Ca[i] = C; voffB[i] = (unsigned)(Rb * K + C) * 2u; }
    constexpr unsigned kstep = BK * 2;
    const unsigned hstep = (unsigned)HALF * (unsigned)K * 2u;
    const unsigned tstep = 2u * hstep;
    const unsigned ldsw = (unsigned)wid * 1024u;
    const int aoff = lds_byte(wr * 64 + fr, fq * 8), boff = lds_byte(wc * 32 + fr, fq * 8);
#define PG8_SA(b, h) (((b) * 2 + (h)) * HTB)
#define PG8_SB(b, h) ((4 + (b) * 2 + (h)) * HTB)
#define PG8_STAGE(bufoff, gbase, uoff, voff) do { _Pragma("unroll") for (int _i = 0; _i < 2; ++_i) \
        __builtin_amdgcn_global_load_lds((const unsigned*)((gbase) + (size_t)((uoff) + (voff)[_i])), (PG8_LAS unsigned*)(lds + (bufoff) + ldsw + _i * 8192), 16, 0, 0); } while (0)
#define PG8_MKOFF(dst, U) do { _Pragma("unroll") for (int _h = 0; _h < 2; ++_h) _Pragma("unroll") for (int _i = 0; _i < 2; ++_i) dst[_h][_i] = (RM(U, _h * HALF + Ra[_i]) * (unsigned)K + (unsigned)Ca[_i]) * 2u; } while (0)
#define PG8_LDA(dst, b, h) do { _Pragma("unroll") for (int m = 0; m < 4; ++m) _Pragma("unroll") for (int k = 0; k < 2; ++k) dst[m][k] = *(const PG8_LAS bf16x8*)(lds + PG8_SA(b, h) + aoff + m * 2048 + k * 1024); } while (0)
#define PG8_LDB(dst, b, h) do { _Pragma("unroll") for (int n = 0; n < 2; ++n) _Pragma("unroll") for (int k = 0; k < 2; ++k) dst[n][k] = *(const PG8_LAS bf16x8*)(lds + PG8_SB(b, h) + boff + n * 2048 + k * 1024); } while (0)
#define PG8_MMA(ai, bj, At, Bt) do { __builtin_amdgcn_s_setprio(1); _Pragma("unroll") for (int m = 0; m < 4; ++m) _Pragma("unroll") for (int n = 0; n < 2; ++n) _Pragma("unroll") for (int k = 0; k < 2; ++k) \
        acc[ai][bj][m][n] = __builtin_amdgcn_mfma_f32_16x16x32_bf16(Bt[n][k], At[m][k], acc[ai][bj][m][n], 0, 0, 0); __builtin_amdgcn_s_setprio(0); } while (0)
#define PG8_WAIT_V(n) asm volatile("s_waitcnt vmcnt(" #n ")" ::: "memory")
#define PG8_WAIT_L(n) asm volatile("s_waitcnt lgkmcnt(" #n ")" ::: "memory")
#define PG8_BAR __builtin_amdgcn_s_barrier()
#define PG8_SCHED __builtin_amdgcn_sched_barrier(0)
    Unit cur, nxt; int ui = 0;
    if (!S.next(0, cur)) return;
    f32x4 acc[2][2][4][2];
#pragma unroll
    for (int a = 0; a < 2; ++a)
#pragma unroll
        for (int b = 0; b < 2; ++b)
#pragma unroll
            for (int m = 0; m < 4; ++m)
#pragma unroll
                for (int n = 0; n < 2; ++n) acc[a][b][m][n] = (f32x4){0.f, 0.f, 0.f, 0.f};
    bf16x8 At[4][2], B0[2][2], B1[2][2];
    unsigned ao[2][2], no[2][2];
    PG8_MKOFF(ao, cur);
    const char* const gA = (const char*)g.A; const char* const gB = (const char*)g.Bt;
    unsigned cB = (unsigned)cur.e * (unsigned)g.estride + (unsigned)cur.pn * tstep;
    PG8_STAGE(PG8_SB(0, 0), gB, cB, voffB); PG8_STAGE(PG8_SB(0, 1), gB, cB + hstep, voffB); PG8_STAGE(PG8_SA(0, 0), gA, 0u, ao[0]); PG8_STAGE(PG8_SA(0, 1), gA, 0u, ao[1]);
    if (wr == 1) PG8_BAR;
    PG8_WAIT_V(2); PG8_BAR;
    PG8_STAGE(PG8_SB(1, 0), gB, cB + kstep, voffB); PG8_STAGE(PG8_SA(1, 0), gA, kstep, ao[0]); PG8_STAGE(PG8_SB(1, 1), gB, cB + hstep + kstep, voffB);
    PG8_WAIT_V(6); PG8_BAR;
    for (;;) {
        const bool has_next = S.next(ui + 1, nxt);
        if (has_next) { PG8_MKOFF(no, nxt); } else {
#pragma unroll
            for (int h = 0; h < 2; ++h)
#pragma unroll
                for (int i = 0; i < 2; ++i) no[h][i] = ao[h][i]; }
        const unsigned nB = has_next ? (unsigned)nxt.e * (unsigned)g.estride + (unsigned)nxt.pn * tstep : cB;
#pragma unroll 1
        for (int t = 0; t < nt; t += 2) {
            const bool last = (t == nt - 2);
            const unsigned a1 = (unsigned)(t + 1) * kstep;
            const unsigned a2 = last ? 0u : (unsigned)(t + 2) * kstep, b2 = last ? nB : cB + (unsigned)(t + 2) * kstep;
            const unsigned a3 = a2 + kstep, b3 = b2 + kstep;
            PG8_LDB(B0, 0, 0); PG8_LDB(B1, 0, 1); PG8_SCHED; PG8_LDA(At, 0, 0); PG8_STAGE(PG8_SA(1, 1), gA, a1, ao[1]);
            if (last) { _Pragma("unroll") for (int h = 0; h < 2; ++h) _Pragma("unroll") for (int i = 0; i < 2; ++i) ao[h][i] = no[h][i]; }
            PG8_WAIT_V(8); PG8_WAIT_L(0); PG8_BAR; PG8_MMA(0, 0, At, B0); PG8_MMA(0, 1, At, B1); PG8_BAR; PG8_SCHED;
            PG8_LDA(At, 0, 1); PG8_STAGE(PG8_SB(0, 0), gB, b2, voffB); PG8_STAGE(PG8_SB(0, 1), gB, b2 + hstep, voffB); PG8_STAGE(PG8_SA(0, 0), gA, a2, ao[0]);
            PG8_WAIT_V(8); PG8_WAIT_L(0); PG8_BAR; PG8_MMA(1, 0, At, B0); PG8_MMA(1, 1, At, B1); PG8_BAR; PG8_SCHED;
            PG8_LDB(B0, 1, 0); PG8_LDB(B1, 1, 1); PG8_SCHED; PG8_LDA(At, 1, 0); PG8_STAGE(PG8_SA(0, 1), gA, a2, ao[1]);
            PG8_WAIT_V(8); PG8_WAIT_L(0); PG8_BAR; PG8_MMA(0, 0, At, B0); PG8_MMA(0, 1, At, B1); PG8_BAR; PG8_SCHED;
            PG8_LDA(At, 1, 1); PG8_STAGE(PG8_SB(1, 0), gB, b3, voffB); PG8_STAGE(PG8_SB(1, 1), gB, b3 + hstep, voffB); PG8_STAGE(PG8_SA(1, 0), gA, a3, ao[0]);
            PG8_WAIT_V(8); PG8_WAIT_L(0); PG8_BAR; PG8_MMA(1, 0, At, B0); PG8_MMA(1, 1, At, B1); PG8_BAR; PG8_SCHED;
        }
        if constexpr (ALIGN_EPI) { if (wr == 0) PG8_BAR; }
        E(acc, cur, wr, wc, fr, fq);
        if (!has_next) break;
#pragma unroll
        for (int a = 0; a < 2; ++a)
#pragma unroll
            for (int b = 0; b < 2; ++b)
#pragma unroll
                for (int m = 0; m < 4; ++m)
#pragma unroll
                    for (int n = 0; n < 2; ++n) acc[a][b][m][n] = (f32x4){0.f, 0.f, 0.f, 0.f};
        cur = nxt; cB = nB; ++ui;
        if constexpr (ALIGN_EPI) { if (wr == 1) PG8_BAR; }
    }
    PG8_WAIT_V(0);
    if constexpr (!ALIGN_EPI) { if (wr == 0) PG8_BAR; }
    PG8_BAR;
#undef PG8_SA
#undef PG8_SB
#undef PG8_STAGE
#undef PG8_MKOFF
#undef PG8_LDA
#undef PG8_LDB
#undef PG8_MMA
#undef PG8_WAIT_V
#undef PG8_WAIT_L
#undef PG8_BAR
#undef PG8_SCHED
}
}


#include <hip/hip_bf16.h>
#include <cmath>
namespace attn_body {
using bf16=__hip_bfloat16;
using bf16x8=__attribute__((ext_vector_type(8)))short;
using s16x4=__attribute__((ext_vector_type(4)))short;
using f32x16=__attribute__((ext_vector_type(16)))float;
using u32x4=__attribute__((ext_vector_type(4)))unsigned;
constexpr int BATCH=8,SEQ=4096,D=64;
constexpr int PQ=512,PK=512,PV=512,PO=1024;
constexpr int NW=8,QBLK=32,QB=QBLK*NW,KVBLK=64,NQB=SEQ/QB;
constexpr int ATTN_UNIT_ROWS=QB;
__device__ __forceinline__ int crow(int r,int hi){return (r&3)+8*(r>>2)+4*hi;}
#define SBAR() __builtin_amdgcn_sched_barrier(0)
__device__ __forceinline__ void cmask(f32x16&p0,f32x16&p1,int jb,int qrel,int hi){
  const float NEG=-INFINITY; int kb=64*jb+4*hi;
  #pragma unroll
  for(int r=0;r<16;++r){int kv=kb+(r&3)+8*(r>>2); if(kv>qrel)p0[r]=NEG; if(kv+32>qrel)p1[r]=NEG;}
}

constexpr int NSLOT=3, SLOTB=8192;
constexpr int VSLOTB=2*SLOTB;
constexpr int LDS_K=0, LDS_V=NSLOT*SLOTB, LDS_WS=LDS_V+NSLOT*VSLOTB, LDS_OST=LDS_WS+NW*64*4, LDS_BYTES=LDS_OST+NW*4096;
constexpr float C2=0.125f*1.4426950408889634f;
__device__ __forceinline__ void glds16(const void*gsrc,unsigned lds_dst){unsigned keep;
  asm volatile("s_mov_b32 %0, m0\n\ts_mov_b32 m0, %2\n\ts_nop 0\n\tglobal_load_lds_dwordx4 %1, off\n\ts_mov_b32 m0, %0":"=&s"(keep):"v"(gsrc),"s"(lds_dst):"memory");}
__device__ __forceinline__ float max3f(float a,float b,float c){float r;asm("v_max3_f32 %0, %1, %2, %3":"=v"(r):"v"(a),"v"(b),"v"(c));return r;}
__device__ __forceinline__ float max2f(float a,float b){float r;asm("v_max_f32_e32 %0, %1, %2":"=v"(r):"v"(a),"v"(b));return r;}
__device__ __forceinline__ float fadd_s(float a,float b){float r;asm("v_add_f32_e32 %0, %1, %2":"=v"(r):"v"(a),"v"(b));return r;}
__device__ __forceinline__ float fsub_s(float a,float b){float r;asm("v_sub_f32_e32 %0, %1, %2":"=v"(r):"v"(a),"v"(b));return r;}
typedef float f32x2_t __attribute__((ext_vector_type(2))); typedef __bf16 bf16x2_t __attribute__((ext_vector_type(2)));
__device__ __forceinline__ unsigned cvtpk_s(float lo,float hi){f32x2_t v={lo,hi};bf16x2_t b=__builtin_convertvector(v,bf16x2_t);return __builtin_bit_cast(unsigned,b);}
#define WAIT_BAR(N) asm volatile("s_waitcnt vmcnt(" #N ") lgkmcnt(0)\n\ts_barrier":::"memory")

__device__ __forceinline__ void qkt(f32x16&p0,f32x16&p1,const char*Kslot,const bf16x8*qr,const f32x16&negm,int r32,int hi){
  const char*kb=Kslot+hi*1024+r32*16;
  #pragma unroll
  for(int d0=0;d0<4;++d0){
    const bf16x8 b0=*reinterpret_cast<const bf16x8*>(kb+d0*2048);
    const bf16x8 b1=*reinterpret_cast<const bf16x8*>(kb+d0*2048+512);
    if(d0==0){p0=__builtin_amdgcn_mfma_f32_32x32x16_bf16(b0,qr[0],negm,0,0,0);p1=__builtin_amdgcn_mfma_f32_32x32x16_bf16(b1,qr[0],negm,0,0,0);}
    else{p0=__builtin_amdgcn_mfma_f32_32x32x16_bf16(b0,qr[d0],p0,0,0,0);p1=__builtin_amdgcn_mfma_f32_32x32x16_bf16(b1,qr[d0],p1,0,0,0);}}
}
typedef __attribute__((address_space(3))) const char* lds_cptr;
typedef short v4i16_t __attribute__((ext_vector_type(4)));
__device__ __forceinline__ void kload8(bf16x8*kf,lds_cptr kp){
  kf[0]=*(const __attribute__((address_space(3))) bf16x8*)(kp);      kf[1]=*(const __attribute__((address_space(3))) bf16x8*)(kp+512);
  kf[2]=*(const __attribute__((address_space(3))) bf16x8*)(kp+2048); kf[3]=*(const __attribute__((address_space(3))) bf16x8*)(kp+2560);
  kf[4]=*(const __attribute__((address_space(3))) bf16x8*)(kp+4096); kf[5]=*(const __attribute__((address_space(3))) bf16x8*)(kp+4608);
  kf[6]=*(const __attribute__((address_space(3))) bf16x8*)(kp+6144); kf[7]=*(const __attribute__((address_space(3))) bf16x8*)(kp+6656);
}
__device__ __forceinline__ void kload2(bf16x8*kf,lds_cptr kp,int j){ kf[2*j]=*(const __attribute__((address_space(3))) bf16x8*)(kp+j*2048); kf[2*j+1]=*(const __attribute__((address_space(3))) bf16x8*)(kp+j*2048+512); }
__device__ __forceinline__ s16x4 vtr(lds_cptr p){ return __builtin_bit_cast(s16x4,__builtin_amdgcn_ds_read_tr16_b64_v4i16((__attribute__((address_space(3))) v4i16_t*)p)); }
__device__ __forceinline__ float rowmax(const f32x16&p0,const f32x16&p1){
  float a=max3f(p0[0],p0[1],p1[0]),b=max3f(p0[2],p0[3],p1[1]);a=max3f(a,p1[2],p1[3]);
  #pragma unroll
  for(int r=4;r<16;r+=4){a=max3f(a,p0[r],p0[r+1]);b=max3f(b,p0[r+2],p0[r+3]);a=max3f(a,p1[r],p1[r+1]);b=max3f(b,p1[r+2],p1[r+3]);}
  const float m=max2f(a,b);
  auto rr=__builtin_amdgcn_permlane32_swap(__float_as_uint(m),__float_as_uint(m),false,false);
  return max2f(__uint_as_float(rr[0]),__uint_as_float(rr[1]));
}
__device__ __forceinline__ void pv(f32x16*o,int vb,bf16x8 pa0,bf16x8 pa1,bf16x8 pa2,bf16x8 pa3){
  #pragma unroll
  for(int d0=0;d0<2;++d0){s16x4 lo[4],hi[4];
    #pragma unroll
    for(int ks=0;ks<4;++ks){
      asm volatile("ds_read_b64_tr_b16 %0,%1 offset:%c2":"=&v"(lo[ks]):"v"(vb),"i"(d0*4096+ks*1024):"memory");
      asm volatile("ds_read_b64_tr_b16 %0,%1 offset:%c2":"=&v"(hi[ks]):"v"(vb),"i"(d0*4096+ks*1024+512):"memory");}
    asm volatile("s_waitcnt lgkmcnt(0)":::"memory");SBAR();
    #define PK(k) (bf16x8){lo[k][0],lo[k][1],lo[k][2],lo[k][3],hi[k][0],hi[k][1],hi[k][2],hi[k][3]}
    o[d0]=__builtin_amdgcn_mfma_f32_32x32x16_bf16(pa0,PK(0),o[d0],0,0,0);
    o[d0]=__builtin_amdgcn_mfma_f32_32x32x16_bf16(pa1,PK(1),o[d0],0,0,0);
    o[d0]=__builtin_amdgcn_mfma_f32_32x32x16_bf16(pa2,PK(2),o[d0],0,0,0);
    o[d0]=__builtin_amdgcn_mfma_f32_32x32x16_bf16(pa3,PK(3),o[d0],0,0,0);
    #undef PK
  }
}

#ifndef ATTN_STORE16
#define ATTN_STORE16(p,v) (*(u32x4*)(p)=(v))
#endif
template<int THRL> __device__ __forceinline__ void attn_unit(int b,int qcol,int kcol,int vcol,int ocol,int qb,const bf16*Q,const bf16*__restrict__ K,const bf16*__restrict__ V,bf16*O,char*shm){
  const int tid=opaque_tid(),lane=tid&63,r32=lane&31,hi=lane>>5; const int wid=__builtin_amdgcn_readfirstlane(tid>>6);
  const long rowbase=(long)b*SEQ; const int q0=qb*QB;
  const bf16*Qw=Q+(rowbase+q0+wid*QBLK)*PQ+qcol;
  const bf16*Kh=K+rowbase*PK+kcol,*Vh=V+rowbase*PV+vcol;
  const unsigned lds0=(unsigned)(uintptr_t)shm;
  float*wsf=(float*)(shm+LDS_WS)+wid*64;
  const bf16*ksrc=Kh+(long)lane*PK+wid*8;
  const bf16*vsrc=Vh+(long)(16*(wid&3)+(lane>>2))*PV+(wid>>2)*32+(lane&3)*8;
  const unsigned kdst=lds0+LDS_K+wid*1024, vdst=lds0+LDS_V+wid*1024;
  #define DMA_K(t,slot) glds16(ksrc+(long)(t)*KVBLK*PK,(unsigned)__builtin_amdgcn_readfirstlane(kdst+(slot)))
  #define DMA_V(t,slot) do{ glds16(vsrc+(long)(t)*KVBLK*PV,(unsigned)__builtin_amdgcn_readfirstlane(vdst+2*(slot))); glds16(vsrc+64+(long)(t)*KVBLK*PV,(unsigned)__builtin_amdgcn_readfirstlane(vdst+8192+2*(slot))); }while(0)
  const int vb0=(int)(lds0+LDS_V)+((lane>>4)&1)*32+(lane&3)*8+(4*hi+((lane&15)>>2))*64;
  const char*Kbase=shm+LDS_K; bf16x8 kf[8];
  const lds_cptr shm3=(lds_cptr)shm; const lds_cptr kp0=shm3+LDS_K+hi*1024+r32*16; const lds_cptr vp0=shm3+LDS_V+((lane>>4)&1)*32+(lane&3)*8+(4*hi+((lane&15)>>2))*64;
  const int NT=(q0+QB)/KVBLK;
  DMA_K(0,0);DMA_V(0,0);DMA_K(1,SLOTB);
  bf16x8 qr[4];
  #pragma unroll
  for(int d0=0;d0<4;++d0)qr[d0]=*reinterpret_cast<const bf16x8*>(&Qw[(long)r32*PQ+d0*16+hi*8]);
  const lds_cptr qpark=shm3+LDS_OST+wid*4096+r32*128;
  #define QOFF(d0) ((((d0)*2+hi)^(r32&7))*16)
  #define QF(d0) (*(const __attribute__((address_space(3))) bf16x8*)(qpark+QOFF(d0)))
  _Pragma("unroll") for(int d0=0;d0<4;++d0) *(__attribute__((address_space(3))) bf16x8*)((__attribute__((address_space(3))) char*)qpark+QOFF(d0))=qr[d0];
  float mhat=0.f,l_reg=0.f;f32x16 o[4];o[0]=f32x16{};o[1]=f32x16{};o[2]=f32x16{};o[3]=f32x16{};f32x16 negm=f32x16{};asm volatile("":"+v"(negm));
  const int qrel=wid*QBLK+r32;
  #define CMASK(P0,P1,t) do{int jb_=(t)-(NT-4); if(jb_>=0)cmask(P0,P1,jb_,qrel,hi);}while(0)
  bool resc=false;
  #define START(P0,P1) do{ const float rm=rowmax(P0,P1); resc=false; \
    { const float dl=rm; mhat=fadd_s(mhat,dl); \
      _Pragma("unroll") for(int r=0;r<16;++r){P0[r]=fsub_s(P0[r],dl);P1[r]=fsub_s(P1[r],dl);} \
      _Pragma("unroll") for(int r=0;r<16;++r)negm[r]=-mhat; asm volatile("":"+v"(negm)); } \
    _Pragma("unroll") for(int r=0;r<16;++r)P0[r]=__builtin_amdgcn_exp2f(P0[r]); }while(0)
  #define RESC() do{ if(resc){ asm volatile("s_waitcnt lgkmcnt(0)":::"memory"); \
      _Pragma("unroll") for(int d_=0;d_<4;++d_) _Pragma("unroll") for(int r=0;r<16;++r)o[d_][r]*=wsf[crow(r,hi)]; } }while(0)
  f32x16 pA0,pA1,pB0,pB1;
  int sl_prev=0,sl_cur=0,sl_next=SLOTB;
  #define ROT() do{sl_prev=sl_cur;sl_cur=sl_next;sl_next=(sl_next==(NSLOT-1)*SLOTB)?0:sl_next+SLOTB;}while(0)
  DMA_K(2,2*SLOTB);
  WAIT_BAR(4);
  qkt(pA0,pA1,Kbase,qr,negm,r32,hi);asm volatile("s_nop 15\n\ts_nop 7":"+v"(pA0),"+v"(pA1));CMASK(pA0,pA1,0);
  START(pA0,pA1);
  _Pragma("unroll") for(int r=0;r<16;++r)pA1[r]=__builtin_amdgcn_exp2f(pA1[r]);
  WAIT_BAR(0);
  DMA_K(3,0);DMA_V(1,SLOTB);
  ROT();
  kload8(kf,kp0+sl_cur);
  WAIT_BAR(3);
  s16x4 vAlo,vAhi,vBlo,vBhi,vClo,vChi; u32x4 pw0,pw1,pw2,pw3;
  #define PKW(P,B) cvtpk_s(P[B],P[B+1])
  #define PAF(k) __builtin_bit_cast(bf16x8,pw##k)
  #define PIN(x) asm volatile("":"+v"(x))
  #define MX3(a,b,c) __builtin_fmaxf(__builtin_fmaxf((a),(b)),(c))
  #define GAPA(MF,A0,A1,A2,A3,W0,W1,PW) do{ MF; sacc+=A0; sacc+=A1; sacc+=A2; sacc+=A3; PIN(sacc); W0; W1; PIN(PW); SBAR(); }while(0)
  #define EX(v) __builtin_amdgcn_exp2f(v)
  #define VLD(bf,db,k) do{ bf##lo=vtr(vp_+((db)*4096+(k)*1024)); bf##hi=vtr(vp_+((db)*4096+(k)*1024+512)); }while(0)
  #define VF(bf) (bf16x8){bf##lo[0],bf##lo[1],bf##lo[2],bf##lo[3],bf##hi[0],bf##hi[1],bf##hi[2],bf##hi[3]}
  #define PVS(cur,nxt,db,k,ndb,nk,X,B) do{ VLD(nxt,ndb,nk); o[db]=__builtin_amdgcn_mfma_f32_32x32x16_bf16(PAF(k),VF(cur),o[db],0,0,0); X[B]=EX(X[B]); X[B+1]=EX(X[B+1]); PIN(X); SBAR(); }while(0)
  #define PVL(cur,db,k,X,B) do{ o[db]=__builtin_amdgcn_mfma_f32_32x32x16_bf16(PAF(k),VF(cur),o[db],0,0,0); X[B]=EX(X[B]); X[B+1]=EX(X[B+1]); PIN(X); SBAR(); }while(0)
  #define KRD(G,j) do{ if(G){ kload2(kf,kp0+sl_next,j); SBAR(); } }while(0)
  #define STEP(C0,C1,P0,P1,t,GK,GV,GL) do{ SBAR(); \
    const lds_cptr vp_=vp0+2*sl_prev; \
    bf16x8 qa_=qr[0]; SBAR(); float sacc=(P0[0]+P0[1]); \
    GAPA(C0=__builtin_amdgcn_mfma_f32_32x32x16_bf16(kf[0],qa_,negm,0,0,0), P0[2],P0[3],P0[4],P0[5],     pw0[0]=PKW(P0,0), pw0[1]=PKW(P0,2), pw0); \
    GAPA(C1=__builtin_amdgcn_mfma_f32_32x32x16_bf16(kf[1],qa_,negm,0,0,0), P0[6],P0[7],P0[8],P0[9],     pw0[2]=PKW(P0,4), pw0[3]=PKW(P0,6), pw0); \
    qa_=qr[1]; SBAR(); GAPA(C0=__builtin_amdgcn_mfma_f32_32x32x16_bf16(kf[2],qa_,C0,0,0,0),   P0[10],P0[11],P0[12],P0[13], pw1[0]=PKW(P0,8), pw1[1]=PKW(P0,10), pw1); \
    GAPA(C1=__builtin_amdgcn_mfma_f32_32x32x16_bf16(kf[3],qa_,C1,0,0,0),   P0[14],P0[15],P1[0],P1[1],   pw1[2]=PKW(P0,12),pw1[3]=PKW(P0,14), pw1); \
    qa_=qr[2]; SBAR(); GAPA(C0=__builtin_amdgcn_mfma_f32_32x32x16_bf16(kf[4],qa_,C0,0,0,0),   P1[2],P1[3],P1[4],P1[5],     pw2[0]=PKW(P1,0), pw2[1]=PKW(P1,2), pw2); \
    GAPA(C1=__builtin_amdgcn_mfma_f32_32x32x16_bf16(kf[5],qa_,C1,0,0,0),   P1[6],P1[7],P1[8],P1[9],     pw2[2]=PKW(P1,4), pw2[3]=PKW(P1,6), pw2); \
    qa_=qr[3]; VLD(vA,0,0); VLD(vB,1,0); SBAR(); GAPA(C0=__builtin_amdgcn_mfma_f32_32x32x16_bf16(kf[6],qa_,C0,0,0,0),   P1[10],P1[11],P1[12],P1[13], pw3[0]=PKW(P1,8), pw3[1]=PKW(P1,10), pw3); \
    GAPA(C1=__builtin_amdgcn_mfma_f32_32x32x16_bf16(kf[7],qa_,C1,0,0,0),   P1[14],P1[15],0.f,0.f,       pw3[2]=PKW(P1,12),pw3[3]=PKW(P1,14), pw3); \
    l_reg+=sacc; \
    if(GK){DMA_K((t)+3,sl_cur);} if(GV){DMA_V((t)+1,sl_next);} \
    CMASK(C0,C1,t); \
    { float a=MX3(C0[0],C0[1],C1[0]),b=MX3(C0[2],C0[3],C1[1]); a=MX3(a,C1[2],C1[3]); \
      _Pragma("unroll") for(int r=4;r<16;r+=4){a=MX3(a,C0[r],C0[r+1]);b=MX3(b,C0[r+2],C0[r+3]);a=MX3(a,C1[r],C1[r+1]);b=MX3(b,C1[r+2],C1[r+3]);} \
      float rm=__builtin_fmaxf(a,b); { auto rr=__builtin_amdgcn_permlane32_swap(__float_as_uint(rm),__float_as_uint(rm),false,false); rm=__builtin_fmaxf(__uint_as_float(rr[0]),__uint_as_float(rr[1])); } \
      resc=false; \
      if(__builtin_expect(__any(rm>(float)THRL),0)){ const float dl=__builtin_fmaxf(rm,0.f); mhat+=dl; \
        _Pragma("unroll") for(int r=0;r<16;++r){C0[r]-=dl;C1[r]-=dl;} \
        _Pragma("unroll") for(int r=0;r<16;++r)negm[r]=-mhat; asm volatile("":"+v"(negm)); \
        const float f=__builtin_amdgcn_exp2f(-dl); l_reg*=f; if(hi==0)wsf[r32]=f; resc=true; } } \
    SBAR(); \
    PVS(vA,vC,0,0, 2,0, C0,0); PVS(vB,vA,1,0, 3,0, C0,2); PVS(vC,vB,2,0, 0,1, C0,4); PVS(vA,vC,3,0, 1,1, C0,6); \
    KRD(GL,0); PVS(vB,vA,0,1, 2,1, C0,8); PVS(vC,vB,1,1, 3,1, C0,10); KRD(GL,1); PVS(vA,vC,2,1, 0,2, C0,12); PVS(vB,vA,3,1, 1,2, C0,14); \
    KRD(GL,2); PVS(vC,vB,0,2, 2,2, C1,0); PVS(vA,vC,1,2, 3,2, C1,2); KRD(GL,3); PVS(vB,vA,2,2, 0,3, C1,4); PVS(vC,vB,3,2, 1,3, C1,6); \
    PVS(vA,vC,0,3, 2,3, C1,8); PVS(vB,vA,1,3, 3,3, C1,10); PVL(vC,2,3, C1,12); PVL(vA,3,3, C1,14); \
    }while(0)
  int t=1;
  #undef CMASK
  #define CMASK(P0,P1,t) do{}while(0)
  for(;t+5<NT;t+=2){
    STEP(pB0,pB1,pA0,pA1,t,true,true,true);     WAIT_BAR(3); RESC(); ROT();
    STEP(pA0,pA1,pB0,pB1,t+1,true,true,true);   WAIT_BAR(3); RESC(); ROT();
  }
  #undef CMASK
  #define CMASK(P0,P1,t) do{int jb_=(t)-(NT-4); if(jb_>=0)cmask(P0,P1,jb_,qrel,hi);}while(0)
  #define ENDW(tt) do{ if((tt)+3<NT){WAIT_BAR(3);} else if((tt)+2<NT){WAIT_BAR(2);} else {WAIT_BAR(0);} }while(0)
  for(;t+1<NT;t+=2){
    STEP(pB0,pB1,pA0,pA1,t,(t+3<NT),(t+1<NT),(t+1<NT));       ENDW(t);   RESC(); ROT();
    STEP(pA0,pA1,pB0,pB1,t+1,(t+4<NT),(t+2<NT),(t+2<NT));     ENDW(t+1); RESC(); ROT();
  }
  STEP(pB0,pB1,pA0,pA1,NT-1,false,false,false); RESC();
  { float sacc=pB0[0]+pB0[1]; _Pragma("unroll") for(int r=2;r<16;++r)sacc+=pB0[r]; _Pragma("unroll") for(int r=0;r<16;++r)sacc+=pB1[r]; l_reg+=sacc;
    pw0=(u32x4){PKW(pB0,0),PKW(pB0,2),PKW(pB0,4),PKW(pB0,6)};pw1=(u32x4){PKW(pB0,8),PKW(pB0,10),PKW(pB0,12),PKW(pB0,14)};pw2=(u32x4){PKW(pB1,0),PKW(pB1,2),PKW(pB1,4),PKW(pB1,6)};pw3=(u32x4){PKW(pB1,8),PKW(pB1,10),PKW(pB1,12),PKW(pB1,14)};
    SBAR(); pv(o,vb0+2*sl_cur,PAF(0),PAF(1),PAF(2),PAF(3)); pv(o+2,vb0+2*sl_cur+8192,PAF(0),PAF(1),PAF(2),PAF(3)); }
  #undef PKW
  #undef PAF
  #undef PIN
  #undef MX3
  #undef GAPA
  #undef EX
  #undef VLD
  #undef VF
  #undef PVS
  #undef PVL
  #undef KRD
  #undef STEP
  #undef ENDW
  {auto rr=__builtin_amdgcn_permlane32_swap(__float_as_uint(l_reg),__float_as_uint(l_reg),false,false);l_reg=__uint_as_float(rr[0])+__uint_as_float(rr[1]);}
  if(hi==0)wsf[32+r32]=l_reg;asm volatile("s_waitcnt lgkmcnt(0)":::"memory");
  float rli[16];
  #pragma unroll
  for(int r=0;r<16;++r)rli[r]=__builtin_amdgcn_rcpf(wsf[32+crow(r,hi)]);
  bf16*Ow=O+(rowbase+q0+wid*QBLK)*PO+ocol;
  { bf16*stg=(bf16*)(shm+LDS_OST)+wid*2048;
    #pragma unroll
    for(int hf=0;hf<2;++hf){
      #pragma unroll
      for(int r=0;r<16;++r){const int orow=crow(r,hi);
        #pragma unroll
        for(int d0=0;d0<2;++d0)stg[orow*64+d0*32+r32]=__float2bfloat16(o[2*hf+d0][r]*rli[r]);}
      asm volatile("s_waitcnt lgkmcnt(0)":::"memory");
      #pragma unroll
      for(int i=0;i<4;++i){const int row=i*8+(lane>>3),ch=lane&7; const u32x4 v=*(const u32x4*)(stg+row*64+ch*8); ATTN_STORE16(Ow+(long)row*PO+hf*64+ch*8,v);}
      asm volatile("s_waitcnt lgkmcnt(0)":::"memory"); } }
  asm volatile("s_waitcnt lgkmcnt(0)\n\ts_barrier":::"memory");
  #undef QF
  #undef QOFF
  #undef DMA_K
  #undef DMA_V
  #undef CMASK
  #undef START
  #undef RESC
  #undef ROT
}
constexpr int ATTN_LDS_BYTES=LDS_BYTES;
struct AttnTensors { const bf16* Q; const bf16* K; const bf16* V; bf16* O; };
template<int THRL=8> __device__ __forceinline__ void attn_phase(char*lds,const AttnTensors&T,int vcu,int ncu){
  for(int w=vcu;w<MK_NB*32;w+=ncu){ const int s=w&3,bhc=w>>2,b=bhc>>3,h=(bhc>>1)&3,c=bhc&1;
    for(int i=0;i<4;++i){ const int qb=(i==0)?15-s:(i==1)?8+s:(i==2)?7-s:s;
      attn_unit<THRL>(b,h*128+c*64,h*128+c*64,h*128,c*512+h*128,qb,T.Q,T.K,T.V,T.O,lds); } }
}
#undef SBAR
#undef WAIT_BAR
}


namespace mk {
#define GAS __attribute__((address_space(1)))
#define LAS __attribute__((address_space(3)))
typedef unsigned short bf16;
typedef unsigned v4u __attribute__((ext_vector_type(4)));
typedef unsigned v2u __attribute__((ext_vector_type(2)));
typedef float f32x4 __attribute__((ext_vector_type(4)));
typedef float v2f __attribute__((ext_vector_type(2)));
typedef float f32x16 __attribute__((ext_vector_type(16)));
typedef short bf16x8 __attribute__((ext_vector_type(8)));
typedef short s16x4 __attribute__((ext_vector_type(4)));
typedef GAS unsigned gu32;
#define RLX_AGENT __ATOMIC_RELAXED, __HIP_MEMORY_SCOPE_AGENT
#define LDS_WAIT() asm volatile("s_waitcnt lgkmcnt(0)" ::: "memory")
#define VM_WAIT() asm volatile("s_waitcnt vmcnt(0)" ::: "memory")
#define LBAR() do { asm volatile("s_waitcnt lgkmcnt(0)" ::: "memory"); __builtin_amdgcn_s_barrier(); asm volatile("" ::: "memory"); } while (0)

constexpr int NWAVES = 8, NTHR = 512;
constexpr int T = MK_T, NB = MK_NB, TFULL = MK_TFULL, SEQ = 4096, D = 1024, NCH = 64;
constexpr float EPSN = 1e-6f;
constexpr int RING_OFF = 0, RING_BYTES = 131072, LDSCTL_OFF = RING_BYTES, MISC_OFF = LDSCTL_OFF + 320, LDS_BYTES = 147456;
#ifndef P0_XSHARE
#define P0_XSHARE 0
#endif
#ifndef P0_MODE
#define P0_MODE 1
#endif
constexpr int CW_FLAG = 64;
constexpr int CW_BAR = 4096;
constexpr int CW_ECNT = 12288;
constexpr int CW_ROWSS = 131072;
constexpr size_t WS_YOFF = 40 * MiB_;
constexpr size_t MS_ROWSS = 24 * MiB_;
constexpr size_t MS_ETOK = 0, MS_EW = 2 * MiB_, MS_DVEC = 4 * MiB_, MS_TPOS = 5 * MiB_, MS_TW = 6 * MiB_, MS_PB = 8 * MiB_;

__device__ __forceinline__ unsigned f2bf(float f) { unsigned u = __builtin_bit_cast(unsigned, f); return (u + 0x7fffu + ((u >> 16) & 1u)) >> 16; }
__device__ __forceinline__ unsigned pk2(float lo, float hi) { return pg8::cvt_pk_bf16(lo, hi); }
__device__ __forceinline__ float bflo(unsigned w) { return __uint_as_float(w << 16); }
__device__ __forceinline__ float bfhi(unsigned w) { return __uint_as_float(w & 0xffff0000u); }
__device__ __forceinline__ float bf1(bf16 v) { return __uint_as_float(((unsigned)v) << 16); }
__device__ __forceinline__ float wave_sum(float v) {
#pragma unroll
    for (int o = 1; o < 64; o <<= 1) v += __shfl_xor(v, o);
    return v;
}
__device__ __forceinline__ float ex2(float x) { return __builtin_amdgcn_exp2f(x); }
__device__ __forceinline__ float fexp(float x) { return __builtin_amdgcn_exp2f(1.4426950408889634f * x); }
__device__ __forceinline__ float frcp(float x) { return __builtin_amdgcn_rcpf(x); }

#define XB_TMO      128
#define XB_XCNT(j)  (256  + 64 * (j))
#define XB_XSUB(j)  (1280 + 64 * (j))
#define XB_XGEN(j)  (2304 + 64 * (j))
#define XB_TOP      3328
#define XB_TOPGEN   3392
#define XCD_BAR_WORDS 3456
#define XB_SPIN_CAP (1u << 18)
__device__ __forceinline__ unsigned xb_ld(unsigned* p)              { return __hip_atomic_load(p, __ATOMIC_RELAXED, __HIP_MEMORY_SCOPE_AGENT); }
__device__ __forceinline__ unsigned xb_add(unsigned* p, unsigned v) { return __hip_atomic_fetch_add(p, v, __ATOMIC_RELAXED, __HIP_MEMORY_SCOPE_AGENT); }
__device__ __forceinline__ unsigned xb_xcc_id() { return (unsigned)__builtin_amdgcn_s_getreg((3 << 11) | 20) & 0xFu; }
#define XB_SPIN(cond, bar) do { unsigned _sp = 0; while (cond) { __builtin_amdgcn_s_sleep(1); \
    if ((++_sp & 255u) == 0u) { if (xb_ld(&(bar)[XB_TMO])) break; if (_sp > XB_SPIN_CAP) { atomicAdd(&(bar)[XB_TMO], 1u); break; } } } } while (0)
struct XcdBarrier { unsigned* bar; unsigned x; volatile LAS unsigned* st; unsigned n; };
__device__ __forceinline__ XcdBarrier xcd_barrier_post(unsigned* bar, volatile LAS unsigned* st, unsigned n) {
    XcdBarrier b; b.bar = bar; b.x = xb_xcc_id(); b.st = st; b.n = n;
    if (threadIdx.x == 0) (void)xb_add(&bar[XB_XCNT(b.x)], 1u);
    return b;
}
__device__ __forceinline__ void xcd_barrier_complete(unsigned* bar, unsigned x, unsigned& nloc, unsigned& nx, unsigned G) {
    unsigned sum, cnt, mine, sp = 0u;
    for (;;) {
        sum = 0u; cnt = 0u; mine = 0u;
#pragma unroll
        for (unsigned j = 0; j < 16; ++j) { const unsigned c = xb_ld(&bar[XB_XCNT(j)]); sum += c; cnt += (c > 0u) ? 1u : 0u; mine = (j == x) ? c : mine; }
        if (sum == G) break;
        __builtin_amdgcn_s_sleep(1);
        if ((++sp & 255u) == 0u) { if (xb_ld(&bar[XB_TMO])) break; if (sp > XB_SPIN_CAP) { atomicAdd(&bar[XB_TMO], 1u); break; } }
    }
    nloc = mine > 0u ? mine : 1u; nx = cnt > 0u ? cnt : 1u;
}
__device__ __forceinline__ void xcd_barrier(const XcdBarrier& b) {
    asm volatile("s_waitcnt vmcnt(0)" ::: "memory");
    __syncthreads();
    if (threadIdx.x == 0) {
        unsigned* bar = b.bar;
        __builtin_amdgcn_s_waitcnt(0);
        unsigned nloc = b.st[0], nx = b.st[1];
        if (nloc == 0u) { xcd_barrier_complete(bar, b.x, nloc, nx, b.n); b.st[0] = nloc; b.st[1] = nx; }
        const unsigned old = xb_add(&bar[XB_XSUB(b.x)], 1u);
        const unsigned gen = old / nloc;
        if (old + 1u == (gen + 1u) * nloc) {
            __builtin_amdgcn_fence(__ATOMIC_RELEASE, "agent");
            asm volatile("s_waitcnt vmcnt(0)" ::: "memory");
            const unsigned og = xb_add(&bar[XB_TOP], 1u);
            const unsigned tg = og / nx;
            if (og + 1u == (tg + 1u) * nx) xb_add(&bar[XB_TOPGEN], 1u);
            else XB_SPIN(xb_ld(&bar[XB_TOPGEN]) == tg, bar);
            __builtin_amdgcn_fence(__ATOMIC_ACQUIRE, "agent");
            xb_add(&bar[XB_XGEN(b.x)], 1u);
            asm volatile("s_waitcnt vmcnt(0)" ::: "memory");
        } else {
            XB_SPIN(xb_ld(&bar[XB_XGEN(b.x)]) == gen, bar);
            __builtin_amdgcn_fence(__ATOMIC_ACQUIRE, "agent");
            asm volatile("s_waitcnt vmcnt(0)" ::: "memory");
        }
    }
    __syncthreads();
}

struct Args { const float* in[22]; float* out; unsigned char* ws; int ph_lo, ph_hi; };
struct Frame {
    LAS unsigned char* lds; volatile LAS unsigned* MISC; unsigned* ctl; int tid, lane, wave, vcu, G, g, bi;
};
enum { I_X = 0, I_P, I_MIXN, I_WIN, I_LB, I_HON, I_QN, I_KN, I_LQ1, I_LK1, I_LQ2, I_LK2, I_SUBLN, I_WOUT, I_FFNN, I_WR, I_WG, I_WU, I_WD, I_PP, I_PLEN, I_PG };

struct P0Item { const float* W; bf16* WT; const float* ks; int K, N, row_off, item; };
__device__ __forceinline__ void p0_load(const P0Item& I, int lane, f32x4 (&v)[8], float (&sc)[8]) {
    const int nblk = I.N / 32, kb = I.item / nblk, nb = I.item % nblk, k0 = 64 * kb, n0 = 32 * nb;
#pragma unroll
    for (int i = 0; i < 8; ++i) v[i] = *(const GAS f32x4*)(I.W + (size_t)(k0 + 8 * i + (lane >> 3)) * I.N + n0 + 4 * (lane & 7));
#pragma unroll
    for (int i = 0; i < 8; ++i) sc[i] = I.ks ? I.ks[k0 + 8 * i + (lane >> 3)] : 1.f;
}
__device__ __forceinline__ void p0_store(const P0Item& I, int lane, LAS float* scr, const f32x4 (&v)[8], const float (&sc)[8]) {
    const int nblk = I.N / 32, kb = I.item / nblk, nb = I.item % nblk, k0 = 64 * kb, n0 = 32 * nb;
#pragma unroll
    for (int i = 0; i < 8; ++i) { LAS float* s = scr + (8 * i + (lane >> 3)) * 33 + 4 * (lane & 7); const float ks = sc[i]; s[0] = v[i].x * ks; s[1] = v[i].y * ks; s[2] = v[i].z * ks; s[3] = v[i].w * ks; }
    LDS_WAIT(); asm volatile("" ::: "memory");
    const int c = lane & 7;
#pragma unroll
    for (int j = 0; j < 4; ++j) { const int n = (lane >> 3) + 8 * j; const LAS float* s = scr + (8 * c) * 33 + n;
        v4u o; o.x = pk2(s[0 * 33], s[1 * 33]); o.y = pk2(s[2 * 33], s[3 * 33]); o.z = pk2(s[4 * 33], s[5 * 33]); o.w = pk2(s[6 * 33], s[7 * 33]);
        *(GAS v4u*)(I.WT + (size_t)(I.row_off + n0 + n) * I.K + k0 + 8 * c) = o; }
    LDS_WAIT(); asm volatile("" ::: "memory");
}
__device__ __forceinline__ void rms_row_to_bf16(const float* xrow, const float* gain, bf16* orow, int lane) {
    const GAS f32x4* xr = (const GAS f32x4*)xrow + lane; const f32x4* gr = (const f32x4*)gain + lane;
    f32x4 v[4]; float s = 0.f;
#pragma unroll
    for (int j = 0; j < 4; ++j) { v[j] = xr[64 * j]; s += (v[j].x * v[j].x + v[j].y * v[j].y) + (v[j].z * v[j].z + v[j].w * v[j].w); }
    const float r = rsqrtf(wave_sum(s) * (1.f / 1024.f) + EPSN);
    GAS v2u* o8 = (GAS v2u*)orow + lane;
#pragma unroll
    for (int j = 0; j < 4; ++j) { const f32x4 g = gr[64 * j]; v2u w; w.x = pk2(v[j].x * r * g.x, v[j].y * r * g.y); w.y = pk2(v[j].z * r * g.z, v[j].w * r * g.w); o8[64 * j] = w; }
}
__device__ __forceinline__ void p0_prologue(Frame& F, const Args& a, unsigned char* ws) {
    LAS float* scr = (LAS float*)(F.lds + RING_OFF + F.wave * 16384);
    const int gw = F.vcu * NWAVES + F.wave, NGW = F.G * NWAVES;
    constexpr int I_IN = 1792, I_OUT = 512, I_G = 4096, I_PPJ = 128, I_PGT = 512, PER_L = I_IN + I_OUT + 3 * I_G + I_PPJ + I_PGT;
#if P0_MODE == 1
    const int it_lo = 0, it_hi = (F.g == 0) ? I_IN : 2 * PER_L - I_IN;
    auto item_of = [&](int j) { return (F.g == 0) ? j : j + I_IN; };
#else
    constexpr int NX_L = I_IN + I_OUT + I_PPJ + I_PGT, XS = P0_XSHARE;
    const int it_lo = 0, it_hi = (F.g == 0) ? 2 * (NX_L + XS) : 2 * (3 * I_G - XS);
    auto item_of = [&](int j) { if (F.g == 0) { const int l = j / (NX_L + XS), r = j % (NX_L + XS); return l * PER_L + (r < I_IN + I_OUT ? r : (r < NX_L ? r + 3 * I_G : I_IN + I_OUT + (r - NX_L))); }
        const int l = j / (3 * I_G - XS), r = j % (3 * I_G - XS); return l * PER_L + I_IN + I_OUT + XS + r; };
#endif
    auto decode = [&](int it) { P0Item I; I.ks = nullptr; I.row_off = 0;
        const int l = it / PER_L; int r = it % PER_L;
        if (r < I_IN) { I.W = a.in[I_WIN] + (size_t)l * 1024 * 3584; I.K = 1024; I.N = 3584; I.WT = (bf16*)(ws + WS_WIN) + (size_t)l * 3584 * 1024; I.item = r; return I; } r -= I_IN;
        if (r < I_OUT) { I.W = a.in[I_WOUT] + (size_t)l * 1024 * 1024; I.K = 1024; I.N = 1024; I.WT = (bf16*)(ws + WS_WOUT) + (size_t)l * 1024 * 1024; I.item = r; return I; } r -= I_OUT;
        if (r < 2 * I_G) { const int up = r / I_G; r %= I_G; const int e = r >> 8, it2 = r & 255, nb = it2 % 16, n0 = nb * 32;
            I.row_off = (n0 >> 7) * 256 + (n0 & 127) + up * 128 - n0;
            I.W = a.in[up ? I_WU : I_WG] + ((size_t)l * 16 + e) * 1024 * 512; I.K = 1024; I.N = 512; I.WT = (bf16*)(ws + WS_WGU) + ((size_t)l * 16 + e) * 1024 * 1024; I.item = it2; I.ks = a.in[I_FFNN] + l * 1024; return I; }
        r -= 2 * I_G;
        if (r < I_G) { const int e = r >> 8, it2 = r & 255; I.W = a.in[I_WD] + ((size_t)l * 16 + e) * 512 * 1024; I.K = 512; I.N = 1024; I.WT = (bf16*)(ws + WS_WDN) + ((size_t)l * 16 + e) * 1024 * 512; I.item = it2; return I; } r -= I_G;
        if (r < I_PPJ) { I.W = a.in[I_PP] + (size_t)l * 256 * 1024; I.K = 256; I.N = 1024; I.WT = (bf16*)(ws + WS_WPP) + (size_t)l * 1024 * 256; I.item = r; return I; } r -= I_PPJ;
        I.W = a.in[I_PG] + (size_t)l * 1024 * 1024; I.K = 1024; I.N = 1024; I.WT = (bf16*)(ws + WS_WPG) + (size_t)l * 1024 * 1024; I.item = r; return I; };
    { int it = it_lo + gw;
      if (it < it_hi) {
        f32x4 va[8], vb[8]; float sa[8], sb[8];
        P0Item A = decode(item_of(it)), B = A; p0_load(A, F.lane, va, sa);
        for (;;) {
            const bool nb_ = (it + NGW < it_hi); if (nb_) { B = decode(item_of(it + NGW)); p0_load(B, F.lane, vb, sb); }
            p0_store(A, F.lane, scr, va, sa); if (!nb_) break; it += NGW;
            const bool na_ = (it + NGW < it_hi); if (na_) { A = decode(item_of(it + NGW)); p0_load(A, F.lane, va, sa); }
            p0_store(B, F.lane, scr, vb, sb); if (!na_) break; it += NGW;
        } } }
    for (int m = gw; m < T; m += 2 * NGW) {
        const int m2 = (m + NGW < T) ? m + NGW : m;
        const GAS f32x4* xa = (const GAS f32x4*)(a.in[I_X] + (size_t)m * D) + F.lane; const GAS f32x4* xb = (const GAS f32x4*)(a.in[I_X] + (size_t)m2 * D) + F.lane;
        const f32x4* gr = (const f32x4*)a.in[I_MIXN] + F.lane;
        f32x4 va[4], vb[4]; float sa = 0.f, sb = 0.f;
#pragma unroll
        for (int j = 0; j < 4; ++j) { va[j] = xa[64 * j]; vb[j] = xb[64 * j]; }
#pragma unroll
        for (int j = 0; j < 4; ++j) { sa += (va[j].x * va[j].x + va[j].y * va[j].y) + (va[j].z * va[j].z + va[j].w * va[j].w); sb += (vb[j].x * vb[j].x + vb[j].y * vb[j].y) + (vb[j].z * vb[j].z + vb[j].w * vb[j].w); }
        const float ra = rsqrtf(wave_sum(sa) * (1.f / 1024.f) + EPSN), rb = rsqrtf(wave_sum(sb) * (1.f / 1024.f) + EPSN);
        GAS v2u* oa = (GAS v2u*)((bf16*)(a.ws + WS_XN) + (size_t)m * D) + F.lane; GAS v2u* ob = (GAS v2u*)((bf16*)(a.ws + WS_XN) + (size_t)m2 * D) + F.lane;
#pragma unroll
        for (int j = 0; j < 4; ++j) { const f32x4 g = gr[64 * j];
            v2u w; w.x = pk2(va[j].x * ra * g.x, va[j].y * ra * g.y); w.y = pk2(va[j].z * ra * g.z, va[j].w * ra * g.w); oa[64 * j] = w;
            v2u u; u.x = pk2(vb[j].x * rb * g.x, vb[j].y * rb * g.y); u.y = pk2(vb[j].z * rb * g.z, vb[j].w * rb * g.w); ob[64 * j] = u; }
    }
}

__device__ __forceinline__ void qk_norm_rows(Frame& F, bf16* dq, bf16* dk, const float* qg, const float* kg) {
    const int gw = F.vcu * NWAVES + F.wave, NGW = F.G * NWAVES, lane = F.lane;
    const int c0 = (lane & 7) * 8;
    float gq[8], gk[8];
#pragma unroll
    for (int j = 0; j < 8; ++j) { gq[j] = qg[c0 + j] * (0.125f * 1.4426950408889634f); gk[j] = kg[c0 + j]; }
    for (int m = gw; m < T; m += NGW) {
#pragma unroll
        for (int w = 0; w < 2; ++w) {
            GAS v4u* p = (GAS v4u*)((w ? dk : dq) + (size_t)m * 512) + lane;
            const v4u x = *p; float v[8] = {bflo(x.x), bfhi(x.x), bflo(x.y), bfhi(x.y), bflo(x.z), bfhi(x.z), bflo(x.w), bfhi(x.w)};
            float s = 0.f;
#pragma unroll
            for (int j = 0; j < 8; ++j) s += v[j] * v[j];
            s += __shfl_xor(s, 1); s += __shfl_xor(s, 2); s += __shfl_xor(s, 4);
            const float r = rsqrtf(s * (1.f / 64.f) + EPSN);
            v4u o;
            if (w == 0) { o.x = pk2(v[0] * r * gq[0], v[1] * r * gq[1]); o.y = pk2(v[2] * r * gq[2], v[3] * r * gq[3]); o.z = pk2(v[4] * r * gq[4], v[5] * r * gq[5]); o.w = pk2(v[6] * r * gq[6], v[7] * r * gq[7]); }
            else        { o.x = pk2(v[0] * r * gk[0], v[1] * r * gk[1]); o.y = pk2(v[2] * r * gk[2], v[3] * r * gk[3]); o.z = pk2(v[4] * r * gk[4], v[5] * r * gk[5]); o.w = pk2(v[6] * r * gk[6], v[7] * r * gk[7]); }
            *p = o;
        }
    }
}

#ifdef PROBE_PH
#define PROBE_SUB(id) do { if (blockIdx.x == 0 && threadIdx.x == 0) { volatile LAS unsigned long long* pw_ = (volatile LAS unsigned long long*)(F.lds + MISC_OFF + 64); const unsigned long long t_ = __builtin_amdgcn_s_memrealtime(); if ((id) == PROBE_PH) pw_[0] += t_ - pw_[1]; pw_[1] = t_; } } while (0)
#else
#define PROBE_SUB(id) do { } while (0)
#endif
constexpr int HB_QM = 0, HB_KM = 17408, HB_KET = 34816, HB_VT = 53248, HB_PART = 71680, HB_RQ = 73728, HB_RF = 90112, HB_RV = 106496;
struct B1Raw { v4u q[2], f[2], v[2]; };
__device__ __forceinline__ void b1_load_raw(B1Raw& R, int tid, int b, int h, int c, const bf16* zq, const bf16* zf, const bf16* zi) {
    const size_t rowbase = (size_t)b * SEQ + c * 64;
#pragma unroll
    for (int j = 0; j < 2; ++j) { const int i = tid + NTHR * j, row = i >> 4, seg = i & 15; const size_t off = (rowbase + row) * 512 + h * 128 + seg * 8;
        R.q[j] = *(const GAS v4u*)(zq + off); R.f[j] = *(const GAS v4u*)(zf + off); R.v[j] = *(const GAS v4u*)(zi + off); }
}
__device__ __forceinline__ void hgrn_b1_unit(Frame& F, int b, int h, int c, bf16* zq, bf16* zf, bf16* zi, bf16* Lst, bf16* dvb, float lbv, B1Raw& R, bool has_next, int nb, int nh, int nc) {
    const int tid = F.tid, lane = F.lane, wave = F.wave;
    LAS unsigned char* lds = F.lds + RING_OFF;
    PROBE_SUB(24);
    const int d = tid & 127, rg = tid >> 7, s0 = rg * 16;
    const size_t rowbase = (size_t)b * SEQ + c * 64;
#pragma unroll
    for (int j = 0; j < 2; ++j) { const int i = tid + NTHR * j, row = i >> 4, seg = i & 15;
        *(LAS v4u*)(lds + HB_RQ + row * 256 + seg * 16) = R.q[j]; *(LAS v4u*)(lds + HB_RF + row * 256 + seg * 16) = R.f[j]; *(LAS v4u*)(lds + HB_RV + row * 256 + seg * 16) = R.v[j]; }
    LBAR();
    PROBE_SUB(20);
    float q[16], kk[16], g[16];
    unsigned vraw[16];
#pragma unroll
    for (int j = 0; j < 16; ++j) {
        const int lo = (s0 + j) * 256 + d * 2;
        const float xq = bf1(*(const LAS bf16*)(lds + HB_RQ + lo)), xf = bf1(*(const LAS bf16*)(lds + HB_RF + lo)); vraw[j] = *(const LAS bf16*)(lds + HB_RV + lo);
        const float eq = fexp(-xq); q[j] = xq * frcp(1.f + eq);
        const float ef = fexp(-xf), sg = frcp(1.f + ef);
        const float fo = fmaxf(lbv + (1.f - lbv) * sg, 1e-6f);
        g[j] = __builtin_amdgcn_logf(fo) * 0.6931471805599453f;
        kk[j] = (1.f - lbv) * ef * sg;
    }
    float run = 0.f;
#pragma unroll
    for (int j = 0; j < 16; ++j) { run += g[j]; g[j] = run; }
    LAS float* part = (LAS float*)(lds + HB_PART);
    part[rg * 128 + d] = run;
    LBAR();
    PROBE_SUB(21);
    const float p0 = part[d], p1 = part[128 + d], p2 = part[256 + d], p3 = part[384 + d];
    const float offs = (rg > 0 ? p0 : 0.f) + (rg > 1 ? p1 : 0.f) + (rg > 2 ? p2 : 0.f);
    const float last = (p0 + p1) + (p2 + p3), ref = p0 + p1;
    unsigned ket[8], vt[8];
#pragma unroll
    for (int j = 0; j < 16; j += 2) {
        const float c0 = g[j] + offs, c1 = g[j + 1] + offs;
        const unsigned wqe = pk2(q[j] * fexp(c0), q[j + 1] * fexp(c1));
        const unsigned wke = pk2(kk[j] * fexp(last - c0), kk[j + 1] * fexp(last - c1));
        const unsigned wqm = pk2(q[j] * fexp(fminf(c0 - ref, 80.f)), q[j + 1] * fexp(fminf(c1 - ref, 80.f)));
        const unsigned wkm = pk2(kk[j] * fexp(fminf(ref - c0, 80.f)), kk[j + 1] * fexp(fminf(ref - c1, 80.f)));
        *(LAS bf16*)(lds + HB_RQ + (s0 + j) * 256 + d * 2) = (bf16)wqe; *(LAS bf16*)(lds + HB_RQ + (s0 + j + 1) * 256 + d * 2) = (bf16)(wqe >> 16);
        *(LAS bf16*)(lds + HB_QM + ((s0 + j) * 136 + d) * 2) = (bf16)wqm; *(LAS bf16*)(lds + HB_QM + ((s0 + j + 1) * 136 + d) * 2) = (bf16)(wqm >> 16);
        *(LAS bf16*)(lds + HB_KM + ((s0 + j) * 136 + d) * 2) = (bf16)wkm; *(LAS bf16*)(lds + HB_KM + ((s0 + j + 1) * 136 + d) * 2) = (bf16)(wkm >> 16);
        ket[j >> 1] = wke; vt[j >> 1] = vraw[j] | (vraw[j + 1] << 16);
    }
    { LAS v4u* pk = (LAS v4u*)(lds + HB_KET + (d * 72 + s0) * 2); pk[0] = (v4u){ket[0], ket[1], ket[2], ket[3]}; pk[1] = (v4u){ket[4], ket[5], ket[6], ket[7]};
      LAS v4u* pv = (LAS v4u*)(lds + HB_VT + (d * 72 + s0) * 2); pv[0] = (v4u){vt[0], vt[1], vt[2], vt[3]}; pv[1] = (v4u){vt[4], vt[5], vt[6], vt[7]}; }
    if (rg == 0) dvb[((((size_t)b * 4 + h) * NCH + c) * 4 + ((d & 15) >> 2)) * 32 + (d >> 4) * 4 + (d & 3)] = (bf16)f2bf(fexp(last));
    LBAR();
    PROBE_SUB(22);
    if (has_next) b1_load_raw(R, tid, nb, nh, nc, zq, zf, zi);
    const int r32 = lane & 31, hh = lane >> 5;
    {
        const int ti = wave >> 2, vb = wave & 3;
        f32x16 o = f32x16{};
        for (int si = 0; si <= ti; ++si) {
            f32x16 xt = f32x16{};
#pragma unroll
            for (int ks = 0; ks < 8; ++ks) {
                const bf16x8 af = *(const LAS bf16x8*)(lds + HB_KM + ((si * 32 + r32) * 136 + ks * 16 + hh * 8) * 2);
                const bf16x8 bfr = *(const LAS bf16x8*)(lds + HB_QM + ((ti * 32 + r32) * 136 + ks * 16 + hh * 8) * 2);
                xt = __builtin_amdgcn_mfma_f32_32x32x16_bf16(af, bfr, xt, 0, 0, 0);
            }
            if (si == ti) {
#pragma unroll
                for (int r = 0; r < 16; ++r) { const int sl = (r & 3) + 8 * (r >> 2) + 4 * hh; if (sl > r32) xt[r] = 0.f; }
            }
#pragma unroll
            for (int ks = 0; ks < 2; ++ks) {
                v4u aw; aw.x = pk2(xt[8 * ks + 0], xt[8 * ks + 1]); aw.y = pk2(xt[8 * ks + 2], xt[8 * ks + 3]); aw.z = pk2(xt[8 * ks + 4], xt[8 * ks + 5]); aw.w = pk2(xt[8 * ks + 6], xt[8 * ks + 7]);
                const LAS unsigned char* vp = lds + HB_VT + ((vb * 32 + r32) * 72 + si * 32 + ks * 16 + 4 * hh) * 2;
                const v2u b0 = *(const LAS v2u*)vp, b1 = *(const LAS v2u*)(vp + 16);
                const v4u bw = (v4u){b0.x, b0.y, b1.x, b1.y};
                o = __builtin_amdgcn_mfma_f32_32x32x16_bf16(__builtin_bit_cast(bf16x8, aw), __builtin_bit_cast(bf16x8, bw), o, 0, 0, 0);
            }
        }
#pragma unroll
        for (int r = 0; r < 16; r += 2) { const int tl = ti * 32 + (r & 3) + 8 * (r >> 2) + 4 * hh; const unsigned w = pk2(o[r], o[r + 1]);
            *(LAS bf16*)(lds + HB_RV + tl * 256 + (vb * 32 + r32) * 2) = (bf16)w; *(LAS bf16*)(lds + HB_RV + (tl + 1) * 256 + (vb * 32 + r32) * 2) = (bf16)(w >> 16); }
    }
    PROBE_SUB(25);
#pragma unroll
    for (int j = 0; j < 2; ++j) { const int i = tid + NTHR * j, row = i >> 4, seg = i & 15;
        *(GAS v4u*)(zq + (rowbase + row) * 512 + h * 128 + seg * 8) = *(const LAS v4u*)(lds + HB_RQ + row * 256 + seg * 16); }
    PROBE_SUB(26);
    v2u Lw[2][4];
#pragma unroll
    for (int tt = 0; tt < 2; ++tt) {
        const int tile = wave * 2 + tt, di = tile >> 2, vi = tile & 3;
        f32x16 L = f32x16{};
#pragma unroll
        for (int ks = 0; ks < 4; ++ks) {
            const bf16x8 af = *(const LAS bf16x8*)(lds + HB_KET + ((di * 32 + r32) * 72 + ks * 16 + hh * 8) * 2);
            const bf16x8 bfr = *(const LAS bf16x8*)(lds + HB_VT + ((vi * 32 + r32) * 72 + ks * 16 + hh * 8) * 2);
            L = __builtin_amdgcn_mfma_f32_32x32x16_bf16(af, bfr, L, 0, 0, 0);
        }
#pragma unroll
        for (int qd = 0; qd < 4; ++qd) { Lw[tt][qd].x = pk2(L[4 * qd + 0], L[4 * qd + 1]); Lw[tt][qd].y = pk2(L[4 * qd + 2], L[4 * qd + 3]); }
    }
    PROBE_SUB(27);
    LBAR();
#pragma unroll
    for (int tt = 0; tt < 2; ++tt) {
        const int tile = wave * 2 + tt, di = tile >> 2, vi = tile & 3;
        const int v = vi * 32 + r32, vs = v >> 4, v16 = v & 15;
#pragma unroll
        for (int qd = 0; qd < 4; ++qd) { const int gg = 2 * (qd & 1) + hh, dt = 2 * di + (qd >> 1);
            const int ci = (gg * 16 + v16) * 4 + (dt >> 1);
            *(LAS v2u*)(lds + HB_QM + vs * 4096 + ((ci ^ ((v16 >> 2) & 3)) * 16) + (dt & 1) * 8) = Lw[tt][qd]; }
    }
#pragma unroll
    for (int j = 0; j < 2; ++j) { const int i = tid + NTHR * j, row = i >> 4, seg = i & 15;
        *(GAS v4u*)(zi + (rowbase + row) * 512 + h * 128 + seg * 8) = *(const LAS v4u*)(lds + HB_RV + row * 256 + seg * 16); }
    LBAR();
    { bf16* Lu = Lst + (((size_t)b * 4 + h) * NCH + c) * 8 * 2048;
#pragma unroll
      for (int j = 0; j < 4; ++j) { const int p = tid + NTHR * j; *(GAS v4u*)(Lu + (size_t)p * 8) = *(const LAS v4u*)(lds + HB_QM + (p ^ ((p >> 4) & 3)) * 16); } }
    PROBE_SUB(23);
}
__device__ __forceinline__ void hgrn_b1_phase(Frame& F, const Args& a, int layer) {
    bf16* zq = (bf16*)(a.ws + WS_Z); bf16* zf = zq + (size_t)T * 512; bf16* zi = zq + (size_t)2 * T * 512;
    bf16* Lst = (bf16*)(a.ws + WS_XN); bf16* dvb = (bf16*)(a.ws + WS_MISC + MS_DVEC);
    B1Raw R;
    if (F.vcu < NB * 4 * NCH) b1_load_raw(R, F.tid, F.vcu >> 8, (F.vcu >> 6) & 3, F.vcu & 63, zq, zf, zi);
    for (int u = F.vcu; u < NB * 4 * NCH; u += F.G) {
        const int c = u & 63, h = (u >> 6) & 3, b = u >> 8; const int un = u + F.G;
        const int col = h * 128 + (F.tid & 127);
        float lbv = 0.f;
        if (layer == 1) { const float a0 = a.in[I_LB][col], a1 = a.in[I_LB][512 + col]; const float mx = fmaxf(a0, a1); const float e0 = fexp(a0 - mx), e1 = fexp(a1 - mx); lbv = e1 / (e0 + e1); }
        hgrn_b1_unit(F, b, h, c, zq, zf, zi, Lst, dvb, lbv, R, un < NB * 4 * NCH, un >> 8, (un >> 6) & 3, un & 63);
    }
}
typedef float f32x4v __attribute__((ext_vector_type(4)));
constexpr int SQ_RING = 16384, SQ_SLOT = 20480, SQ_NSLOT = 5, SQ_LOFF = 16384;
__device__ __forceinline__ void hgrn_seq_unit(Frame& F, int b, int h, int vs, const bf16* QE, bf16* O, const bf16* Lst, const bf16* dvb) {
    const int lane = F.lane, wave = F.wave;
    const size_t bh = (size_t)b * 4 + h;
    LAS unsigned char* lds = F.lds + RING_OFF;
    {
        const GAS v4u* src = (const GAS v4u*)(dvb + bh * NCH * 128); LAS v4u* dst = (LAS v4u*)lds;
        for (int i = F.tid; i < 1024; i += NTHR) dst[i] = src[i];
        LDS_WAIT(); __syncthreads();
    }
#define SQ_BAR() do { asm volatile("s_waitcnt lgkmcnt(0)" ::: "memory"); __builtin_amdgcn_s_barrier(); asm volatile("" ::: "memory"); } while (0)
    if (wave >= 4) {
        const int pw = wave - 4;
        const char* srcq[4]; unsigned dstq[4];
#pragma unroll
        for (int j = 0; j < 4; ++j) { const int q = pw * 4 + j, row = 4 * q + (lane >> 4), gch = (lane & 15) ^ (row & 15);
            srcq[j] = (const char*)(QE + ((size_t)b * SEQ + row) * 512 + h * 128) + gch * 16; dstq[j] = (unsigned)(q * 1024); }
        const char* srcl = (const char*)(Lst + (bh * NCH * 8 + vs) * 2048 + lane * 32 + pw * 8);
#define SQ_ISSUE(cc) do { LAS unsigned char* sl_ = lds + SQ_RING + ((cc) % SQ_NSLOT) * SQ_SLOT + wave * 0; \
        _Pragma("unroll") for (int j = 0; j < 4; ++j) __builtin_amdgcn_global_load_lds((const unsigned*)(srcq[j] + (size_t)(cc) * (64 * 1024)), (LAS unsigned*)(sl_ + dstq[j]), 16, 0, 0); \
        __builtin_amdgcn_global_load_lds((const unsigned*)(srcl + (size_t)(cc) * (8 * 4096)), (LAS unsigned*)(sl_ + SQ_LOFF + pw * 1024), 16, 0, 0); } while (0)
        SQ_ISSUE(0); SQ_ISSUE(1); SQ_ISSUE(2); SQ_ISSUE(3);
        asm volatile("s_waitcnt vmcnt(15)" ::: "memory");
        SQ_BAR();
        for (int c = 0; c < NCH; ++c) {
            if (c + 4 < NCH) { SQ_ISSUE(c + 4); asm volatile("s_waitcnt vmcnt(15)" ::: "memory"); }
            else asm volatile("s_waitcnt vmcnt(0)" ::: "memory");
            SQ_BAR();
        }
#undef SQ_ISSUE
        return;
    }
    const int v16 = lane & 15, g = lane >> 4, tb = wave;
    float S8[8];
#pragma unroll
    for (int i = 0; i < 8; ++i) S8[i] = 0.f;
    const int rowl = tb * 16 + v16;
    const LAS unsigned char* pd = lds + g * 64 + tb * 16;
    char* pw_ = (char*)(O + ((size_t)b * SEQ + tb * 16 + ((lane >> 1) & 15)) * 512 + h * 128 + vs * 16 + (lane & 1) * 8);
    LAS unsigned char* ost = lds + SQ_RING + SQ_NSLOT * SQ_SLOT + 8192 + tb * 512;
    LAS unsigned char* sbuf = lds + SQ_RING + SQ_NSLOT * SQ_SLOT;
    { LAS v4u* z = (LAS v4u*)sbuf; unsigned z0 = 0u; asm volatile("" : "+v"(z0)); for (int i = F.tid; i < 512; i += 256) z[i] = (v4u){z0, z0, z0, z0}; }
    struct SqOps { v2u qa[4][2]; v4u lw, dd; };
#define SQ_LOAD(R, cc) do { const LAS unsigned char* sl_ = lds + SQ_RING + ((cc) % SQ_NSLOT) * SQ_SLOT; \
        _Pragma("unroll") for (int ks = 0; ks < 4; ++ks) { R.qa[ks][0] = *(const LAS v2u*)(sl_ + rowl * 256 + (((ks * 4 + (g >> 1)) ^ (rowl & 15)) * 16) + 8 * (g & 1)); R.qa[ks][1] = *(const LAS v2u*)(sl_ + rowl * 256 + (((ks * 4 + 2 + (g >> 1)) ^ (rowl & 15)) * 16) + 8 * (g & 1)); } \
        R.lw = *(const LAS v4u*)(sl_ + SQ_LOFF + tb * 1024 + lane * 16); R.dd = *(const LAS v4u*)(pd + (cc) * 256); } while (0)
#define SQ_STEP(R, cc) do { f32x4v acc = (f32x4v){0.f, 0.f, 0.f, 0.f}; \
        const LAS unsigned char* sr_ = sbuf + ((((cc) + 1) & 1) * 4096) + lane * 16; \
        _Pragma("unroll") for (int ks = 0; ks < 4; ++ks) { \
            const v4u bw = *(const LAS v4u*)(sr_ + ks * 1024); \
            const v4u aw = (v4u){R.qa[ks][0].x, R.qa[ks][0].y, R.qa[ks][1].x, R.qa[ks][1].y}; \
            acc = __builtin_amdgcn_mfma_f32_16x16x32_bf16(__builtin_bit_cast(bf16x8, aw), __builtin_bit_cast(bf16x8, bw), acc, 0, 0, 0); } \
        _Pragma("unroll") for (int dt = 0; dt < 2; ++dt) { \
            const unsigned w0 = R.lw[dt * 2], w1 = R.lw[dt * 2 + 1], d0 = R.dd[dt * 2], d1 = R.dd[dt * 2 + 1]; \
            S8[4 * dt + 0] = bflo(d0) * S8[4 * dt + 0] + bflo(w0); S8[4 * dt + 1] = bfhi(d0) * S8[4 * dt + 1] + bfhi(w0); \
            S8[4 * dt + 2] = bflo(d1) * S8[4 * dt + 2] + bflo(w1); S8[4 * dt + 3] = bfhi(d1) * S8[4 * dt + 3] + bfhi(w1); } \
        *(LAS v4u*)(sbuf + (((cc) & 1) * 4096) + tb * 1024 + lane * 16) = (v4u){pk2(S8[0], S8[1]), pk2(S8[2], S8[3]), pk2(S8[4], S8[5]), pk2(S8[6], S8[7])}; \
        _Pragma("unroll") for (int r = 0; r < 4; ++r) *(LAS unsigned short*)(ost + (4 * g + r) * 32 + v16 * 2) = (unsigned short)f2bf(acc[r]); \
        asm volatile("s_waitcnt lgkmcnt(0)" ::: "memory"); \
        if (lane < 32) *(GAS v4u*)pw_ = *(const LAS v4u*)(ost + lane * 16); \
        pw_ += 64 * 1024; } while (0)
    SQ_BAR();
    SqOps RA;
    for (int c = 0; c < NCH; ++c) {
        SQ_LOAD(RA, c);
        SQ_STEP(RA, c);
        SQ_BAR();
    }
#undef SQ_LOAD
#undef SQ_STEP
#undef SQ_BAR
}
__device__ __forceinline__ void hgrn_seq_phase(Frame& F, const Args& a) {
    const bf16* zq = (const bf16*)(a.ws + WS_Z); bf16* zi = (bf16*)(a.ws + WS_Z) + (size_t)1 * T * 512;
    const bf16* Lst = (const bf16*)(a.ws + WS_XN); const bf16* dvb = (const bf16*)(a.ws + WS_MISC + MS_DVEC);
    for (int u = F.vcu; u < NB * 32; u += F.G) hgrn_seq_unit(F, u >> 5, (u >> 3) & 3, u & 7, zq, zi, Lst, dvb);
}

__device__ __forceinline__ void mix_finalize(Frame& F, const Args& a, int layer) {
    const int gw = F.vcu * NWAVES + F.wave, NGW = F.G * NWAVES, lane = F.lane;
    const bf16* oh = (const bf16*)(a.ws + WS_Z) + (size_t)2 * T * 512; const bf16* oi = (const bf16*)(a.ws + WS_Z) + (size_t)1 * T * 512; const bf16* zg = (const bf16*)(a.ws + WS_Z) + (size_t)3 * T * 512;
    const bf16* OA = (const bf16*)(a.ws + WS_OA); bf16* mix = (bf16*)(a.ws + WS_Z) + (size_t)4 * T * 512;
    const float lam_init = 0.8f - 0.6f * fexp(-0.3f * (float)layer);
    const float la = wave_sum(a.in[I_LQ1][layer * 64 + lane] * a.in[I_LK1][layer * 64 + lane]), lb = wave_sum(a.in[I_LQ2][layer * 64 + lane] * a.in[I_LK2][layer * 64 + lane]);
    const float lam = fexp(la) - fexp(lb) + lam_init;
    const int c0 = (lane & 15) * 8;
    float gh[8], gs[8];
#pragma unroll
    for (int j = 0; j < 8; ++j) { gh[j] = a.in[I_HON][layer * 128 + c0 + j]; gs[j] = a.in[I_SUBLN][layer * 128 + c0 + j] * (1.f - lam_init); }
    struct DRow { v4u xo, xi, xg, x0, x1; };
    auto ld = [&](int m) { DRow r; r.xo = *((const GAS v4u*)(oh + (size_t)m * 512) + lane); r.xi = *((const GAS v4u*)(oi + (size_t)m * 512) + lane); r.xg = *((const GAS v4u*)(zg + (size_t)m * 512) + lane);
        r.x0 = *((const GAS v4u*)(OA + (size_t)m * 1024) + lane); r.x1 = *((const GAS v4u*)(OA + (size_t)m * 1024 + 512) + lane); return r; };
    auto fin = [&](int m, const DRow& R) {
        const v4u xo = R.xo, xi = R.xi, xg = R.xg, x0 = R.x0, x1 = R.x1;
        float o[8] = {bflo(xo.x) + bflo(xi.x), bfhi(xo.x) + bfhi(xi.x), bflo(xo.y) + bflo(xi.y), bfhi(xo.y) + bfhi(xi.y), bflo(xo.z) + bflo(xi.z), bfhi(xo.z) + bfhi(xi.z), bflo(xo.w) + bflo(xi.w), bfhi(xo.w) + bfhi(xi.w)};
        float gt[8] = {bflo(xg.x), bfhi(xg.x), bflo(xg.y), bfhi(xg.y), bflo(xg.z), bfhi(xg.z), bflo(xg.w), bfhi(xg.w)};
        float d0[8] = {bflo(x0.x), bfhi(x0.x), bflo(x0.y), bfhi(x0.y), bflo(x0.z), bfhi(x0.z), bflo(x0.w), bfhi(x0.w)};
        float d1[8] = {bflo(x1.x), bfhi(x1.x), bflo(x1.y), bfhi(x1.y), bflo(x1.z), bfhi(x1.z), bflo(x1.w), bfhi(x1.w)};
        float s = 0.f, s2 = 0.f;
#pragma unroll
        for (int j = 0; j < 8; ++j) { s += o[j] * o[j]; d0[j] -= lam * d1[j]; s2 += d0[j] * d0[j]; }
#pragma unroll
        for (int k = 1; k < 16; k <<= 1) { s += __shfl_xor(s, k); s2 += __shfl_xor(s2, k); }
        const float r = rsqrtf(s * (1.f / 128.f) + EPSN), r2 = rsqrtf(s2 * (1.f / 128.f) + EPSN);
        float y[8], z[8];
#pragma unroll
        for (int j = 0; j < 8; ++j) { y[j] = o[j] * r * gh[j] * (gt[j] * frcp(1.f + fexp(-gt[j]))); z[j] = d0[j] * r2 * gs[j]; }
        *((GAS v4u*)(mix + (size_t)m * 1024) + lane) = (v4u){pk2(y[0], y[1]), pk2(y[2], y[3]), pk2(y[4], y[5]), pk2(y[6], y[7])};
        *((GAS v4u*)(mix + (size_t)m * 1024 + 512) + lane) = (v4u){pk2(z[0], z[1]), pk2(z[2], z[3]), pk2(z[4], z[5]), pk2(z[6], z[7])};
    };
    for (int m = gw; m < T; m += 2 * NGW) {
        const int m2 = (m + NGW < T) ? m + NGW : m;
        const DRow A = ld(m), B = ld(m2);
        fin(m, A); fin(m2, B);
    }
}

__device__ __forceinline__ void router_phase(Frame& F, const Args& a, int layer) {
    const int tid = F.tid, lane = F.lane, wave = F.wave;
    LAS unsigned char* lds = F.lds + RING_OFF;
    LAS unsigned* w3 = (LAS unsigned*)lds; LAS float* stg = (LAS float*)(lds + 99328) + wave * 272;
    LAS int* le = (LAS int*)(lds + 108032); LAS float* lw = (LAS float*)(lds + 109056); LAS float* lrs = (LAS float*)(lds + 110080); LAS int* lrank = (LAS int*)(lds + 111104);
    LAS int* lcnt = (LAS int*)(lds + 112128); LAS int* lbase = (LAS int*)(lds + 112192);
    const bf16* h = (const bf16*)a.out; const float* gain = a.in[I_FFNN] + layer * 1024;
    int* etok = (int*)(a.ws + WS_MISC + MS_ETOK); float* er = (float*)(a.ws + WS_MISC + MS_EW); int* tpos = (int*)(a.ws + WS_MISC + MS_TPOS); float* tw = (float*)(a.ws + WS_MISC + MS_TW);
    unsigned* gcnt = F.ctl + CW_ECNT + (F.g * 2 + layer) * 16 * 64;
    const int t16 = lane & 15, kq = lane >> 4;
#define RT_LOADW(it0) _Pragma("unroll") for (int it = 0; it < 8; ++it) { const int j = tid + ((it0) + it) * NTHR, e = j & 15, kp = j >> 4; wa[it] = a.in[I_WR][(2 * kp) * 16 + e]; wb[it] = a.in[I_WR][(2 * kp + 1) * 16 + e]; gg[it] = *(const v2f*)(gain + 2 * kp); }
#define RT_PUTW(it0) _Pragma("unroll") for (int it = 0; it < 8; ++it) { const int j = tid + ((it0) + it) * NTHR, e = j & 15, kp = j >> 4; \
            const float w0 = wa[it] * gg[it].x, w1 = wb[it] * gg[it].y; \
            const unsigned u0 = pk2(w0, w1); const float r0 = w0 - bflo(u0), r1 = w1 - bfhi(u0); \
            const unsigned u1 = pk2(r0, r1); const float q0 = r0 - bflo(u1), q1 = r1 - bfhi(u1); \
            const unsigned u2 = pk2(q0, q1); \
            w3[e * 516 + kp] = u0; w3[(16 + e) * 516 + kp] = u1; w3[(32 + e) * 516 + kp] = u2; }
    { float wa[8], wb[8]; v2f gg[8];
      RT_LOADW(0); RT_PUTW(0);
      RT_LOADW(8); RT_PUTW(8); }
#undef RT_LOADW
#undef RT_PUTW
    const GAS f32x4* psrc = (const GAS f32x4*)(a.in[I_P] + (size_t)layer * TFULL * 256); GAS v2u* pdst = (GAS v2u*)(a.ws + WS_MISC + MS_PB);
    const bool one = (F.G * 128 == T);
    f32x4 pq[16];
    for (int tb0 = F.vcu * 128; tb0 < T; tb0 += F.G * 128) {
        v4u hv[32];
        { const GAS v4u* hp = (const GAS v4u*)(h + (size_t)(tb0 + wave * 16 + t16) * 1024) + kq;
#pragma unroll
          for (int c = 0; c < 32; ++c) hv[c] = hp[4 * c]; }
        if (tid < 16) lcnt[tid] = 0;
        LDS_WAIT(); __syncthreads();
        {
            const LAS pg8::bf16x8* wp = (const LAS pg8::bf16x8*)(w3 + t16 * 516) + kq;
            f32x4 ac0 = (f32x4){0.f, 0.f, 0.f, 0.f}, ac1 = ac0, ac2 = ac0; float ss = 0.f;
#pragma unroll
            for (int c = 0; c < 32; ++c) {
                const v4u hw = hv[c]; const pg8::bf16x8 a8 = __builtin_bit_cast(pg8::bf16x8, hw);
                const float x0 = bflo(hw.x), x1 = bfhi(hw.x), x2 = bflo(hw.y), x3 = bfhi(hw.y), x4 = bflo(hw.z), x5 = bfhi(hw.z), x6 = bflo(hw.w), x7 = bfhi(hw.w);
                ss += ((x0 * x0 + x1 * x1) + (x2 * x2 + x3 * x3)) + ((x4 * x4 + x5 * x5) + (x6 * x6 + x7 * x7));
                ac0 = __builtin_amdgcn_mfma_f32_16x16x32_bf16(a8, wp[4 * c], ac0, 0, 0, 0);
                ac1 = __builtin_amdgcn_mfma_f32_16x16x32_bf16(a8, wp[4 * c + 16 * 129], ac1, 0, 0, 0);
                ac2 = __builtin_amdgcn_mfma_f32_16x16x32_bf16(a8, wp[4 * c + 32 * 129], ac2, 0, 0, 0);
            }
            if (one) {
#pragma unroll
                for (int j = 0; j < 16; ++j) pq[j] = psrc[(size_t)tb0 * 4 + tid + (size_t)j * F.G * NTHR]; }
            ss += __shfl_xor(ss, 16); ss += __shfl_xor(ss, 32);
            const float rs = rsqrtf(ss * (1.f / 1024.f) + EPSN);
#pragma unroll
            for (int r = 0; r < 4; ++r) stg[(4 * kq + r) * 17 + t16] = ac0[r] + (ac1[r] + ac2[r]);
            LDS_WAIT();
            if (lane < 16) {
                float lg[16];
#pragma unroll
                for (int e = 0; e < 16; ++e) lg[e] = stg[lane * 17 + e] * rs;
                float mx = lg[0];
#pragma unroll
                for (int e = 1; e < 16; ++e) mx = fmaxf(mx, lg[e]);
                float sum = 0.f;
#pragma unroll
                for (int e = 0; e < 16; ++e) { lg[e] = __expf(lg[e] - mx); sum += lg[e]; }
                const float inv = 1.f / sum;
#pragma unroll
                for (int e = 0; e < 16; ++e) lg[e] *= inv;
                float bestg = -1.f; int gs = 0, bi1 = 0, bi2 = 1; float bv1 = 0.f, bv2 = 0.f;
#pragma unroll
                for (int gq = 0; gq < 4; ++gq) {
                    int i1 = 0; float v1 = lg[4 * gq];
#pragma unroll
                    for (int jj = 1; jj < 4; ++jj) if (lg[4 * gq + jj] > v1) { v1 = lg[4 * gq + jj]; i1 = jj; }
                    int i2 = -1; float v2 = -1.f;
#pragma unroll
                    for (int jj = 0; jj < 4; ++jj) if (jj != i1 && lg[4 * gq + jj] > v2) { v2 = lg[4 * gq + jj]; i2 = jj; }
                    const float sc = v1 + v2;
                    if (sc > bestg) { bestg = sc; gs = gq; bi1 = i1; bi2 = i2; bv1 = v1; bv2 = v2; }
                }
                const float si = 1.f / (bv1 + bv2); const int aidx = (wave * 16 + lane) * 2;
                le[aidx] = gs * 4 + bi1; le[aidx + 1] = gs * 4 + bi2; lw[aidx] = bv1 * si; lw[aidx + 1] = bv2 * si; lrs[aidx] = rs; lrs[aidx + 1] = rs;
            }
        }
        LDS_WAIT(); __syncthreads();
        if (tid < 256) lrank[tid] = __hip_atomic_fetch_add(&lcnt[le[tid]], 1, __ATOMIC_RELAXED, __HIP_MEMORY_SCOPE_WORKGROUP);
        LDS_WAIT(); __syncthreads();
        if (tid < 16) lbase[tid] = (int)__hip_atomic_fetch_add(gcnt + tid * 64, (unsigned)lcnt[tid], RLX_AGENT);
        LDS_WAIT(); __syncthreads();
        if (tid < 256) { const int e = le[tid], pos = lbase[e] + lrank[tid]; etok[(size_t)e * T + pos] = tb0 + (tid >> 1); er[(size_t)e * T + pos] = lrs[tid]; tpos[(size_t)tb0 * 2 + tid] = (e << 20) | pos; tw[(size_t)tb0 * 2 + tid] = lw[tid]; }
        __syncthreads();
    }
    if (one) {
#pragma unroll
        for (int j = 0; j < 16; ++j) { const f32x4 v = pq[j]; v2u w; w.x = pk2(v.x, v.y); w.y = pk2(v.z, v.w); pdst[(size_t)F.vcu * NTHR + tid + (size_t)j * F.G * NTHR] = w; }
    } else {
        for (size_t i = (size_t)F.vcu * NTHR + tid; i < (size_t)T * 64; i += (size_t)F.G * NTHR) { const f32x4 v = psrc[i]; v2u w; w.x = pk2(v.x, v.y); w.y = pk2(v.z, v.w); pdst[i] = w; }
    }
}

struct MoeTab { const LAS int* tb; const LAS int* cnt; };
__device__ __forceinline__ void moe_table(Frame& F, int layer) {
    LAS int* tb = (LAS int*)(F.lds + LDSCTL_OFF); LAS int* cnt = tb + 20;
    if (F.tid == 0) { int s = 0; for (int e = 0; e < 16; ++e) { const int c = (int)__hip_atomic_load(F.ctl + CW_ECNT + ((F.g * 2 + layer) * 16 + e) * 64, RLX_AGENT); cnt[e] = c; tb[e] = s; s += (c + 255) >> 8; } tb[16] = s; }
    LDS_WAIT(); __syncthreads();
}
struct MoeOrder {
    const LAS int* tb; int G, c;
    __device__ __forceinline__ bool next(int i, pg8::Unit& u) const {
        const int L = i * G + c, nt = tb[16]; if (L >= nt * 4) return false;
        const int tile = L >> 2; int e = 0;
#pragma unroll
        for (int j = 1; j < 16; ++j) e += (tile >= tb[j]) ? 1 : 0;
        u.pm = tile; u.pn = L & 3; u.e = __builtin_amdgcn_readfirstlane(e); return true;
    }
};
struct MoeGather {
    const LAS int* tb; const LAS int* cnt; const int* etok;
    __device__ __forceinline__ unsigned operator()(const pg8::Unit& u, int r) const {
        const int pos = (u.pm - tb[u.e]) * 256 + r; const unsigned tok = (unsigned)etok[(size_t)u.e * T + pos];
        return (pos < cnt[u.e]) ? tok : 0u;
    }
};
struct EpiMoeScatter {
    static constexpr bool PERM = false;
    float* H; const LAS int* tb; const LAS int* cnt; const int* etok; const float* ew;
    __device__ __forceinline__ void operator()(const pg8::f32x4 (&acc)[2][2][4][2], const pg8::Unit& u, int wr, int wc, int fr, int fq) const {
        const int col0 = u.pn * 256 + wc * 32 + 4 * fq; const int p0 = (u.pm - tb[u.e]) * 256, n = cnt[u.e];
#pragma unroll
        for (int ai = 0; ai < 2; ++ai)
#pragma unroll
            for (int m = 0; m < 4; ++m) { const int pos = p0 + ai * 128 + wr * 64 + m * 16 + fr;
                if (pos < n) { const int tok = etok[(size_t)u.e * T + pos]; const float w = ew[(size_t)u.e * T + pos]; float* hp = H + (size_t)tok * 1024 + col0;
#pragma unroll
                    for (int bj = 0; bj < 2; ++bj)
#pragma unroll
                        for (int nn = 0; nn < 2; ++nn)
#pragma unroll
                            for (int i = 0; i < 4; ++i) __hip_atomic_fetch_add(hp + bj * 128 + nn * 16 + i, w * acc[ai][bj][m][nn][i], RLX_AGENT); } }
    }
};

__device__ __forceinline__ void rows_to_bf16(Frame& F, const float* src, bf16* dst) {
    const GAS f32x4* ps = (const GAS f32x4*)src; GAS v2u* pd = (GAS v2u*)dst;
    for (size_t i = (size_t)F.vcu * NTHR + F.tid; i < (size_t)T * 256; i += (size_t)F.G * NTHR) { const f32x4 v = ps[i]; v2u w; w.x = pk2(v.x, v.y); w.y = pk2(v.z, v.w); pd[i] = w; }
}
__device__ __forceinline__ void moe_combine(Frame& F, const Args& a) {
    const int gw = F.vcu * NWAVES + F.wave, NGW = F.G * NWAVES, lane = F.lane;
    const LAS int* tb = (const LAS int*)(F.lds + LDSCTL_OFF);
    const int* tpos = (const int*)(a.ws + WS_MISC + MS_TPOS); const float* tw = (const float*)(a.ws + WS_MISC + MS_TW);
    const bf16* Y = (const bf16*)(a.ws + WS_Z + WS_YOFF); bf16* h2b = (bf16*)(a.ws + WS_XN);
    for (int m = gw; m < T; m += 2 * NGW) {
        const int mm[2] = {m, (m + NGW < T) ? m + NGW : m};
        int pp[2][2]; float ww[2][2];
#pragma unroll
        for (int q = 0; q < 2; ++q) { pp[q][0] = tpos[2 * mm[q]]; pp[q][1] = tpos[2 * mm[q] + 1]; ww[q][0] = tw[2 * mm[q]]; ww[q][1] = tw[2 * mm[q] + 1]; }
        v4u y0[2][2], y1[2][2], hx[2][2];
#pragma unroll
        for (int q = 0; q < 2; ++q) {
            const size_t r0 = (size_t)tb[pp[q][0] >> 20] * 256 + (pp[q][0] & 0xfffff), r1 = (size_t)tb[pp[q][1] >> 20] * 256 + (pp[q][1] & 0xfffff);
#pragma unroll
            for (int j = 0; j < 2; ++j) { y0[q][j] = *((const GAS v4u*)(Y + r0 * 1024) + lane + 64 * j); y1[q][j] = *((const GAS v4u*)(Y + r1 * 1024) + lane + 64 * j);
                hx[q][j] = *((const GAS v4u*)((const bf16*)a.out + (size_t)mm[q] * 1024) + lane + 64 * j); } }
#pragma unroll
        for (int q = 0; q < 2; ++q)
#pragma unroll
            for (int j = 0; j < 2; ++j) { const float w0 = ww[q][0], w1 = ww[q][1]; const v4u a0 = y0[q][j], a1 = y1[q][j], hh = hx[q][j];
                f32x4 ha = (f32x4){bflo(hh.x), bfhi(hh.x), bflo(hh.y), bfhi(hh.y)}, hb = (f32x4){bflo(hh.z), bfhi(hh.z), bflo(hh.w), bfhi(hh.w)};
                ha.x = (ha.x + w0 * bflo(a0.x)) + w1 * bflo(a1.x); ha.y = (ha.y + w0 * bfhi(a0.x)) + w1 * bfhi(a1.x); ha.z = (ha.z + w0 * bflo(a0.y)) + w1 * bflo(a1.y); ha.w = (ha.w + w0 * bfhi(a0.y)) + w1 * bfhi(a1.y);
                hb.x = (hb.x + w0 * bflo(a0.z)) + w1 * bflo(a1.z); hb.y = (hb.y + w0 * bfhi(a0.z)) + w1 * bfhi(a1.z); hb.z = (hb.z + w0 * bflo(a0.w)) + w1 * bflo(a1.w); hb.w = (hb.w + w0 * bfhi(a0.w)) + w1 * bfhi(a1.w);
                *((GAS v4u*)(h2b + (size_t)mm[q] * 1024) + lane + 64 * j) = (v4u){pk2(ha.x, ha.y), pk2(ha.z, ha.w), pk2(hb.x, hb.y), pk2(hb.z, hb.w)}; }
    }
}
__device__ __forceinline__ void rows_sumsq(Frame& F, const bf16* P, float* rowss, int vcu, int ncu) {
    const int gw = vcu * NWAVES + F.wave, NGW = ncu * NWAVES;
    for (int m = gw; m < T; m += 4 * NGW) {
        int mm[4]; v4u x[4][2];
#pragma unroll
        for (int q = 0; q < 4; ++q) { mm[q] = (m + q * NGW < T) ? m + q * NGW : m;
#pragma unroll
            for (int j = 0; j < 2; ++j) x[q][j] = *((const GAS v4u*)(P + (size_t)mm[q] * 1024) + F.lane + 64 * j); }
#pragma unroll
        for (int q = 0; q < 4; ++q) { float s = 0.f;
#pragma unroll
            for (int j = 0; j < 2; ++j) { const v4u w = x[q][j];
                const float a0 = bflo(w.x), a1 = bfhi(w.x), a2 = bflo(w.y), a3 = bfhi(w.y), a4 = bflo(w.z), a5 = bfhi(w.z), a6 = bflo(w.w), a7 = bfhi(w.w);
                s += (a0 * a0 + a1 * a1) + (a2 * a2 + a3 * a3) + (a4 * a4 + a5 * a5) + (a6 * a6 + a7 * a7); }
            s = wave_sum(s); if (F.lane == 0) rowss[mm[q]] = s; }
    }
}
__device__ __forceinline__ void rows_rms_to_bf16(Frame& F, const float* src, const float* gain, bf16* dst) {
    const int gw = F.vcu * NWAVES + F.wave, NGW = F.G * NWAVES;
    for (int m = gw; m < T; m += NGW) rms_row_to_bf16(src + (size_t)m * D, gain, dst + (size_t)m * D, F.lane);
}

__device__ __forceinline__ void rows_rms_b2b(Frame& F, const bf16* src, const float* gain, bf16* dst) {
    const int gw = F.vcu * NWAVES + F.wave, NGW = F.G * NWAVES, lane = F.lane;
    for (int m = gw; m < T; m += 4 * NGW) {
        int mm[4]; v4u x[4][2];
#pragma unroll
        for (int q = 0; q < 4; ++q) { mm[q] = (m + q * NGW < T) ? m + q * NGW : m;
#pragma unroll
            for (int j = 0; j < 2; ++j) x[q][j] = *((const GAS v4u*)(src + (size_t)mm[q] * 1024) + lane + 64 * j); }
#pragma unroll
        for (int q = 0; q < 4; ++q) {
            float v[16]; float s = 0.f;
#pragma unroll
            for (int j = 0; j < 2; ++j) { v[8 * j + 0] = bflo(x[q][j].x); v[8 * j + 1] = bfhi(x[q][j].x); v[8 * j + 2] = bflo(x[q][j].y); v[8 * j + 3] = bfhi(x[q][j].y); v[8 * j + 4] = bflo(x[q][j].z); v[8 * j + 5] = bfhi(x[q][j].z); v[8 * j + 6] = bflo(x[q][j].w); v[8 * j + 7] = bfhi(x[q][j].w); }
#pragma unroll
            for (int i = 0; i < 16; ++i) s += v[i] * v[i];
            const float r = rsqrtf(wave_sum(s) * (1.f / 1024.f) + EPSN);
#pragma unroll
            for (int j = 0; j < 2; ++j) { const f32x4 g0 = *((const f32x4*)gain + 2 * (lane + 64 * j)), g1 = *((const f32x4*)gain + 2 * (lane + 64 * j) + 1);
                *((GAS v4u*)(dst + (size_t)mm[q] * 1024) + lane + 64 * j) = (v4u){pk2(v[8 * j] * r * g0.x, v[8 * j + 1] * r * g0.y), pk2(v[8 * j + 2] * r * g0.z, v[8 * j + 3] * r * g0.w), pk2(v[8 * j + 4] * r * g1.x, v[8 * j + 5] * r * g1.y), pk2(v[8 * j + 6] * r * g1.z, v[8 * j + 7] * r * g1.w)}; }
        }
    }
}
enum { PH_A = 0, PH_B, PH_C, PH_D, PH_E, PH_F, PH_H, PH_I, PH_J, PH_K, PH_L, NPH };
#ifndef MK_PHMASK
#define MK_PHMASK 0xFFFF
#endif
#define PHON(p) ((MK_PHMASK >> (p)) & 1)
#ifndef MK_SKIP_SEQ
#define MK_SKIP_SEQ 0
#endif
#ifndef MK_H_PART
#define MK_H_PART 3
#endif
#ifndef MK_SKIP_ATTN
#define MK_SKIP_ATTN 0
#endif
#ifndef MK_SKIP_HGRN
#define MK_SKIP_HGRN 0
#endif
__global__ void __launch_bounds__(NTHR, 2) mk_fwd(Args args) {
    extern __shared__ __attribute__((aligned(16))) unsigned char lds_raw[];
    Frame F;
    F.lds = (LAS unsigned char*)lds_raw; F.MISC = (volatile LAS unsigned*)(F.lds + MISC_OFF);
    F.tid = threadIdx.x; F.lane = F.tid & 63; F.wave = __builtin_amdgcn_readfirstlane(F.tid >> 6);
    { const int Gall = gridDim.x, bx = blockIdx.x;
      if (Gall % 16 == 0) { F.g = (bx >> 3) & 1; F.G = Gall / 2; F.vcu = (bx & 7) * (Gall / 16) + (bx >> 4); F.bi = (bx >> 4) * 8 + (bx & 7); }
      else { F.g = bx & 1; F.G = (Gall + 1 - F.g) / 2; F.vcu = bx >> 1; F.bi = bx >> 1; } }
    unsigned char* wsw = args.ws;
    Args ga = args;
    ga.in[I_X] = args.in[I_X] + (size_t)F.g * T * 1024; ga.in[I_P] = args.in[I_P] + (size_t)F.g * T * 256; ga.out = args.out + (size_t)F.g * T * 1024; ga.ws = args.ws + (size_t)F.g * WS_GSTRIDE;
    unsigned char* ws = ga.ws;
    F.ctl = (unsigned*)(wsw + WS_CTL);
    for (int u = F.tid; u < (LDS_BYTES - LDSCTL_OFF) / 4; u += NTHR) ((LAS unsigned*)(F.lds + LDSCTL_OFF))[u] = 0u;
    __syncthreads();
    XcdBarrier bar = xcd_barrier_post(F.ctl + CW_BAR + F.g * 4096, F.MISC + 8, (unsigned)F.G);
    const int lo = args.ph_lo, hi = args.ph_hi;
#ifdef PROBE_PH
    unsigned long long probe_last = __builtin_amdgcn_s_memrealtime(), probe_acc = 0;
#endif
#define IN(k) (lo <= (k) && (k) < hi)
#define PHB() do { const int t_ = opaque_tid(); F.tid = t_; F.lane = t_ & 63; F.wave = __builtin_amdgcn_readfirstlane(t_ >> 6); } while (0)
#ifdef PROBE_PH
#define PROBE_MID(id) do { if (blockIdx.x == 0 && threadIdx.x == 0) { const unsigned long long t_ = __builtin_amdgcn_s_memrealtime(); if ((id) == PROBE_PH) probe_acc += t_ - probe_last; probe_last = t_; } } while (0)
#define SEAM(k) do { if ((k) + 1 < hi) xcd_barrier(bar); if (blockIdx.x == 0 && threadIdx.x == 0) { const unsigned long long t_ = __builtin_amdgcn_s_memrealtime(); const int pp_ = ((k) == 0) ? 15 : (((k) - 1) % NPH); if (pp_ == PROBE_PH) probe_acc += t_ - probe_last; probe_last = t_; } } while (0)
#else
#define PROBE_MID(id) do { } while (0)
#define SEAM(k) do { if ((k) + 1 < hi) xcd_barrier(bar); } while (0)
#endif
#define FLAGSET(k) do { if (F.tid == 0) __hip_atomic_store(F.ctl + CW_FLAG + 64 * (k), 1u, RLX_AGENT); } while (0)
#define FLAGWAIT(k) do { if (F.tid == 0) { unsigned sp_ = 0; while (__hip_atomic_load(F.ctl + CW_FLAG + 64 * (k), RLX_AGENT) == 0u && ++sp_ < (1u << 18)) __builtin_amdgcn_s_sleep(2); \
        __builtin_amdgcn_fence(__ATOMIC_ACQUIRE, "agent"); asm volatile("s_waitcnt vmcnt(0)" ::: "memory"); } __syncthreads(); } while (0)
    if (PHON(15) && IN(0)) { PHB(); p0_prologue(F, ga, wsw); SEAM(0); FLAGSET(F.g); }
    for (int layer = 0; layer < 2; ++layer) {
        const int g0 = 1 + layer * NPH;
        bf16* zbase = (bf16*)(ws + WS_Z);
        bf16* h1b = (bf16*)ga.out; bf16* h3b = (bf16*)ga.out + (size_t)T * 1024;
        if (PHON(PH_A) && IN(g0 + PH_A)) { PHB();
            if (layer == 0) FLAGWAIT(0);
            pg8::Gemm g{(const pg8::bf16_t*)(ws + WS_XN), (const pg8::bf16_t*)(wsw + WS_WIN) + (size_t)layer * 3584 * 1024, 1024, 0};
            pg8::StaticOrder S; S.init(T, 3584, F.G, F.bi);
            { LAS float* gq = (LAS float*)(F.lds + LDSCTL_OFF + 2048) + 2048; if (F.tid < 64) gq[F.tid] = args.in[I_QN][layer * 64 + F.tid]; else if (F.tid < 128) gq[F.tid] = args.in[I_KN][layer * 64 + F.tid - 64]; LDS_WAIT(); __syncthreads(); }
            pg8::EpiInProjQK E{zbase, (size_t)T * 512, (LAS float*)(F.lds + LDSCTL_OFF + 2048)};
            pg8::gemm_phase<pg8::EpiInProjQK, pg8::StaticOrder, pg8::RowIdent, true>(F.lds + RING_OFF, g, S, E, pg8::RowIdent{});
            SEAM(g0 + PH_A);
        }
        if (PHON(PH_B) && IN(g0 + PH_B)) { PHB();
            PROBE_MID(12);
            if (!MK_SKIP_HGRN) hgrn_b1_phase(F, ga, layer);
            SEAM(g0 + PH_B);
        }
        if (PHON(PH_C) && IN(g0 + PH_C)) { PHB();
            if (!MK_SKIP_HGRN && !MK_SKIP_SEQ) { hgrn_seq_phase(F, ga); VM_WAIT(); __syncthreads(); }
            PROBE_MID(11);
            if (!MK_SKIP_ATTN) {
                const attn_body::AttnTensors AT{(const attn_body::bf16*)(zbase + (size_t)4 * T * 512), (const attn_body::bf16*)(zbase + (size_t)5 * T * 512), (const attn_body::bf16*)(zbase + (size_t)6 * T * 512), (attn_body::bf16*)(ws + WS_OA)};
                attn_body::attn_phase<8>((char*)lds_raw + RING_OFF, AT, F.vcu, F.G);
            }
            SEAM(g0 + PH_C);
        }
        if (PHON(PH_D) && IN(g0 + PH_D)) { PHB(); mix_finalize(F, ga, layer); SEAM(g0 + PH_D); }
        if (PHON(PH_E) && IN(g0 + PH_E)) { PHB();
            if (layer == 0) FLAGWAIT(1);
            pg8::Gemm g{(const pg8::bf16_t*)(zbase + (size_t)4 * T * 512), (const pg8::bf16_t*)(wsw + WS_WOUT) + (size_t)layer * 1024 * 1024, 1024, 0};
            pg8::StaticOrder S; S.init(T, 1024, F.G, F.bi);
            pg8::EpiResB E{layer == 0 ? ga.in[I_X] : nullptr, layer == 0 ? nullptr : (const pg8::bf16_t*)h3b, (pg8::bf16_t*)h1b};
            pg8::gemm_phase<pg8::EpiResB, pg8::StaticOrder, pg8::RowIdent, true>(F.lds + RING_OFF, g, S, E, pg8::RowIdent{});
            SEAM(g0 + PH_E);
        }
        if (PHON(PH_F) && IN(g0 + PH_F)) { PHB(); router_phase(F, ga, layer); SEAM(g0 + PH_F); }
        if (PHON(PH_H) && IN(g0 + PH_H)) { PHB();
            moe_table(F, layer);
            const LAS int* tb = (const LAS int*)(F.lds + LDSCTL_OFF);
            if (MK_H_PART & 1) {
                pg8::Gemm g{(const pg8::bf16_t*)h1b, (const pg8::bf16_t*)(wsw + WS_WGU) + (size_t)layer * 16 * 1024 * 1024, 1024, (size_t)1024 * 1024 * 2};
                MoeOrder S{tb, F.G, F.vcu}; MoeGather RM{tb, tb + 20, (const int*)(ws + WS_MISC + MS_ETOK)};
                pg8::EpiSiluMul E{(pg8::bf16_t*)zbase, tb, tb + 20, (const float*)(ws + WS_MISC + MS_EW)};
                pg8::gemm_phase<pg8::EpiSiluMul, MoeOrder, MoeGather, true>(F.lds + RING_OFF, g, S, E, RM);
            }
            if (MK_H_PART & 2) {
                pg8::Gemm g{(const pg8::bf16_t*)(ws + WS_MISC + MS_PB), (const pg8::bf16_t*)(wsw + WS_WPP) + (size_t)layer * 1024 * 256, 256, 0};
                const int n5 = (__builtin_amdgcn_readfirstlane(tb[16]) * 4) % F.G, nl = F.G - n5; const bool bal = 3 * nl >= 2 * F.G;
                pg8::StaticOrder S; S.init(T, 1024, bal ? nl : F.G, bal ? (F.vcu >= n5 ? F.vcu - n5 : 1 << 20) : F.bi);
                pg8::EpiBf16 E{(pg8::bf16_t*)(ws + WS_OA), 1024, 0, 0};
                pg8::gemm_phase<pg8::EpiBf16, pg8::StaticOrder, pg8::RowIdent, true>(F.lds + RING_OFF, g, S, E, pg8::RowIdent{});
            }
            SEAM(g0 + PH_H);
        }
        if (PHON(PH_I) && IN(g0 + PH_I)) { PHB();
            moe_table(F, layer);
            const LAS int* tb = (const LAS int*)(F.lds + LDSCTL_OFF);
            pg8::Gemm g{(const pg8::bf16_t*)zbase, (const pg8::bf16_t*)(wsw + WS_WDN) + (size_t)layer * 16 * 1024 * 512, 512, (size_t)1024 * 512 * 2};
            MoeOrder S{tb, F.G, F.vcu};
            pg8::EpiBf16 E{(pg8::bf16_t*)(ws + WS_Z + WS_YOFF), 1024, 0, 0};
            pg8::gemm_phase<pg8::EpiBf16, MoeOrder, pg8::RowIdent, true>(F.lds + RING_OFF, g, S, E, pg8::RowIdent{});
            { const int n5 = (__builtin_amdgcn_readfirstlane(tb[16]) * 4) % F.G, nl = F.G - n5; const bool bal = 3 * nl >= 2 * F.G;
              if (!bal || F.vcu >= n5) rows_sumsq(F, (const bf16*)(ws + WS_OA), (float*)(F.ctl + CW_ROWSS) + (size_t)(F.g * 2 + layer) * T, bal ? F.vcu - n5 : F.vcu, bal ? nl : F.G); }
            SEAM(g0 + PH_I);
        }
        if (PHON(PH_J) && IN(g0 + PH_J)) { PHB(); moe_table(F, layer);
            moe_combine(F, ga); SEAM(g0 + PH_J); }
        if (PHON(PH_K) && IN(g0 + PH_K)) { PHB();
            pg8::Gemm g{(const pg8::bf16_t*)(ws + WS_XN), (const pg8::bf16_t*)(wsw + WS_WPG) + (size_t)layer * 1024 * 1024, 1024, 0};
            pg8::StaticOrder S; S.init(T, 1024, F.G, F.bi);
            pg8::EpiPleGate E{layer == 1 ? ga.out : nullptr, layer == 1 ? nullptr : (pg8::bf16_t*)h3b, (const pg8::bf16_t*)(ws + WS_XN), (const pg8::bf16_t*)(ws + WS_OA), (const float*)(F.ctl + CW_ROWSS) + (size_t)(F.g * 2 + layer) * T, args.in[I_PLEN] + layer * 1024};
            pg8::gemm_phase<pg8::EpiPleGate, pg8::StaticOrder, pg8::RowIdent, true>(F.lds + RING_OFF, g, S, E, pg8::RowIdent{});
            if (layer == 0) SEAM(g0 + PH_K);
        }
        if (PHON(PH_L) && IN(g0 + PH_L)) { PHB(); if (layer == 0) rows_rms_b2b(F, h3b, args.in[I_MIXN] + 1024, (bf16*)(ws + WS_XN)); SEAM(g0 + PH_L); }
    }
#ifdef PROBE_PH
    if (blockIdx.x == 0 && threadIdx.x == 0) { probe_acc += ((volatile LAS unsigned long long*)(F.lds + MISC_OFF + 64))[0]; const unsigned long long t0_ = __builtin_amdgcn_s_memrealtime(); while (__builtin_amdgcn_s_memrealtime() - t0_ < probe_acc * PROBE_MUL) __builtin_amdgcn_s_sleep(8); }
#endif
#undef IN
#undef SEAM
}
constexpr int N_PHASES = 1 + 2 * NPH;

static int launch_mk(void* const* d_in, void* d_out, void* d_ws, size_t ws_size, hipStream_t stream, int ph_lo, int ph_hi, bool do_memset) {
    static int grid = 0;
    if (grid == 0) {
        if (ws_size < WS_END) { fprintf(stderr, "kernel_launch: workspace too small (%zu < %zu)\n", ws_size, (size_t)WS_END); grid = -1; return -1; }
        int dev = 0, cus = 0, per_cu = 0;
        if (hipGetDevice(&dev) != hipSuccess || hipDeviceGetAttribute(&cus, hipDeviceAttributeMultiprocessorCount, dev) != hipSuccess) { grid = -1; return -1; }
        if (hipFuncSetAttribute((const void*)mk_fwd, hipFuncAttributeMaxDynamicSharedMemorySize, LDS_BYTES) != hipSuccess) { fprintf(stderr, "kernel_launch: hipFuncSetAttribute failed\n"); grid = -1; return -1; }
        if (hipOccupancyMaxActiveBlocksPerMultiprocessor(&per_cu, (const void*)mk_fwd, NTHR, LDS_BYTES) != hipSuccess || per_cu < 1) fprintf(stderr, "kernel_launch: occupancy query reports %d blocks per CU\n", per_cu);
        (void)hipGetLastError();
        grid = cus;
    }
    if (grid < 0) return -1;
    if (do_memset) (void)hipMemsetAsync((char*)d_ws + WS_CTL, 0, CTL_ZERO_BYTES, stream);
    Args a{};
    for (int i = 0; i < 22; ++i) a.in[i] = (const float*)d_in[i];
    a.out = (float*)d_out; a.ws = (unsigned char*)d_ws; a.ph_lo = ph_lo; a.ph_hi = ph_hi;
    hipLaunchKernelGGL(mk_fwd, dim3(grid), dim3(NTHR), LDS_BYTES, stream, a);
    return 0;
}
}

extern "C" void kernel_launch(void* const* d_in, const int* in_sizes, int n_in, void* d_out, int out_size, void* d_ws, size_t ws_size, hipStream_t stream) {
    (void)in_sizes; (void)n_in; (void)out_size;
    (void)mk::launch_mk(d_in, d_out, d_ws, ws_size, stream, 0, mk::N_PHASES, true);
}
```

```cpp
#include <hip/hip_runtime.h>
#include <hip/hip_bf16.h>
#include <cstdio>
#include <cstdint>
#include <cmath>

constexpr size_t MiB_ = 1u << 20;
constexpr size_t WS_CTL = 0, CTL_ZERO_BYTES = 400 * 1024;
constexpr size_t WS_WIN = 1 * MiB_;
constexpr size_t WS_WOUT = 15 * MiB_;
constexpr size_t WS_WGU = 19 * MiB_;
constexpr size_t WS_WDN = 83 * MiB_;
constexpr size_t WS_WPP = 115 * MiB_;
constexpr size_t WS_WPG = 116 * MiB_;
constexpr int MK_T = 16384, MK_NB = 4, MK_TFULL = 32768;
constexpr size_t WS_GSTRIDE = 196 * MiB_;
constexpr size_t WS_Z = 120 * MiB_;
constexpr size_t ZSLOT = 16 * MiB_;
constexpr size_t WS_XN = 232 * MiB_;
constexpr size_t WS_OA = 264 * MiB_;
constexpr size_t WS_MISC = 296 * MiB_;
constexpr size_t WS_END = 512 * MiB_;


__device__ __forceinline__ int opaque_tid() { int t = threadIdx.x; asm volatile("" : "+v"(t)); return t; }
namespace pg8 {
#define PG8_LAS __attribute__((address_space(3)))
typedef unsigned short bf16_t;
typedef short bf16x8 __attribute__((ext_vector_type(8)));
typedef float f32x4 __attribute__((ext_vector_type(4)));
typedef float f32x2 __attribute__((ext_vector_type(2)));
typedef unsigned u32x4 __attribute__((ext_vector_type(4)));
typedef unsigned u32x2 __attribute__((ext_vector_type(2)));
constexpr int BM = 256, BK = 64, HALF = 128, HTB = HALF * BK * 2  , STAGE_BYTES = 8 * HTB, NXCD = 8, WGM = 4;

__host__ __device__ __forceinline__ int lds_byte(int r, int c) { const int st = (r >> 4) * 2 + (c >> 5), rr = r & 15, cc = c & 31, ob = rr * 64 + cc * 2; return st * 1024 + (ob ^ (((ob >> 9) & 1) << 5)); }
__host__ __device__ __forceinline__ void stage_rc(int b, int& R, int& C) { const int st = b / 1024, sb = b % 1024, swz = sb ^ (((sb >> 9) & 1) << 5); R = (st >> 1) * 16 + swz / 64; C = (st & 1) * 32 + (swz % 64) / 2; }
__host__ __device__ __forceinline__ int perm32(int rho) { const int n = rho >> 4, i = rho & 15; return 8 * (i >> 2) + 4 * n + (i & 3); }

struct Unit { int pm, pn, e; };
struct Gemm { const bf16_t* A; const bf16_t* Bt; int K; size_t estride; };

struct StaticOrder {
    int nM, nN, nwg, G, c;
    __device__ void init(int M, int N, int G_, int c_) { nM = M / BM; nN = N / BM; nwg = nM * nN; G = G_; c = c_; }
    __device__ bool next(int i, Unit& u) const {
        const long L = (long)i * G + c; if (L >= nwg) return false;
        int wgid = (int)L; { const int q = nwg / NXCD, r = nwg % NXCD, xcd = wgid % NXCD, off = wgid / NXCD; wgid = (xcd < r ? xcd * (q + 1) : r * (q + 1) + (xcd - r) * q) + off; }
        const int nig = WGM * nN, gid = wgid / nig, fm = gid * WGM, gsz = (nM - fm) < WGM ? (nM - fm) : WGM;
        u.pm = fm + ((wgid % nig) % gsz); u.pn = (wgid % nig) / gsz; u.e = 0; return true;
    }
};
struct RowIdent { __device__ __forceinline__ unsigned operator()(const Unit& u, int r) const { return (unsigned)(u.pm * BM + r); } };

typedef __bf16 bf16x2_t __attribute__((ext_vector_type(2)));
__device__ __forceinline__ unsigned cvt_pk_bf16(float lo, float hi) { f32x2 v = {lo, hi}; bf16x2_t b = __builtin_convertvector(v, bf16x2_t); return __builtin_bit_cast(unsigned, b); }
__device__ __forceinline__ float bf_lo(unsigned w) { return __uint_as_float(w << 16); }
__device__ __forceinline__ float bf_hi(unsigned w) { return __uint_as_float(w & 0xffff0000u); }
__device__ __forceinline__ float fsigm(float x) { return __builtin_amdgcn_rcpf(1.f + __builtin_amdgcn_exp2f(-1.4426950408889634f * x)); }

struct EpiBf16 {
    static constexpr bool PERM = true;
    bf16_t* O; int ldc; int split_cols; size_t split_stride;
    __device__ __forceinline__ void operator()(const f32x4 (&acc)[2][2][4][2], const Unit& u, int wr, int wc, int fr, int fq) const {
        const int row0 = u.pm * BM + wr * 64 + fr; int colt = u.pn * BM; bf16_t* base = O;
        if (split_cols) { const int t = colt / split_cols; base += (size_t)t * split_stride; colt -= t * split_cols; }
        const int col0 = colt + wc * 32 + 8 * fq;
#pragma unroll
        for (int ai = 0; ai < 2; ++ai)
#pragma unroll
            for (int m = 0; m < 4; ++m) { bf16_t* rowp = base + (size_t)(row0 + ai * HALF + m * 16) * ldc + col0;
#pragma unroll
                for (int bj = 0; bj < 2; ++bj) { const f32x4 v0 = acc[ai][bj][m][0], v1 = acc[ai][bj][m][1];
                    u32x4 w; w.x = cvt_pk_bf16(v0[0], v0[1]); w.y = cvt_pk_bf16(v0[2], v0[3]); w.z = cvt_pk_bf16(v1[0], v1[1]); w.w = cvt_pk_bf16(v1[2], v1[3]);
                    __builtin_nontemporal_store(w, (u32x4*)(rowp + bj * HALF)); } }
    }
};
struct EpiInProjQK {
    static constexpr bool PERM = true;
    bf16_t* O; size_t split_stride; PG8_LAS float* xch;
    __device__ __forceinline__ void operator()(f32x4 (&acc)[2][2][4][2], const Unit& u, int wr, int wc, int fr, int fq) const {
        const int row0 = u.pm * BM + wr * 64 + fr; int colt = u.pn * BM; const int t = colt >> 9; bf16_t* base = O + (size_t)t * split_stride; colt -= t << 9;
        const int col0 = colt + wc * 32 + 8 * fq;
        if (t == 4 || t == 5) {
            const PG8_LAS float* gsrc = xch + 2048 + (t - 4) * 64 + (wc & 1) * 32 + 8 * fq; const float sc = (t == 4) ? 0.125f * 1.4426950408889634f : 1.f;
#pragma unroll
            for (int ai = 0; ai < 2; ++ai)
#pragma unroll
                for (int m = 0; m < 4; ++m) {
#pragma unroll
                    for (int bj = 0; bj < 2; ++bj) { const f32x4 v0 = acc[ai][bj][m][0], v1 = acc[ai][bj][m][1];
                        float ss = ((v0[0] * v0[0] + v0[1] * v0[1]) + (v0[2] * v0[2] + v0[3] * v0[3])) + ((v1[0] * v1[0] + v1[1] * v1[1]) + (v1[2] * v1[2] + v1[3] * v1[3]));
                        ss += __shfl_xor(ss, 16); ss += __shfl_xor(ss, 32);
                        if (fq == 0) xch[((ai * HALF + wr * 64 + m * 16 + fr) * 2 + bj) * 4 + wc] = ss; }
                    asm volatile("" ::: "memory"); }
            asm volatile("s_waitcnt lgkmcnt(0)" ::: "memory"); __builtin_amdgcn_s_barrier(); asm volatile("" ::: "memory");
#pragma unroll
            for (int ai = 0; ai < 2; ++ai)
#pragma unroll
                for (int m = 0; m < 4; ++m) {
#pragma unroll
                    for (int bj = 0; bj < 2; ++bj) { const PG8_LAS float* xp = xch + ((ai * HALF + wr * 64 + m * 16 + fr) * 2 + bj) * 4 + (wc & 2);
                        const float r = rsqrtf((xp[0] + xp[1]) * (1.f / 64.f) + 1e-6f) * sc; const f32x4 g0 = *(const PG8_LAS f32x4*)gsrc, g1 = *(const PG8_LAS f32x4*)(gsrc + 4);
                        acc[ai][bj][m][0] *= g0 * r; acc[ai][bj][m][1] *= g1 * r; }
                    asm volatile("" ::: "memory"); }
        }
#pragma unroll
        for (int ai = 0; ai < 2; ++ai)
#pragma unroll
            for (int m = 0; m < 4; ++m) { bf16_t* rowp = base + (size_t)(row0 + ai * HALF + m * 16) * 512 + col0;
#pragma unroll
                for (int bj = 0; bj < 2; ++bj) { const f32x4 v0 = acc[ai][bj][m][0], v1 = acc[ai][bj][m][1];
                    u32x4 w; w.x = cvt_pk_bf16(v0[0], v0[1]); w.y = cvt_pk_bf16(v0[2], v0[3]); w.z = cvt_pk_bf16(v1[0], v1[1]); w.w = cvt_pk_bf16(v1[2], v1[3]);
                    *(u32x4*)(rowp + bj * HALF) = w; }
                asm volatile("" ::: "memory"); }
    }
};
struct EpiBf16RowSS {
    static constexpr bool PERM = true;
    bf16_t* O; int ldc; float* rowss;
    __device__ __forceinline__ void operator()(const f32x4 (&acc)[2][2][4][2], const Unit& u, int wr, int wc, int fr, int fq) const {
        const int row0 = u.pm * BM + wr * 64 + fr; const int col0 = u.pn * BM + wc * 32 + 8 * fq;
#pragma unroll
        for (int ai = 0; ai < 2; ++ai)
#pragma unroll
            for (int m = 0; m < 4; ++m) { const int row = row0 + ai * HALF + m * 16; bf16_t* rowp = O + (size_t)row * ldc + col0; float ss = 0.f;
#pragma unroll
                for (int bj = 0; bj < 2; ++bj) { const f32x4 v0 = acc[ai][bj][m][0], v1 = acc[ai][bj][m][1];
                    ss += (v0[0] * v0[0] + v0[1] * v0[1]) + (v0[2] * v0[2] + v0[3] * v0[3]) + (v1[0] * v1[0] + v1[1] * v1[1]) + (v1[2] * v1[2] + v1[3] * v1[3]);
                    u32x4 w; w.x = cvt_pk_bf16(v0[0], v0[1]); w.y = cvt_pk_bf16(v0[2], v0[3]); w.z = cvt_pk_bf16(v1[0], v1[1]); w.w = cvt_pk_bf16(v1[2], v1[3]);
                    *(u32x4*)(rowp + bj * HALF) = w; }
                ss += __shfl_xor(ss, 16); ss += __shfl_xor(ss, 32);
                if (fq == 0) rowss[(size_t)row * 16 + u.pn * 4 + wc] = ss;
                asm volatile("" ::: "memory"); }
    }
};
struct EpiSiluMul {
    static constexpr bool PERM = true;
    bf16_t* O;
    const PG8_LAS int* tb; const PG8_LAS int* cnt; const float* er;
    __device__ __forceinline__ void operator()(const f32x4 (&acc)[2][2][4][2], const Unit& u, int wr, int wc, int fr, int fq) const {
        const int row0 = u.pm * BM + wr * 64 + fr; const int col0 = u.pn * HALF + wc * 32 + 8 * fq; const int p0 = (u.pm - tb[u.e]) * BM + wr * 64 + fr, n = cnt[u.e];
        float rs[2][4];
#pragma unroll
        for (int ai = 0; ai < 2; ++ai)
#pragma unroll
            for (int m = 0; m < 4; ++m) { const int pos = p0 + ai * HALF + m * 16; const float rl = er[(size_t)u.e * MK_T + pos]; rs[ai][m] = (pos < n) ? rl : 0.f; }
#pragma unroll
        for (int ai = 0; ai < 2; ++ai)
#pragma unroll
            for (int m = 0; m < 4; ++m) { bf16_t* rowp = O + (size_t)(row0 + ai * HALF + m * 16) * 512 + col0; float h[8]; const float r = rs[ai][m];
#pragma unroll
                for (int nn = 0; nn < 2; ++nn)
#pragma unroll
                    for (int i = 0; i < 4; ++i) { const float g = r * acc[ai][0][m][nn][i], up = r * acc[ai][1][m][nn][i]; h[nn * 4 + i] = g * fsigm(g) * up; }
                u32x4 w; w.x = cvt_pk_bf16(h[0], h[1]); w.y = cvt_pk_bf16(h[2], h[3]); w.z = cvt_pk_bf16(h[4], h[5]); w.w = cvt_pk_bf16(h[6], h[7]);
                *(u32x4*)rowp = w; }
    }
};
struct EpiResB {
    static constexpr bool PERM = true;
    const float* basef; const bf16_t* baseb; bf16_t* out;
    __device__ __forceinline__ void operator()(const f32x4 (&acc)[2][2][4][2], const Unit& u, int wr, int wc, int fr, int fq) const {
        const int col0 = u.pn * BM + wc * 32 + 8 * fq;
        if (!basef) {
            u32x4 w[2][4][2];
#pragma unroll
            for (int ai = 0; ai < 2; ++ai) { const size_t off0 = (size_t)(u.pm * BM + ai * HALF + wr * 64 + fr) * 1024 + col0;
#pragma unroll
                for (int m = 0; m < 4; ++m)
#pragma unroll
                    for (int bj = 0; bj < 2; ++bj) w[ai][m][bj] = *(const u32x4*)(baseb + off0 + (size_t)m * 16 * 1024 + bj * HALF); }
#pragma unroll
            for (int ai = 0; ai < 2; ++ai) { const size_t off0 = (size_t)(u.pm * BM + ai * HALF + wr * 64 + fr) * 1024 + col0;
#pragma unroll
                for (int m = 0; m < 4; ++m)
#pragma unroll
                    for (int bj = 0; bj < 2; ++bj) { const u32x4 r = w[ai][m][bj];
                        const f32x4 v0 = (f32x4){bf_lo(r.x), bf_hi(r.x), bf_lo(r.y), bf_hi(r.y)} + acc[ai][bj][m][0], v1 = (f32x4){bf_lo(r.z), bf_hi(r.z), bf_lo(r.w), bf_hi(r.w)} + acc[ai][bj][m][1];
                        u32x4 o; o.x = cvt_pk_bf16(v0[0], v0[1]); o.y = cvt_pk_bf16(v0[2], v0[3]); o.z = cvt_pk_bf16(v1[0], v1[1]); o.w = cvt_pk_bf16(v1[2], v1[3]);
                        *(u32x4*)(out + off0 + (size_t)m * 16 * 1024 + bj * HALF) = o; }
                asm volatile("" ::: "memory"); }
            return;
        }
#pragma unroll
        for (int ai = 0; ai < 2; ++ai) {
            const size_t off0 = (size_t)(u.pm * BM + ai * HALF + wr * 64 + fr) * 1024 + col0;
            f32x4 b0[4][2], b1[4][2];
#pragma unroll
            for (int m = 0; m < 4; ++m)
#pragma unroll
                for (int bj = 0; bj < 2; ++bj) { b0[m][bj] = *(const f32x4*)(basef + off0 + (size_t)m * 16 * 1024 + bj * HALF); b1[m][bj] = *(const f32x4*)(basef + off0 + (size_t)m * 16 * 1024 + bj * HALF + 4); }
#pragma unroll
            for (int m = 0; m < 4; ++m)
#pragma unroll
                for (int bj = 0; bj < 2; ++bj) { const f32x4 v0 = b0[m][bj] + acc[ai][bj][m][0], v1 = b1[m][bj] + acc[ai][bj][m][1];
                    u32x4 o; o.x = cvt_pk_bf16(v0[0], v0[1]); o.y = cvt_pk_bf16(v0[2], v0[3]); o.z = cvt_pk_bf16(v1[0], v1[1]); o.w = cvt_pk_bf16(v1[2], v1[3]);
                    *(u32x4*)(out + off0 + (size_t)m * 16 * 1024 + bj * HALF) = o; }
            asm volatile("" ::: "memory");
        }
    }
};
struct EpiScatter {
    static constexpr bool PERM = false;
    float* H; const int* row_tok; const float* row_w;
    __device__ __forceinline__ void operator()(const f32x4 (&acc)[2][2][4][2], const Unit& u, int wr, int wc, int fr, int fq) const {
        const int col0 = u.pn * BM + wc * 32 + 4 * fq;
#pragma unroll
        for (int ai = 0; ai < 2; ++ai)
#pragma unroll
            for (int m = 0; m < 4; ++m) { const int sr = u.pm * BM + ai * HALF + wr * 64 + m * 16 + fr; const int tok = row_tok[sr]; const float w = row_w[sr];
                if (tok >= 0) { float* hp = H + (size_t)tok * 1024 + col0;
#pragma unroll
                    for (int bj = 0; bj < 2; ++bj)
#pragma unroll
                        for (int n = 0; n < 2; ++n)
#pragma unroll
                            for (int i = 0; i < 4; ++i) __hip_atomic_fetch_add(hp + bj * HALF + n * 16 + i, w * acc[ai][bj][m][n][i], __ATOMIC_RELAXED, __HIP_MEMORY_SCOPE_AGENT); } }
    }
};
struct EpiPleGate {
    static constexpr bool PERM = true;
    float* outf; bf16_t* outb; const bf16_t* B2; const bf16_t* P; const float* rowss; const float* gain;
    __device__ __forceinline__ void operator()(const f32x4 (&acc)[2][2][4][2], const Unit& u, int wr, int wc, int fr, int fq) const {
        const int col0 = u.pn * BM + wc * 32 + 8 * fq;
        f32x4 g0[2], g1[2];
#pragma unroll
        for (int bj = 0; bj < 2; ++bj) { g0[bj] = *(const f32x4*)(gain + col0 + bj * HALF); g1[bj] = *(const f32x4*)(gain + col0 + bj * HALF + 4); }
#pragma unroll
        for (int ai = 0; ai < 2; ++ai) {
            const int row0 = u.pm * BM + ai * HALF + wr * 64 + fr; const size_t off0 = (size_t)row0 * 1024 + col0;
            u32x4 hw[4][2], pw[4][2]; float rq[4];
#pragma unroll
            for (int m = 0; m < 4; ++m) { rq[m] = rowss[row0 + m * 16];
#pragma unroll
                for (int bj = 0; bj < 2; ++bj) { hw[m][bj] = *(const u32x4*)(B2 + off0 + (size_t)m * 16 * 1024 + bj * HALF); pw[m][bj] = *(const u32x4*)(P + off0 + (size_t)m * 16 * 1024 + bj * HALF); } }
#pragma unroll
            for (int m = 0; m < 4; ++m) { const float rstd = rsqrtf(rq[m] * (1.f / 1024.f) + 1e-6f);
#pragma unroll
                for (int bj = 0; bj < 2; ++bj) { const size_t off = off0 + (size_t)m * 16 * 1024 + bj * HALF; const u32x4 h = hw[m][bj], p = pw[m][bj]; const f32x4 a0 = acc[ai][bj][m][0], a1 = acc[ai][bj][m][1];
                    f32x4 o0, o1;
                    o0[0] = bf_lo(h.x) + bf_lo(p.x) * rstd * g0[bj][0] * fsigm(a0[0]); o0[1] = bf_hi(h.x) + bf_hi(p.x) * rstd * g0[bj][1] * fsigm(a0[1]);
                    o0[2] = bf_lo(h.y) + bf_lo(p.y) * rstd * g0[bj][2] * fsigm(a0[2]); o0[3] = bf_hi(h.y) + bf_hi(p.y) * rstd * g0[bj][3] * fsigm(a0[3]);
                    o1[0] = bf_lo(h.z) + bf_lo(p.z) * rstd * g1[bj][0] * fsigm(a1[0]); o1[1] = bf_hi(h.z) + bf_hi(p.z) * rstd * g1[bj][1] * fsigm(a1[1]);
                    o1[2] = bf_lo(h.w) + bf_lo(p.w) * rstd * g1[bj][2] * fsigm(a1[2]); o1[3] = bf_hi(h.w) + bf_hi(p.w) * rstd * g1[bj][3] * fsigm(a1[3]);
                    if (outf) { __builtin_nontemporal_store(o0, (f32x4*)(outf + off)); __builtin_nontemporal_store(o1, (f32x4*)(outf + off + 4)); }
                    else { u32x4 w; w.x = cvt_pk_bf16(o0[0], o0[1]); w.y = cvt_pk_bf16(o0[2], o0[3]); w.z = cvt_pk_bf16(o1[0], o1[1]); w.w = cvt_pk_bf16(o1[2], o1[3]); *(u32x4*)(outb + off) = w; } } }
            asm volatile("" ::: "memory");
        }
    }
};

template <class Epi, class Sched, class RowMap, bool ALIGN_EPI>
__device__ __forceinline__ void gemm_phase(PG8_LAS unsigned char* lds, const Gemm g, const Sched& S, const Epi& E, const RowMap& RM) {
    const int tid = opaque_tid(), wid = __builtin_amdgcn_readfirstlane(tid >> 6), lane = tid & 63, wr = wid >> 2, wc = wid & 3, fr = lane & 15, fq = lane >> 4;
    const int K = g.K, nt = K / BK;
    int Ra[2], Ca[2]; unsigned voffB[2];
#pragma unroll
    for (int i = 0; i < 2; ++i) { int R, C; stage_rc(tid * 16 + i * 8192, R, C); const int Rb = Epi::PERM ? ((R & ~31) + perm32(R & 31)) : R; Ra[i] = R; Ca[i] = C; voffB[i] = (unsigned)(Rb * K + C) * 2u; }
    constexpr unsigned kstep = BK * 2;
    const unsigned hstep = (unsigned)HALF * (unsigned)K * 2u;
    const unsigned tstep = 2u * hstep;
    const unsigned ldsw = (unsigned)wid * 1024u;
    const int aoff = lds_byte(wr * 64 + fr, fq * 8), boff = lds_byte(wc * 32 + fr, fq * 8);
#define PG8_SA(b, h) (((b) * 2 + (h)) * HTB)
#define PG8_SB(b, h) ((4 + (b) * 2 + (h)) * HTB)
#define PG8_STAGE(bufoff, gbase, uoff, voff) do { _Pragma("unroll") for (int _i = 0; _i < 2; ++_i) \
        __builtin_amdgcn_global_load_lds((const unsigned*)((gbase) + (size_t)((uoff) + (voff)[_i])), (PG8_LAS unsigned*)(lds + (bufoff) + ldsw + _i * 8192), 16, 0, 0); } while (0)
#define PG8_MKOFF(dst, U) do { _Pragma("unroll") for (int _h = 0; _h < 2; ++_h) _Pragma("unroll") for (int _i = 0; _i < 2; ++_i) dst[_h][_i] = (RM(U, _h * HALF + Ra[_i]) * (unsigned)K + (unsigned)Ca[_i]) * 2u; } while (0)
#define PG8_LDA(dst, b, h) do { _Pragma("unroll") for (int m = 0; m < 4; ++m) _Pragma("unroll") for (int k = 0; k < 2; ++k) dst[m][k] = *(const PG8_LAS bf16x8*)(lds + PG8_SA(b, h) + aoff + m * 2048 + k * 1024); } while (0)
#define PG8_LDB(dst, b, h) do { _Pragma("unroll") for (int n = 0; n < 2; ++n) _Pragma("unroll") for (int k = 0; k < 2; ++k) dst[n][k] = *(const PG8_LAS bf16x8*)(lds + PG8_SB(b, h) + boff + n * 2048 + k * 1024); } while (0)
#define PG8_MMA(ai, bj, At, Bt) do { __builtin_amdgcn_s_setprio(1); _Pragma("unroll") for (int m = 0; m < 4; ++m) _Pragma("unroll") for (int n = 0; n < 2; ++n) _Pragma("unroll") for (int k = 0; k < 2; ++k) \
        acc[ai][bj][m][n] = __builtin_amdgcn_mfma_f32_16x16x32_bf16(Bt[n][k], At[m][k], acc[ai][bj][m][n], 0, 0, 0); __builtin_amdgcn_s_setprio(0); } while (0)
#define PG8_WAIT_V(n) asm volatile("s_waitcnt vmcnt(" #n ")" ::: "memory")
#define PG8_WAIT_L(n) asm volatile("s_waitcnt lgkmcnt(" #n ")" ::: "memory")
#define PG8_BAR __builtin_amdgcn_s_barrier()
#define PG8_SCHED __builtin_amdgcn_sched_barrier(0)
    Unit cur, nxt; int ui = 0;
    if (!S.next(0, cur)) return;
    f32x4 acc[2][2][4][2];
#pragma unroll
    for (int a = 0; a < 2; ++a)
#pragma unroll
        for (int b = 0; b < 2; ++b)
#pragma unroll
            for (int m = 0; m < 4; ++m)
#pragma unroll
                for (int n = 0; n < 2; ++n) acc[a][b][m][n] = (f32x4){0.f, 0.f, 0.f, 0.f};
    bf16x8 At[4][2], B0[2][2], B1[2][2];
    unsigned ao[2][2], no[2][2];
    PG8_MKOFF(ao, cur);
    const char* const gA = (const char*)g.A; const char* const gB = (const char*)g.Bt;
    unsigned cB = (unsigned)cur.e * (unsigned)g.estride + (unsigned)cur.pn * tstep;
    PG8_STAGE(PG8_SB(0, 0), gB, cB, voffB); PG8_STAGE(PG8_SB(0, 1), gB, cB + hstep, voffB); PG8_STAGE(PG8_SA(0, 0), gA, 0u, ao[0]); PG8_STAGE(PG8_SA(0, 1), gA, 0u, ao[1]);
    if (wr == 1) PG8_BAR;
    PG8_WAIT_V(2); PG8_BAR;
    PG8_STAGE(PG8_SB(1, 0), gB, cB + kstep, voffB); PG8_STAGE(PG8_SA(1, 0), gA, kstep, ao[0]); PG8_STAGE(PG8_SB(1, 1), gB, cB + hstep + kstep, voffB);
    PG8_WAIT_V(6); PG8_BAR;
    for (;;) {
        const bool has_next = S.next(ui + 1, nxt);
        if (has_next) { PG8_MKOFF(no, nxt); } else {
#pragma unroll
            for (int h = 0; h < 2; ++h)
#pragma unroll
                for (int i = 0; i < 2; ++i) no[h][i] = ao[h][i]; }
        const unsigned nB = has_next ? (unsigned)nxt.e * (unsigned)g.estride + (unsigned)nxt.pn * tstep : cB;
#pragma unroll 1
        for (int t = 0; t < nt; t += 2) {
            const bool last = (t == nt - 2);
            const unsigned a1 = (unsigned)(t + 1) * kstep;
            const unsigned a2 = last ? 0u : (unsigned)(t + 2) * kstep, b2 = last ? nB : cB + (unsigned)(t + 2) * kstep;
            const unsigned a3 = a2 + kstep, b3 = b2 + kstep;
            PG8_LDB(B0, 0, 0); PG8_LDB(B1, 0, 1); PG8_SCHED; PG8_LDA(At, 0, 0); PG8_STAGE(PG8_SA(1, 1), gA, a1, ao[1]);
            if (last) { _Pragma("unroll") for (int h = 0; h < 2; ++h) _Pragma("unroll") for (int i = 0; i < 2; ++i) ao[h][i] = no[h][i]; }
            PG8_WAIT_V(8); PG8_WAIT_L(0); PG8_BAR; PG8_MMA(0, 0, At, B0); PG8_MMA(0, 1, At, B1); PG8_BAR; PG8_SCHED;
            PG8_LDA(At, 0, 1); PG8_STAGE(PG8_SB(0, 0), gB, b2, voffB); PG8_STAGE(PG8_SB(0, 1), gB, b2 + hstep, voffB); PG8_STAGE(PG8_SA(0, 0), gA, a2, ao[0]);
            PG8_WAIT_V(8); PG8_WAIT_L(0); PG8_BAR; PG8_MMA(1, 0, At, B0); PG8_MMA(1, 1, At, B1); PG8_BAR; PG8_SCHED;
            PG8_LDB(B0, 1, 0); PG8_LDB(B1, 1, 1); PG8_SCHED; PG8_LDA(At, 1, 0); PG8_STAGE(PG8_SA(0, 1), gA, a2, ao[1]);
            PG8_WAIT_V(8); PG8_WAIT_L(0); PG8_BAR; PG8_MMA(0, 0, At, B0); PG8_MMA(0, 1, At, B1); PG8_BAR; PG8_SCHED;
            PG8_LDA(At, 1, 1); PG8_STAGE(PG8_SB(1, 0), gB, b3, voffB); PG8_STAGE(PG8_SB(1, 1), gB, b3 + hstep, voffB); PG8_STAGE(PG8_SA(1, 0), gA, a3, ao[0]);
            PG8_WAIT_V(8); PG8_WAIT_L(0); PG8_BAR; PG8_MMA(1, 0, At, B0); PG8_MMA(1, 1, At, B1); PG8_BAR; PG8_SCHED;
        }
        if constexpr (ALIGN_EPI) { if (wr == 0) PG8_BAR; }
        E(acc, cur, wr, wc, fr, fq);
        if (!has_next) break;
#pragma unroll
        for (int a = 0; a < 2; ++a)
#pragma unroll
            for (int b = 0; b < 2; ++b)
#pragma unroll
                for (int m = 0; m < 4; ++m)
#pragma unroll
                    for (int n = 0; n < 2; ++n) acc[a][b][m][n] = (f32x4){0.f, 0.f, 0.f, 0.f};
        cur = nxt; cB = nB; ++ui;
        if constexpr (ALIGN_EPI) { if (wr == 1) PG8_BAR; }
    }
    PG8_WAIT_V(0);
    if constexpr (!ALIGN_EPI) { if (wr == 0) PG8_BAR; }
    PG8_BAR;
#undef PG8_SA
#undef PG8_SB
#undef PG8_STAGE
#undef PG8_MKOFF
#undef PG8_LDA
#undef PG8_LDB
#undef PG8_MMA
#undef PG8_WAIT_V
#undef PG8_WAIT_L
#undef PG8_BAR
#undef PG8_SCHED
}
}


#include <hip/hip_bf16.h>
#include <cmath>
namespace attn_body {
using bf16=__hip_bfloat16;
using bf16x8=__attribute__((ext_vector_type(8)))short;
using s16x4=__attribute__((ext_vector_type(4)))short;
using f32x16=__attribute__((ext_vector_type(16)))float;
using u32x4=__attribute__((ext_vector_type(4)))unsigned;
constexpr int BATCH=8,SEQ=4096,D=64;
constexpr int PQ=512,PK=512,PV=512,PO=1024;
constexpr int NW=8,QBLK=32,QB=QBLK*NW,KVBLK=64,NQB=SEQ/QB;
constexpr int ATTN_UNIT_ROWS=QB;
__device__ __forceinline__ int crow(int r,int hi){return (r&3)+8*(r>>2)+4*hi;}
#define SBAR() __builtin_amdgcn_sched_barrier(0)
__device__ __forceinline__ void cmask(f32x16&p0,f32x16&p1,int jb,int qrel,int hi){
  const float NEG=-INFINITY; int kb=64*jb+4*hi;
  #pragma unroll
  for(int r=0;r<16;++r){int kv=kb+(r&3)+8*(r>>2); if(kv>qrel)p0[r]=NEG; if(kv+32>qrel)p1[r]=NEG;}
}

constexpr int NSLOT=3, SLOTB=8192;
constexpr int VSLOTB=2*SLOTB;
constexpr int LDS_K=0, LDS_V=NSLOT*SLOTB, LDS_WS=LDS_V+NSLOT*VSLOTB, LDS_OST=LDS_WS+NW*64*4, LDS_BYTES=LDS_OST+NW*4096;
constexpr float C2=0.125f*1.4426950408889634f;
__device__ __forceinline__ void glds16(const void*gsrc,unsigned lds_dst){unsigned keep;
  asm volatile("s_mov_b32 %0, m0\n\ts_mov_b32 m0, %2\n\ts_nop 0\n\tglobal_load_lds_dwordx4 %1, off\n\ts_mov_b32 m0, %0":"=&s"(keep):"v"(gsrc),"s"(lds_dst):"memory");}
__device__ __forceinline__ float max3f(float a,float b,float c){float r;asm("v_max3_f32 %0, %1, %2, %3":"=v"(r):"v"(a),"v"(b),"v"(c));return r;}
__device__ __forceinline__ float max2f(float a,float b){float r;asm("v_max_f32_e32 %0, %1, %2":"=v"(r):"v"(a),"v"(b));return r;}
__device__ __forceinline__ float fadd_s(float a,float b){float r;asm("v_add_f32_e32 %0, %1, %2":"=v"(r):"v"(a),"v"(b));return r;}
__device__ __forceinline__ float fsub_s(float a,float b){float r;asm("v_sub_f32_e32 %0, %1, %2":"=v"(r):"v"(a),"v"(b));return r;}
typedef float f32x2_t __attribute__((ext_vector_type(2))); typedef __bf16 bf16x2_t __attribute__((ext_vector_type(2)));
__device__ __forceinline__ unsigned cvtpk_s(float lo,float hi){f32x2_t v={lo,hi};bf16x2_t b=__builtin_convertvector(v,bf16x2_t);return __builtin_bit_cast(unsigned,b);}
#define WAIT_BAR(N) asm volatile("s_waitcnt vmcnt(" #N ") lgkmcnt(0)\n\ts_barrier":::"memory")

__device__ __forceinline__ void qkt(f32x16&p0,f32x16&p1,const char*Kslot,const bf16x8*qr,const f32x16&negm,int r32,int hi){
  const char*kb=Kslot+hi*1024+r32*16;
  #pragma unroll
  for(int d0=0;d0<4;++d0){
    const bf16x8 b0=*reinterpret_cast<const bf16x8*>(kb+d0*2048);
    const bf16x8 b1=*reinterpret_cast<const bf16x8*>(kb+d0*2048+512);
    if(d0==0){p0=__builtin_amdgcn_mfma_f32_32x32x16_bf16(b0,qr[0],negm,0,0,0);p1=__builtin_amdgcn_mfma_f32_32x32x16_bf16(b1,qr[0],negm,0,0,0);}
    else{p0=__builtin_amdgcn_mfma_f32_32x32x16_bf16(b0,qr[d0],p0,0,0,0);p1=__builtin_amdgcn_mfma_f32_32x32x16_bf16(b1,qr[d0],p1,0,0,0);}}
}
typedef __attribute__((address_space(3))) const char* lds_cptr;
typedef short v4i16_t __attribute__((ext_vector_type(4)));
__device__ __forceinline__ void kload8(bf16x8*kf,lds_cptr kp){
  kf[0]=*(const __attribute__((address_space(3))) bf16x8*)(kp);      kf[1]=*(const __attribute__((address_space(3))) bf16x8*)(kp+512);
  kf[2]=*(const __attribute__((address_space(3))) bf16x8*)(kp+2048); kf[3]=*(const __attribute__((address_space(3))) bf16x8*)(kp+2560);
  kf[4]=*(const __attribute__((address_space(3))) bf16x8*)(kp+4096); kf[5]=*(const __attribute__((address_space(3))) bf16x8*)(kp+4608);
  kf[6]=*(const __attribute__((address_space(3))) bf16x8*)(kp+6144); kf[7]=*(const __attribute__((address_space(3))) bf16x8*)(kp+6656);
}
__device__ __forceinline__ void kload2(bf16x8*kf,lds_cptr kp,int j){ kf[2*j]=*(const __attribute__((address_space(3))) bf16x8*)(kp+j*2048); kf[2*j+1]=*(const __attribute__((address_space(3))) bf16x8*)(kp+j*2048+512); }
__device__ __forceinline__ s16x4 vtr(lds_cptr p){ return __builtin_bit_cast(s16x4,__builtin_amdgcn_ds_read_tr16_b64_v4i16((__attribute__((address_space(3))) v4i16_t*)p)); }
__device__ __forceinline__ float rowmax(const f32x16&p0,const f32x16&p1){
  float a=max3f(p0[0],p0[1],p1[0]),b=max3f(p0[2],p0[3],p1[1]);a=max3f(a,p1[2],p1[3]);
  #pragma unroll
  for(int r=4;r<16;r+=4){a=max3f(a,p0[r],p0[r+1]);b=max3f(b,p0[r+2],p0[r+3]);a=max3f(a,p1[r],p1[r+1]);b=max3f(b,p1[r+2],p1[r+3]);}
  const float m=max2f(a,b);
  auto rr=__builtin_amdgcn_permlane32_swap(__float_as_uint(m),__float_as_uint(m),false,false);
  return max2f(__uint_as_float(rr[0]),__uint_as_float(rr[1]));
}
__device__ __forceinline__ void pv(f32x16*o,int vb,bf16x8 pa0,bf16x8 pa1,bf16x8 pa2,bf16x8 pa3){
  #pragma unroll
  for(int d0=0;d0<2;++d0){s16x4 lo[4],hi[4];
    #pragma unroll
    for(int ks=0;ks<4;++ks){
      asm volatile("ds_read_b64_tr_b16 %0,%1 offset:%c2":"=&v"(lo[ks]):"v"(vb),"i"(d0*4096+ks*1024):"memory");
      asm volatile("ds_read_b64_tr_b16 %0,%1 offset:%c2":"=&v"(hi[ks]):"v"(vb),"i"(d0*4096+ks*1024+512):"memory");}
    asm volatile("s_waitcnt lgkmcnt(0)":::"memory");SBAR();
    #define PK(k) (bf16x8){lo[k][0],lo[k][1],lo[k][2],lo[k][3],hi[k][0],hi[k][1],hi[k][2],hi[k][3]}
    o[d0]=__builtin_amdgcn_mfma_f32_32x32x16_bf16(pa0,PK(0),o[d0],0,0,0);
    o[d0]=__builtin_amdgcn_mfma_f32_32x32x16_bf16(pa1,PK(1),o[d0],0,0,0);
    o[d0]=__builtin_amdgcn_mfma_f32_32x32x16_bf16(pa2,PK(2),o[d0],0,0,0);
    o[d0]=__builtin_amdgcn_mfma_f32_32x32x16_bf16(pa3,PK(3),o[d0],0,0,0);
    #undef PK
  }
}

#ifndef ATTN_STORE16
#define ATTN_STORE16(p,v) __builtin_nontemporal_store((v),(u32x4*)(p))
#endif
template<int THRL> __device__ __forceinline__ void attn_unit(int b,int qcol,int kcol,int vcol,int ocol,int qb,const bf16*Q,const bf16*__restrict__ K,const bf16*__restrict__ V,bf16*O,char*shm){
  const int tid=opaque_tid(),lane=tid&63,r32=lane&31,hi=lane>>5; const int wid=__builtin_amdgcn_readfirstlane(tid>>6);
  const long rowbase=(long)b*SEQ; const int q0=qb*QB;
  const bf16*Qw=Q+(rowbase+q0+wid*QBLK)*PQ+qcol;
  const bf16*Kh=K+rowbase*PK+kcol,*Vh=V+rowbase*PV+vcol;
  const unsigned lds0=(unsigned)(uintptr_t)shm;
  float*wsf=(float*)(shm+LDS_WS)+wid*64;
  const bf16*ksrc=Kh+(long)lane*PK+wid*8;
  const bf16*vsrc=Vh+(long)(16*(wid&3)+(lane>>2))*PV+(wid>>2)*32+(lane&3)*8;
  const unsigned kdst=lds0+LDS_K+wid*1024, vdst=lds0+LDS_V+wid*1024;
  #define DMA_K(t,slot) glds16(ksrc+(long)(t)*KVBLK*PK,(unsigned)__builtin_amdgcn_readfirstlane(kdst+(slot)))
  #define DMA_V(t,slot) do{ glds16(vsrc+(long)(t)*KVBLK*PV,(unsigned)__builtin_amdgcn_readfirstlane(vdst+2*(slot))); glds16(vsrc+64+(long)(t)*KVBLK*PV,(unsigned)__builtin_amdgcn_readfirstlane(vdst+8192+2*(slot))); }while(0)
  const int vb0=(int)(lds0+LDS_V)+((lane>>4)&1)*32+(lane&3)*8+(4*hi+((lane&15)>>2))*64;
  const char*Kbase=shm+LDS_K; bf16x8 kf[8];
  const lds_cptr shm3=(lds_cptr)shm; const lds_cptr kp0=shm3+LDS_K+hi*1024+r32*16; const lds_cptr vp0=shm3+LDS_V+((lane>>4)&1)*32+(lane&3)*8+(4*hi+((lane&15)>>2))*64;
  const int NT=(q0+QB)/KVBLK;
  DMA_K(0,0);DMA_V(0,0);DMA_K(1,SLOTB);
  bf16x8 qr[4];
  #pragma unroll
  for(int d0=0;d0<4;++d0)qr[d0]=*reinterpret_cast<const bf16x8*>(&Qw[(long)r32*PQ+d0*16+hi*8]);
  const lds_cptr qpark=shm3+LDS_OST+wid*4096+r32*128;
  #define QOFF(d0) ((((d0)*2+hi)^(r32&7))*16)
  #define QF(d0) (*(const __attribute__((address_space(3))) bf16x8*)(qpark+QOFF(d0)))
  _Pragma("unroll") for(int d0=0;d0<4;++d0) *(__attribute__((address_space(3))) bf16x8*)((__attribute__((address_space(3))) char*)qpark+QOFF(d0))=qr[d0];
  float mhat=0.f,l_reg=0.f;f32x16 o[4];o[0]=f32x16{};o[1]=f32x16{};o[2]=f32x16{};o[3]=f32x16{};f32x16 negm=f32x16{};asm volatile("":"+v"(negm));
  const int qrel=wid*QBLK+r32;
  #define CMASK(P0,P1,t) do{int jb_=(t)-(NT-4); if(jb_>=0)cmask(P0,P1,jb_,qrel,hi);}while(0)
  bool resc=false;
  #define START(P0,P1) do{ const float rm=rowmax(P0,P1); resc=false; \
    { const float dl=rm; mhat=fadd_s(mhat,dl); \
      _Pragma("unroll") for(int r=0;r<16;++r){P0[r]=fsub_s(P0[r],dl);P1[r]=fsub_s(P1[r],dl);} \
      _Pragma("unroll") for(int r=0;r<16;++r)negm[r]=-mhat; asm volatile("":"+v"(negm)); } \
    _Pragma("unroll") for(int r=0;r<16;++r)P0[r]=__builtin_amdgcn_exp2f(P0[r]); }while(0)
  #define RESC() do{ if(resc){ asm volatile("s_waitcnt lgkmcnt(0)":::"memory"); \
      _Pragma("unroll") for(int d_=0;d_<4;++d_) _Pragma("unroll") for(int r=0;r<16;++r)o[d_][r]*=wsf[crow(r,hi)]; } }while(0)
  f32x16 pA0,pA1,pB0,pB1;
  int sl_prev=0,sl_cur=0,sl_next=SLOTB;
  #define ROT() do{sl_prev=sl_cur;sl_cur=sl_next;sl_next=(sl_next==(NSLOT-1)*SLOTB)?0:sl_next+SLOTB;}while(0)
  DMA_K(2,2*SLOTB);
  WAIT_BAR(4);
  qkt(pA0,pA1,Kbase,qr,negm,r32,hi);asm volatile("s_nop 15\n\ts_nop 7":"+v"(pA0),"+v"(pA1));CMASK(pA0,pA1,0);
  START(pA0,pA1);
  _Pragma("unroll") for(int r=0;r<16;++r)pA1[r]=__builtin_amdgcn_exp2f(pA1[r]);
  WAIT_BAR(0);
  DMA_K(3,0);DMA_V(1,SLOTB);
  ROT();
  kload8(kf,kp0+sl_cur);
  WAIT_BAR(3);
  s16x4 vAlo,vAhi,vBlo,vBhi,vClo,vChi; u32x4 pw0,pw1,pw2,pw3;
  #define PKW(P,B) cvtpk_s(P[B],P[B+1])
  #define PAF(k) __builtin_bit_cast(bf16x8,pw##k)
  #define PIN(x) asm volatile("":"+v"(x))
  #define MX3(a,b,c) __builtin_fmaxf(__builtin_fmaxf((a),(b)),(c))
  #define GAPA(MF,A0,A1,A2,A3,W0,W1,PW) do{ MF; sacc+=A0; sacc+=A1; sacc+=A2; sacc+=A3; PIN(sacc); W0; W1; PIN(PW); SBAR(); }while(0)
  #define EX(v) __builtin_amdgcn_exp2f(v)
  #define VLD(bf,db,k) do{ bf##lo=vtr(vp_+((db)*4096+(k)*1024)); bf##hi=vtr(vp_+((db)*4096+(k)*1024+512)); }while(0)
  #define VF(bf) (bf16x8){bf##lo[0],bf##lo[1],bf##lo[2],bf##lo[3],bf##hi[0],bf##hi[1],bf##hi[2],bf##hi[3]}
  #define PVS(cur,nxt,db,k,ndb,nk,X,B) do{ VLD(nxt,ndb,nk); o[db]=__builtin_amdgcn_mfma_f32_32x32x16_bf16(PAF(k),VF(cur),o[db],0,0,0); X[B]=EX(X[B]); X[B+1]=EX(X[B+1]); PIN(X); SBAR(); }while(0)
  #define PVL(cur,db,k,X,B) do{ o[db]=__builtin_amdgcn_mfma_f32_32x32x16_bf16(PAF(k),VF(cur),o[db],0,0,0); X[B]=EX(X[B]); X[B+1]=EX(X[B+1]); PIN(X); SBAR(); }while(0)
  #define KRD(G,j) do{ if(G){ kload2(kf,kp0+sl_next,j); SBAR(); } }while(0)
  #define STEP(C0,C1,P0,P1,t,GK,GV,GL) do{ SBAR(); \
    const lds_cptr vp_=vp0+2*sl_prev; \
    bf16x8 qa_=qr[0]; SBAR(); float sacc=(P0[0]+P0[1]); \
    GAPA(C0=__builtin_amdgcn_mfma_f32_32x32x16_bf16(kf[0],qa_,negm,0,0,0), P0[2],P0[3],P0[4],P0[5],     pw0[0]=PKW(P0,0), pw0[1]=PKW(P0,2), pw0); \
    GAPA(C1=__builtin_amdgcn_mfma_f32_32x32x16_bf16(kf[1],qa_,negm,0,0,0), P0[6],P0[7],P0[8],P0[9],     pw0[2]=PKW(P0,4), pw0[3]=PKW(P0,6), pw0); \
    qa_=qr[1]; SBAR(); GAPA(C0=__builtin_amdgcn_mfma_f32_32x32x16_bf16(kf[2],qa_,C0,0,0,0),   P0[10],P0[11],P0[12],P0[13], pw1[0]=PKW(P0,8), pw1[1]=PKW(P0,10), pw1); \
    GAPA(C1=__builtin_amdgcn_mfma_f32_32x32x16_bf16(kf[3],qa_,C1,0,0,0),   P0[14],P0[15],P1[0],P1[1],   pw1[2]=PKW(P0,12),pw1[3]=PKW(P0,14), pw1); \
    qa_=qr[2]; SBAR(); GAPA(C0=__builtin_amdgcn_mfma_f32_32x32x16_bf16(kf[4],qa_,C0,0,0,0),   P1[2],P1[3],P1[4],P1[5],     pw2[0]=PKW(P1,0), pw2[1]=PKW(P1,2), pw2); \
    GAPA(C1=__builtin_amdgcn_mfma_f32_32x32x16_bf16(kf[5],qa_,C1,0,0,0),   P1[6],P1[7],P1[8],P1[9],     pw2[2]=PKW(P1,4), pw2[3]=PKW(P1,6), pw2); \
    qa_=qr[3]; VLD(vA,0,0); VLD(vB,1,0); SBAR(); GAPA(C0=__builtin_amdgcn_mfma_f32_32x32x16_bf16(kf[6],qa_,C0,0,0,0),   P1[10],P1[11],P1[12],P1[13], pw3[0]=PKW(P1,8), pw3[1]=PKW(P1,10), pw3); \
    GAPA(C1=__builtin_amdgcn_mfma_f32_32x32x16_bf16(kf[7],qa_,C1,0,0,0),   P1[14],P1[15],0.f,0.f,       pw3[2]=PKW(P1,12),pw3[3]=PKW(P1,14), pw3); \
    l_reg+=sacc; \
    if(GK){DMA_K((t)+3,sl_cur);} if(GV){DMA_V((t)+1,sl_next);} \
    CMASK(C0,C1,t); \
    { float a=MX3(C0[0],C0[1],C1[0]),b=MX3(C0[2],C0[3],C1[1]); a=MX3(a,C1[2],C1[3]); \
      _Pragma("unroll") for(int r=4;r<16;r+=4){a=MX3(a,C0[r],C0[r+1]);b=MX3(b,C0[r+2],C0[r+3]);a=MX3(a,C1[r],C1[r+1]);b=MX3(b,C1[r+2],C1[r+3]);} \
      float rm=__builtin_fmaxf(a,b); { auto rr=__builtin_amdgcn_permlane32_swap(__float_as_uint(rm),__float_as_uint(rm),false,false); rm=__builtin_fmaxf(__uint_as_float(rr[0]),__uint_as_float(rr[1])); } \
      resc=false; \
      if(__builtin_expect(__any(rm>(float)THRL),0)){ const float dl=__builtin_fmaxf(rm,0.f); mhat+=dl; \
        _Pragma("unroll") for(int r=0;r<16;++r){C0[r]-=dl;C1[r]-=dl;} \
        _Pragma("unroll") for(int r=0;r<16;++r)negm[r]=-mhat; asm volatile("":"+v"(negm)); \
        const float f=__builtin_amdgcn_exp2f(-dl); l_reg*=f; if(hi==0)wsf[r32]=f; resc=true; } } \
    SBAR(); \
    PVS(vA,vC,0,0, 2,0, C0,0); PVS(vB,vA,1,0, 3,0, C0,2); PVS(vC,vB,2,0, 0,1, C0,4); PVS(vA,vC,3,0, 1,1, C0,6); \
    KRD(GL,0); PVS(vB,vA,0,1, 2,1, C0,8); PVS(vC,vB,1,1, 3,1, C0,10); KRD(GL,1); PVS(vA,vC,2,1, 0,2, C0,12); PVS(vB,vA,3,1, 1,2, C0,14); \
    KRD(GL,2); PVS(vC,vB,0,2, 2,2, C1,0); PVS(vA,vC,1,2, 3,2, C1,2); KRD(GL,3); PVS(vB,vA,2,2, 0,3, C1,4); PVS(vC,vB,3,2, 1,3, C1,6); \
    PVS(vA,vC,0,3, 2,3, C1,8); PVS(vB,vA,1,3, 3,3, C1,10); PVL(vC,2,3, C1,12); PVL(vA,3,3, C1,14); \
    }while(0)
  int t=1;
  #undef CMASK
  #define CMASK(P0,P1,t) do{}while(0)
  for(;t+5<NT;t+=2){
    STEP(pB0,pB1,pA0,pA1,t,true,true,true);     WAIT_BAR(3); RESC(); ROT();
    STEP(pA0,pA1,pB0,pB1,t+1,true,true,true);   WAIT_BAR(3); RESC(); ROT();
  }
  #undef CMASK
  #define CMASK(P0,P1,t) do{int jb_=(t)-(NT-4); if(jb_>=0)cmask(P0,P1,jb_,qrel,hi);}while(0)
  #define ENDW(tt) do{ if((tt)+3<NT){WAIT_BAR(3);} else if((tt)+2<NT){WAIT_BAR(2);} else {WAIT_BAR(0);} }while(0)
  for(;t+1<NT;t+=2){
    STEP(pB0,pB1,pA0,pA1,t,(t+3<NT),(t+1<NT),(t+1<NT));       ENDW(t);   RESC(); ROT();
    STEP(pA0,pA1,pB0,pB1,t+1,(t+4<NT),(t+2<NT),(t+2<NT));     ENDW(t+1); RESC(); ROT();
  }
  STEP(pB0,pB1,pA0,pA1,NT-1,false,false,false); RESC();
  { float sacc=pB0[0]+pB0[1]; _Pragma("unroll") for(int r=2;r<16;++r)sacc+=pB0[r]; _Pragma("unroll") for(int r=0;r<16;++r)sacc+=pB1[r]; l_reg+=sacc;
    pw0=(u32x4){PKW(pB0,0),PKW(pB0,2),PKW(pB0,4),PKW(pB0,6)};pw1=(u32x4){PKW(pB0,8),PKW(pB0,10),PKW(pB0,12),PKW(pB0,14)};pw2=(u32x4){PKW(pB1,0),PKW(pB1,2),PKW(pB1,4),PKW(pB1,6)};pw3=(u32x4){PKW(pB1,8),PKW(pB1,10),PKW(pB1,12),PKW(pB1,14)};
    SBAR(); pv(o,vb0+2*sl_cur,PAF(0),PAF(1),PAF(2),PAF(3)); pv(o+2,vb0+2*sl_cur+8192,PAF(0),PAF(1),PAF(2),PAF(3)); }
  #undef PKW
  #undef PAF
  #undef PIN
  #undef MX3
  #undef GAPA
  #undef EX
  #undef VLD
  #undef VF
  #undef PVS
  #undef PVL
  #undef KRD
  #undef STEP
  #undef ENDW
  {auto rr=__builtin_amdgcn_permlane32_swap(__float_as_uint(l_reg),__float_as_uint(l_reg),false,false);l_reg=__uint_as_float(rr[0])+__uint_as_float(rr[1]);}
  if(hi==0)wsf[32+r32]=l_reg;asm volatile("s_waitcnt lgkmcnt(0)":::"memory");
  float rli[16];
  #pragma unroll
  for(int r=0;r<16;++r)rli[r]=__builtin_amdgcn_rcpf(wsf[32+crow(r,hi)]);
  bf16*Ow=O+(rowbase+q0+wid*QBLK)*PO+ocol;
  { bf16*stg=(bf16*)(shm+LDS_OST)+wid*2048;
    #pragma unroll
    for(int hf=0;hf<2;++hf){
      #pragma unroll
      for(int r=0;r<16;++r){const int orow=crow(r,hi);
        #pragma unroll
        for(int d0=0;d0<2;++d0)stg[orow*64+d0*32+r32]=__float2bfloat16(o[2*hf+d0][r]*rli[r]);}
      asm volatile("s_waitcnt lgkmcnt(0)":::"memory");
      #pragma unroll
      for(int i=0;i<4;++i){const int row=i*8+(lane>>3),ch=lane&7; const u32x4 v=*(const u32x4*)(stg+row*64+ch*8); ATTN_STORE16(Ow+(long)row*PO+hf*64+ch*8,v);}
      asm volatile("s_waitcnt lgkmcnt(0)":::"memory"); } }
  asm volatile("s_waitcnt lgkmcnt(0)\n\ts_barrier":::"memory");
  #undef QF
  #undef QOFF
  #undef DMA_K
  #undef DMA_V
  #undef CMASK
  #undef START
  #undef RESC
  #undef ROT
}
constexpr int ATTN_LDS_BYTES=LDS_BYTES;
struct AttnTensors { const bf16* Q; const bf16* K; const bf16* V; bf16* O; };
template<int THRL=8> __device__ __forceinline__ void attn_phase(char*lds,const AttnTensors&T,int vcu,int ncu){
  for(int w=vcu;w<MK_NB*32;w+=ncu){ const int s=w&3,bhc=w>>2,b=bhc>>3,h=(bhc>>1)&3,c=bhc&1;
    for(int i=0;i<4;++i){ const int qb=(i==0)?15-s:(i==1)?8+s:(i==2)?7-s:s;
      attn_unit<THRL>(b,h*128+c*64,h*128+c*64,h*128,c*512+h*128,qb,T.Q,T.K,T.V,T.O,lds); } }
}
#undef SBAR
#undef WAIT_BAR
}


namespace mk {
#define GAS __attribute__((address_space(1)))
#define LAS __attribute__((address_space(3)))
typedef unsigned short bf16;
typedef unsigned v4u __attribute__((ext_vector_type(4)));
typedef unsigned v2u __attribute__((ext_vector_type(2)));
typedef float f32x4 __attribute__((ext_vector_type(4)));
typedef float v2f __attribute__((ext_vector_type(2)));
typedef float f32x16 __attribute__((ext_vector_type(16)));
typedef short bf16x8 __attribute__((ext_vector_type(8)));
typedef short s16x4 __attribute__((ext_vector_type(4)));
typedef GAS unsigned gu32;
#define RLX_AGENT __ATOMIC_RELAXED, __HIP_MEMORY_SCOPE_AGENT
#define LDS_WAIT() asm volatile("s_waitcnt lgkmcnt(0)" ::: "memory")
#define VM_WAIT() asm volatile("s_waitcnt vmcnt(0)" ::: "memory")
#define LBAR() do { asm volatile("s_waitcnt lgkmcnt(0)" ::: "memory"); __builtin_amdgcn_s_barrier(); asm volatile("" ::: "memory"); } while (0)

constexpr int NWAVES = 8, NTHR = 512;
constexpr int T = MK_T, NB = MK_NB, TFULL = MK_TFULL, SEQ = 4096, D = 1024, NCH = 64;
constexpr float EPSN = 1e-6f;
constexpr int RING_OFF = 0, RING_BYTES = 131072, LDSCTL_OFF = RING_BYTES, MISC_OFF = LDSCTL_OFF + 320, LDS_BYTES = 147456;
#ifndef P0_XSHARE
#define P0_XSHARE 0
#endif
#ifndef P0_MODE
#define P0_MODE 1
#endif
constexpr int CW_SBAR = 32768;
constexpr int CW_FLAG = 64;
constexpr int CW_BAR = 4096;
constexpr int CW_ECNT = 12288;
constexpr int CW_ROWSS = 131072;
constexpr size_t WS_YOFF = 40 * MiB_;
constexpr size_t MS_ROWSS = 24 * MiB_;
constexpr size_t MS_ETOK = 0, MS_EW = 2 * MiB_, MS_DVEC = 4 * MiB_, MS_TPOS = 5 * MiB_, MS_TW = 6 * MiB_, MS_PB = 8 * MiB_;

__device__ __forceinline__ unsigned f2bf(float f) { unsigned u = __builtin_bit_cast(unsigned, f); return (u + 0x7fffu + ((u >> 16) & 1u)) >> 16; }
__device__ __forceinline__ unsigned pk2(float lo, float hi) { return pg8::cvt_pk_bf16(lo, hi); }
__device__ __forceinline__ float bflo(unsigned w) { return __uint_as_float(w << 16); }
__device__ __forceinline__ float bfhi(unsigned w) { return __uint_as_float(w & 0xffff0000u); }
__device__ __forceinline__ float bf1(bf16 v) { return __uint_as_float(((unsigned)v) << 16); }
__device__ __forceinline__ float wave_sum(float v) {
#pragma unroll
    for (int o = 1; o < 64; o <<= 1) v += __shfl_xor(v, o);
    return v;
}
__device__ __forceinline__ float ex2(float x) { return __builtin_amdgcn_exp2f(x); }
__device__ __forceinline__ float fexp(float x) { return __builtin_amdgcn_exp2f(1.4426950408889634f * x); }
__device__ __forceinline__ float frcp(float x) { return __builtin_amdgcn_rcpf(x); }

#define XB_TMO      128
#define XB_XCNT(j)  (256  + 64 * (j))
#define XB_XSUB(j)  (1280 + 64 * (j))
#define XB_XGEN(j)  (2304 + 64 * (j))
#define XB_TOP      3328
#define XB_TOPGEN   3392
#define XCD_BAR_WORDS 3456
#define XB_SPIN_CAP (1u << 18)
__device__ __forceinline__ unsigned xb_ld(unsigned* p)              { return __hip_atomic_load(p, __ATOMIC_RELAXED, __HIP_MEMORY_SCOPE_AGENT); }
__device__ __forceinline__ unsigned xb_add(unsigned* p, unsigned v) { return __hip_atomic_fetch_add(p, v, __ATOMIC_RELAXED, __HIP_MEMORY_SCOPE_AGENT); }
__device__ __forceinline__ unsigned xb_xcc_id() { return (unsigned)__builtin_amdgcn_s_getreg((3 << 11) | 20) & 0xFu; }
#define XB_SPIN(cond, bar) do { unsigned _sp = 0; while (cond) { __builtin_amdgcn_s_sleep(1); \
    if ((++_sp & 255u) == 0u) { if (xb_ld(&(bar)[XB_TMO])) break; if (_sp > XB_SPIN_CAP) { atomicAdd(&(bar)[XB_TMO], 1u); break; } } } } while (0)
struct XcdBarrier { unsigned* bar; unsigned x; volatile LAS unsigned* st; unsigned n; };
__device__ __forceinline__ XcdBarrier xcd_barrier_post(unsigned* bar, volatile LAS unsigned* st, unsigned n) {
    XcdBarrier b; b.bar = bar; b.x = xb_xcc_id(); b.st = st; b.n = n;
    if (threadIdx.x == 0) (void)xb_add(&bar[XB_XCNT(b.x)], 1u);
    return b;
}
__device__ __forceinline__ void xcd_barrier_complete(unsigned* bar, unsigned x, unsigned& nloc, unsigned& nx, unsigned G) {
    unsigned sum, cnt, mine, sp = 0u;
    for (;;) {
        sum = 0u; cnt = 0u; mine = 0u;
#pragma unroll
        for (unsigned j = 0; j < 16; ++j) { const unsigned c = xb_ld(&bar[XB_XCNT(j)]); sum += c; cnt += (c > 0u) ? 1u : 0u; mine = (j == x) ? c : mine; }
        if (sum == G) break;
        __builtin_amdgcn_s_sleep(1);
        if ((++sp & 255u) == 0u) { if (xb_ld(&bar[XB_TMO])) break; if (sp > XB_SPIN_CAP) { atomicAdd(&bar[XB_TMO], 1u); break; } }
    }
    nloc = mine > 0u ? mine : 1u; nx = cnt > 0u ? cnt : 1u;
}
__device__ __forceinline__ void xcd_barrier(const XcdBarrier& b) {
    asm volatile("s_waitcnt vmcnt(0)" ::: "memory");
    __syncthreads();
    if (threadIdx.x == 0) {
        unsigned* bar = b.bar;
        __builtin_amdgcn_s_waitcnt(0);
        unsigned nloc = b.st[0], nx = b.st[1];
        if (nloc == 0u) { xcd_barrier_complete(bar, b.x, nloc, nx, b.n); b.st[0] = nloc; b.st[1] = nx; }
        const unsigned old = xb_add(&bar[XB_XSUB(b.x)], 1u);
        const unsigned gen = old / nloc;
        if (old + 1u == (gen + 1u) * nloc) {
            __builtin_amdgcn_fence(__ATOMIC_RELEASE, "agent");
            asm volatile("s_waitcnt vmcnt(0)" ::: "memory");
            const unsigned og = xb_add(&bar[XB_TOP], 1u);
            const unsigned tg = og / nx;
            if (og + 1u == (tg + 1u) * nx) xb_add(&bar[XB_TOPGEN], 1u);
            else XB_SPIN(xb_ld(&bar[XB_TOPGEN]) == tg, bar);
            __builtin_amdgcn_fence(__ATOMIC_ACQUIRE, "agent");
            xb_add(&bar[XB_XGEN(b.x)], 1u);
            asm volatile("s_waitcnt vmcnt(0)" ::: "memory");
        } else {
            XB_SPIN(xb_ld(&bar[XB_XGEN(b.x)]) == gen, bar);
            __builtin_amdgcn_fence(__ATOMIC_ACQUIRE, "agent");
            asm volatile("s_waitcnt vmcnt(0)" ::: "memory");
        }
    }
    __syncthreads();
}

struct Args { const float* in[22]; float* out; unsigned char* ws; int ph_lo, ph_hi; };
struct Frame {
    LAS unsigned char* lds; volatile LAS unsigned* MISC; unsigned* ctl; int tid, lane, wave, vcu, G, g, bi;
};
enum { I_X = 0, I_P, I_MIXN, I_WIN, I_LB, I_HON, I_QN, I_KN, I_LQ1, I_LK1, I_LQ2, I_LK2, I_SUBLN, I_WOUT, I_FFNN, I_WR, I_WG, I_WU, I_WD, I_PP, I_PLEN, I_PG };

struct P0Item { const float* W; bf16* WT; const float* ks; int K, N, row_off, item; };
__device__ __forceinline__ void p0_load(const P0Item& I, int lane, f32x4 (&v)[8], float (&sc)[8]) {
    const int nblk = I.N / 32, kb = I.item / nblk, nb = I.item % nblk, k0 = 64 * kb, n0 = 32 * nb;
#pragma unroll
    for (int i = 0; i < 8; ++i) v[i] = *(const GAS f32x4*)(I.W + (size_t)(k0 + 8 * i + (lane >> 3)) * I.N + n0 + 4 * (lane & 7));
#pragma unroll
    for (int i = 0; i < 8; ++i) sc[i] = I.ks ? I.ks[k0 + 8 * i + (lane >> 3)] : 1.f;
}
__device__ __forceinline__ void p0_store(const P0Item& I, int lane, LAS float* scr, const f32x4 (&v)[8], const float (&sc)[8]) {
    const int nblk = I.N / 32, kb = I.item / nblk, nb = I.item % nblk, k0 = 64 * kb, n0 = 32 * nb;
#pragma unroll
    for (int i = 0; i < 8; ++i) { LAS float* s = scr + (8 * i + (lane >> 3)) * 33 + 4 * (lane & 7); const float ks = sc[i]; s[0] = v[i].x * ks; s[1] = v[i].y * ks; s[2] = v[i].z * ks; s[3] = v[i].w * ks; }
    LDS_WAIT(); asm volatile("" ::: "memory");
    const int c = lane & 7;
#pragma unroll
    for (int j = 0; j < 4; ++j) { const int n = (lane >> 3) + 8 * j; const LAS float* s = scr + (8 * c) * 33 + n;
        v4u o; o.x = pk2(s[0 * 33], s[1 * 33]); o.y = pk2(s[2 * 33], s[3 * 33]); o.z = pk2(s[4 * 33], s[5 * 33]); o.w = pk2(s[6 * 33], s[7 * 33]);
        *(GAS v4u*)(I.WT + (size_t)(I.row_off + n0 + n) * I.K + k0 + 8 * c) = o; }
    LDS_WAIT(); asm volatile("" ::: "memory");
}
__device__ __forceinline__ void rms_row_to_bf16(const float* xrow, const float* gain, bf16* orow, int lane) {
    const GAS f32x4* xr = (const GAS f32x4*)xrow + lane; const f32x4* gr = (const f32x4*)gain + lane;
    f32x4 v[4]; float s = 0.f;
#pragma unroll
    for (int j = 0; j < 4; ++j) { v[j] = xr[64 * j]; s += (v[j].x * v[j].x + v[j].y * v[j].y) + (v[j].z * v[j].z + v[j].w * v[j].w); }
    const float r = rsqrtf(wave_sum(s) * (1.f / 1024.f) + EPSN);
    GAS v2u* o8 = (GAS v2u*)orow + lane;
#pragma unroll
    for (int j = 0; j < 4; ++j) { const f32x4 g = gr[64 * j]; v2u w; w.x = pk2(v[j].x * r * g.x, v[j].y * r * g.y); w.y = pk2(v[j].z * r * g.z, v[j].w * r * g.w); o8[64 * j] = w; }
}
__device__ __forceinline__ void p0_prologue(Frame& F, const Args& a, unsigned char* ws) {
    LAS float* scr = (LAS float*)(F.lds + RING_OFF + F.wave * 16384);
    const int gw = F.vcu * NWAVES + F.wave, NGW = F.G * NWAVES;
    constexpr int I_IN = 1792, I_OUT = 512, I_G = 4096, I_PPJ = 128, I_PGT = 512, PER_L = I_IN + I_OUT + 3 * I_G + I_PPJ + I_PGT;
#if P0_MODE == 1
    const int it_lo = 0, it_hi = (F.g == 0) ? I_IN : 2 * PER_L - I_IN;
    auto item_of = [&](int j) { return (F.g == 0) ? j : j + I_IN; };
#else
    constexpr int NX_L = I_IN + I_OUT + I_PPJ + I_PGT, XS = P0_XSHARE;
    const int it_lo = 0, it_hi = (F.g == 0) ? 2 * (NX_L + XS) : 2 * (3 * I_G - XS);
    auto item_of = [&](int j) { if (F.g == 0) { const int l = j / (NX_L + XS), r = j % (NX_L + XS); return l * PER_L + (r < I_IN + I_OUT ? r : (r < NX_L ? r + 3 * I_G : I_IN + I_OUT + (r - NX_L))); }
        const int l = j / (3 * I_G - XS), r = j % (3 * I_G - XS); return l * PER_L + I_IN + I_OUT + XS + r; };
#endif
    auto decode = [&](int it) { P0Item I; I.ks = nullptr; I.row_off = 0;
        const int l = it / PER_L; int r = it % PER_L;
        if (r < I_IN) { I.W = a.in[I_WIN] + (size_t)l * 1024 * 3584; I.K = 1024; I.N = 3584; I.WT = (bf16*)(ws + WS_WIN) + (size_t)l * 3584 * 1024; I.item = r; return I; } r -= I_IN;
        if (r < I_OUT) { I.W = a.in[I_WOUT] + (size_t)l * 1024 * 1024; I.K = 1024; I.N = 1024; I.WT = (bf16*)(ws + WS_WOUT) + (size_t)l * 1024 * 1024; I.item = r; return I; } r -= I_OUT;
        if (r < 2 * I_G) { const int up = r / I_G; r %= I_G; const int e = r >> 8, it2 = r & 255, nb = it2 % 16, n0 = nb * 32;
            I.row_off = (n0 >> 7) * 256 + (n0 & 127) + up * 128 - n0;
            I.W = a.in[up ? I_WU : I_WG] + ((size_t)l * 16 + e) * 1024 * 512; I.K = 1024; I.N = 512; I.WT = (bf16*)(ws + WS_WGU) + ((size_t)l * 16 + e) * 1024 * 1024; I.item = it2; I.ks = a.in[I_FFNN] + l * 1024; return I; }
        r -= 2 * I_G;
        if (r < I_G) { const int e = r >> 8, it2 = r & 255; I.W = a.in[I_WD] + ((size_t)l * 16 + e) * 512 * 1024; I.K = 512; I.N = 1024; I.WT = (bf16*)(ws + WS_WDN) + ((size_t)l * 16 + e) * 1024 * 512; I.item = it2; return I; } r -= I_G;
        if (r < I_PPJ) { I.W = a.in[I_PP] + (size_t)l * 256 * 1024; I.K = 256; I.N = 1024; I.WT = (bf16*)(ws + WS_WPP) + (size_t)l * 1024 * 256; I.item = r; return I; } r -= I_PPJ;
        I.W = a.in[I_PG] + (size_t)l * 1024 * 1024; I.K = 1024; I.N = 1024; I.WT = (bf16*)(ws + WS_WPG) + (size_t)l * 1024 * 1024; I.item = r; return I; };
    { int it = it_lo + gw;
      if (it < it_hi) {
        f32x4 va[8], vb[8]; float sa[8], sb[8];
        P0Item A = decode(item_of(it)), B = A; p0_load(A, F.lane, va, sa);
        for (;;) {
            const bool nb_ = (it + NGW < it_hi); if (nb_) { B = decode(item_of(it + NGW)); p0_load(B, F.lane, vb, sb); }
            p0_store(A, F.lane, scr, va, sa); if (!nb_) break; it += NGW;
            const bool na_ = (it + NGW < it_hi); if (na_) { A = decode(item_of(it + NGW)); p0_load(A, F.lane, va, sa); }
            p0_store(B, F.lane, scr, vb, sb); if (!na_) break; it += NGW;
        } } }
    for (int m = gw; m < T; m += 2 * NGW) {
        const int m2 = (m + NGW < T) ? m + NGW : m;
        const GAS f32x4* xa = (const GAS f32x4*)(a.in[I_X] + (size_t)m * D) + F.lane; const GAS f32x4* xb = (const GAS f32x4*)(a.in[I_X] + (size_t)m2 * D) + F.lane;
        const f32x4* gr = (const f32x4*)a.in[I_MIXN] + F.lane;
        f32x4 va[4], vb[4]; float sa = 0.f, sb = 0.f;
#pragma unroll
        for (int j = 0; j < 4; ++j) { va[j] = xa[64 * j]; vb[j] = xb[64 * j]; }
#pragma unroll
        for (int j = 0; j < 4; ++j) { sa += (va[j].x * va[j].x + va[j].y * va[j].y) + (va[j].z * va[j].z + va[j].w * va[j].w); sb += (vb[j].x * vb[j].x + vb[j].y * vb[j].y) + (vb[j].z * vb[j].z + vb[j].w * vb[j].w); }
        const float ra = rsqrtf(wave_sum(sa) * (1.f / 1024.f) + EPSN), rb = rsqrtf(wave_sum(sb) * (1.f / 1024.f) + EPSN);
        GAS v2u* oa = (GAS v2u*)((bf16*)(a.ws + WS_XN) + (size_t)m * D) + F.lane; GAS v2u* ob = (GAS v2u*)((bf16*)(a.ws + WS_XN) + (size_t)m2 * D) + F.lane;
#pragma unroll
        for (int j = 0; j < 4; ++j) { const f32x4 g = gr[64 * j];
            v2u w; w.x = pk2(va[j].x * ra * g.x, va[j].y * ra * g.y); w.y = pk2(va[j].z * ra * g.z, va[j].w * ra * g.w); oa[64 * j] = w;
            v2u u; u.x = pk2(vb[j].x * rb * g.x, vb[j].y * rb * g.y); u.y = pk2(vb[j].z * rb * g.z, vb[j].w * rb * g.w); ob[64 * j] = u; }
    }
}

__device__ __forceinline__ void qk_norm_rows(Frame& F, bf16* dq, bf16* dk, const float* qg, const float* kg) {
    const int gw = F.vcu * NWAVES + F.wave, NGW = F.G * NWAVES, lane = F.lane;
    const int c0 = (lane & 7) * 8;
    float gq[8], gk[8];
#pragma unroll
    for (int j = 0; j < 8; ++j) { gq[j] = qg[c0 + j] * (0.125f * 1.4426950408889634f); gk[j] = kg[c0 + j]; }
    for (int m = gw; m < T; m += NGW) {
#pragma unroll
        for (int w = 0; w < 2; ++w) {
            GAS v4u* p = (GAS v4u*)((w ? dk : dq) + (size_t)m * 512) + lane;
            const v4u x = *p; float v[8] = {bflo(x.x), bfhi(x.x), bflo(x.y), bfhi(x.y), bflo(x.z), bfhi(x.z), bflo(x.w), bfhi(x.w)};
            float s = 0.f;
#pragma unroll
            for (int j = 0; j < 8; ++j) s += v[j] * v[j];
            s += __shfl_xor(s, 1); s += __shfl_xor(s, 2); s += __shfl_xor(s, 4);
            const float r = rsqrtf(s * (1.f / 64.f) + EPSN);
            v4u o;
            if (w == 0) { o.x = pk2(v[0] * r * gq[0], v[1] * r * gq[1]); o.y = pk2(v[2] * r * gq[2], v[3] * r * gq[3]); o.z = pk2(v[4] * r * gq[4], v[5] * r * gq[5]); o.w = pk2(v[6] * r * gq[6], v[7] * r * gq[7]); }
            else        { o.x = pk2(v[0] * r * gk[0], v[1] * r * gk[1]); o.y = pk2(v[2] * r * gk[2], v[3] * r * gk[3]); o.z = pk2(v[4] * r * gk[4], v[5] * r * gk[5]); o.w = pk2(v[6] * r * gk[6], v[7] * r * gk[7]); }
            *p = o;
        }
    }
}

#ifdef PROBE_PH
#define PROBE_SUB(id) do { if (blockIdx.x == 0 && threadIdx.x == 0) { volatile LAS unsigned long long* pw_ = (volatile LAS unsigned long long*)(F.lds + MISC_OFF + 64); const unsigned long long t_ = __builtin_amdgcn_s_memrealtime(); if ((id) == PROBE_PH) pw_[0] += t_ - pw_[1]; pw_[1] = t_; } } while (0)
#else
#define PROBE_SUB(id) do { } while (0)
#endif
constexpr int HB_QM = 0, HB_KM = 17408, HB_KET = 34816, HB_VT = 53248, HB_PART = 71680, HB_RQ = 73728, HB_RF = 90112, HB_RV = 106496;
struct B1Raw { v4u q[2], f[2], v[2]; };
__device__ __forceinline__ void b1_load_raw(B1Raw& R, int tid, int b, int h, int c, const bf16* zq, const bf16* zf, const bf16* zi) {
    const size_t rowbase = (size_t)b * SEQ + c * 64;
#pragma unroll
    for (int j = 0; j < 2; ++j) { const int i = tid + NTHR * j, row = i >> 4, seg = i & 15; const size_t off = (rowbase + row) * 512 + h * 128 + seg * 8;
        R.q[j] = *(const GAS v4u*)(zq + off); R.f[j] = *(const GAS v4u*)(zf + off); R.v[j] = *(const GAS v4u*)(zi + off); }
}
__device__ __forceinline__ void hgrn_b1_unit(Frame& F, int b, int h, int c, bf16* zq, bf16* zf, bf16* zi, bf16* Lst, bf16* dvb, float lbv, B1Raw& R, bool has_next, int nb, int nh, int nc) {
    const int tid = F.tid, lane = F.lane, wave = F.wave;
    LAS unsigned char* lds = F.lds + RING_OFF;
    PROBE_SUB(24);
    const int d = tid & 127, rg = tid >> 7, s0 = rg * 16;
    const size_t rowbase = (size_t)b * SEQ + c * 64;
#pragma unroll
    for (int j = 0; j < 2; ++j) { const int i = tid + NTHR * j, row = i >> 4, seg = i & 15;
        *(LAS v4u*)(lds + HB_RQ + row * 256 + seg * 16) = R.q[j]; *(LAS v4u*)(lds + HB_RF + row * 256 + seg * 16) = R.f[j]; *(LAS v4u*)(lds + HB_RV + row * 256 + seg * 16) = R.v[j]; }
    LBAR();
    if (has_next) b1_load_raw(R, tid, nb, nh, nc, zq, zf, zi);
    PROBE_SUB(20);
    float q[16], kk[16], g[16];
    unsigned vraw[16];
#pragma unroll
    for (int j = 0; j < 16; ++j) {
        const int lo = (s0 + j) * 256 + d * 2;
        const float xq = bf1(*(const LAS bf16*)(lds + HB_RQ + lo)), xf = bf1(*(const LAS bf16*)(lds + HB_RF + lo)); vraw[j] = *(const LAS bf16*)(lds + HB_RV + lo);
        const float eq = fexp(-xq); q[j] = xq * frcp(1.f + eq);
        const float ef = fexp(-xf), sg = frcp(1.f + ef);
        const float fo = fmaxf(lbv + (1.f - lbv) * sg, 1e-6f);
        g[j] = __builtin_amdgcn_logf(fo);
        kk[j] = (1.f - lbv) * ef * sg;
    }
    float run = 0.f;
#pragma unroll
    for (int j = 0; j < 16; ++j) { run += g[j]; g[j] = run; }
    LAS float* part = (LAS float*)(lds + HB_PART);
    part[rg * 128 + d] = run;
    LBAR();
    PROBE_SUB(21);
    const float p0 = part[d], p1 = part[128 + d], p2 = part[256 + d], p3 = part[384 + d];
    const float offs = (rg > 0 ? p0 : 0.f) + (rg > 1 ? p1 : 0.f) + (rg > 2 ? p2 : 0.f);
    const float last = (p0 + p1) + (p2 + p3), ref = p0 + p1;
    unsigned ket[8], vt[8];
#pragma unroll
    for (int j = 0; j < 16; j += 2) {
        const float c0 = g[j] + offs, c1 = g[j + 1] + offs;
        const unsigned wqe = pk2(q[j] * ex2(c0), q[j + 1] * ex2(c1));
        const unsigned wke = pk2(kk[j] * ex2(last - c0), kk[j + 1] * ex2(last - c1));
        const unsigned wqm = pk2(q[j] * ex2(fminf(c0 - ref, 115.f)), q[j + 1] * ex2(fminf(c1 - ref, 115.f)));
        const unsigned wkm = pk2(kk[j] * ex2(fminf(ref - c0, 115.f)), kk[j + 1] * ex2(fminf(ref - c1, 115.f)));
        *(LAS bf16*)(lds + HB_RQ + (s0 + j) * 256 + d * 2) = (bf16)wqe; *(LAS bf16*)(lds + HB_RQ + (s0 + j + 1) * 256 + d * 2) = (bf16)(wqe >> 16);
        *(LAS bf16*)(lds + HB_QM + ((s0 + j) * 136 + d) * 2) = (bf16)wqm; *(LAS bf16*)(lds + HB_QM + ((s0 + j + 1) * 136 + d) * 2) = (bf16)(wqm >> 16);
        *(LAS bf16*)(lds + HB_KM + ((s0 + j) * 136 + d) * 2) = (bf16)wkm; *(LAS bf16*)(lds + HB_KM + ((s0 + j + 1) * 136 + d) * 2) = (bf16)(wkm >> 16);
        ket[j >> 1] = wke; vt[j >> 1] = vraw[j] | (vraw[j + 1] << 16);
    }
    { LAS v4u* pk = (LAS v4u*)(lds + HB_KET + (d * 72 + s0) * 2); pk[0] = (v4u){ket[0], ket[1], ket[2], ket[3]}; pk[1] = (v4u){ket[4], ket[5], ket[6], ket[7]};
      LAS v4u* pv = (LAS v4u*)(lds + HB_VT + (d * 72 + s0) * 2); pv[0] = (v4u){vt[0], vt[1], vt[2], vt[3]}; pv[1] = (v4u){vt[4], vt[5], vt[6], vt[7]}; }
    if (rg == 0) dvb[((((size_t)b * 4 + h) * NCH + c) * 4 + ((d & 15) >> 2)) * 32 + (d >> 4) * 4 + (d & 3)] = (bf16)f2bf(ex2(last));
    LBAR();
    PROBE_SUB(22);
    const int r32 = lane & 31, hh = lane >> 5;
    {
        const int ti = wave >> 2, vb = wave & 3;
        f32x16 o = f32x16{};
        for (int si = 0; si <= ti; ++si) {
            f32x16 xt = f32x16{};
#pragma unroll
            for (int ks = 0; ks < 8; ++ks) {
                const bf16x8 af = *(const LAS bf16x8*)(lds + HB_KM + ((si * 32 + r32) * 136 + ks * 16 + hh * 8) * 2);
                const bf16x8 bfr = *(const LAS bf16x8*)(lds + HB_QM + ((ti * 32 + r32) * 136 + ks * 16 + hh * 8) * 2);
                xt = __builtin_amdgcn_mfma_f32_32x32x16_bf16(af, bfr, xt, 0, 0, 0);
            }
            if (si == ti) {
#pragma unroll
                for (int r = 0; r < 16; ++r) { const int sl = (r & 3) + 8 * (r >> 2) + 4 * hh; if (sl > r32) xt[r] = 0.f; }
            }
#pragma unroll
            for (int ks = 0; ks < 2; ++ks) {
                v4u aw; aw.x = pk2(xt[8 * ks + 0], xt[8 * ks + 1]); aw.y = pk2(xt[8 * ks + 2], xt[8 * ks + 3]); aw.z = pk2(xt[8 * ks + 4], xt[8 * ks + 5]); aw.w = pk2(xt[8 * ks + 6], xt[8 * ks + 7]);
                const LAS unsigned char* vp = lds + HB_VT + ((vb * 32 + r32) * 72 + si * 32 + ks * 16 + 4 * hh) * 2;
                const v2u b0 = *(const LAS v2u*)vp, b1 = *(const LAS v2u*)(vp + 16);
                const v4u bw = (v4u){b0.x, b0.y, b1.x, b1.y};
                o = __builtin_amdgcn_mfma_f32_32x32x16_bf16(__builtin_bit_cast(bf16x8, aw), __builtin_bit_cast(bf16x8, bw), o, 0, 0, 0);
            }
        }
#pragma unroll
        for (int r = 0; r < 16; r += 2) { const int tl = ti * 32 + (r & 3) + 8 * (r >> 2) + 4 * hh; const unsigned w = pk2(o[r], o[r + 1]);
            *(LAS bf16*)(lds + HB_RV + tl * 256 + (vb * 32 + r32) * 2) = (bf16)w; *(LAS bf16*)(lds + HB_RV + (tl + 1) * 256 + (vb * 32 + r32) * 2) = (bf16)(w >> 16); }
    }
    PROBE_SUB(25);
#pragma unroll
    for (int j = 0; j < 2; ++j) { const int i = tid + NTHR * j, row = i >> 4, seg = i & 15;
        *(GAS v4u*)(zq + (rowbase + row) * 512 + h * 128 + seg * 8) = *(const LAS v4u*)(lds + HB_RQ + row * 256 + seg * 16); }
    PROBE_SUB(26);
    v2u Lw[2][4];
#pragma unroll
    for (int tt = 0; tt < 2; ++tt) {
        const int tile = wave * 2 + tt, di = tile >> 2, vi = tile & 3;
        f32x16 L = f32x16{};
#pragma unroll
        for (int ks = 0; ks < 4; ++ks) {
            const bf16x8 af = *(const LAS bf16x8*)(lds + HB_KET + ((di * 32 + r32) * 72 + ks * 16 + hh * 8) * 2);
            const bf16x8 bfr = *(const LAS bf16x8*)(lds + HB_VT + ((vi * 32 + r32) * 72 + ks * 16 + hh * 8) * 2);
            L = __builtin_amdgcn_mfma_f32_32x32x16_bf16(af, bfr, L, 0, 0, 0);
        }
#pragma unroll
        for (int qd = 0; qd < 4; ++qd) { Lw[tt][qd].x = pk2(L[4 * qd + 0], L[4 * qd + 1]); Lw[tt][qd].y = pk2(L[4 * qd + 2], L[4 * qd + 3]); }
    }
    PROBE_SUB(27);
    LBAR();
#pragma unroll
    for (int tt = 0; tt < 2; ++tt) {
        const int tile = wave * 2 + tt, di = tile >> 2, vi = tile & 3;
        const int v = vi * 32 + r32, vs = v >> 4, v16 = v & 15;
#pragma unroll
        for (int qd = 0; qd < 4; ++qd) { const int gg = 2 * (qd & 1) + hh, dt = 2 * di + (qd >> 1);
            const int ci = (gg * 16 + v16) * 4 + (dt >> 1);
            *(LAS v2u*)(lds + HB_QM + vs * 4096 + ((ci ^ ((v16 >> 2) & 3)) * 16) + (dt & 1) * 8) = Lw[tt][qd]; }
    }
#pragma unroll
    for (int j = 0; j < 2; ++j) { const int i = tid + NTHR * j, row = i >> 4, seg = i & 15;
        *(GAS v4u*)(zi + (rowbase + row) * 512 + h * 128 + seg * 8) = *(const LAS v4u*)(lds + HB_RV + row * 256 + seg * 16); }
    LBAR();
    { bf16* Lu = Lst + (((size_t)b * 4 + h) * NCH + c) * 8 * 2048;
#pragma unroll
      for (int j = 0; j < 4; ++j) { const int p = tid + NTHR * j; *(GAS v4u*)(Lu + (size_t)p * 8) = *(const LAS v4u*)(lds + HB_QM + (p ^ ((p >> 4) & 3)) * 16); } }
    PROBE_SUB(23);
}
__device__ __forceinline__ void hgrn_b1_phase(Frame& F, const Args& a, int layer) {
    bf16* zq = (bf16*)(a.ws + WS_Z); bf16* zf = zq + (size_t)T * 512; bf16* zi = zq + (size_t)2 * T * 512;
    bf16* Lst = (bf16*)(a.ws + WS_XN); bf16* dvb = (bf16*)(a.ws + WS_MISC + MS_DVEC);
    B1Raw R;
    if (F.vcu < NB * 4 * NCH) b1_load_raw(R, F.tid, F.vcu >> 8, (F.vcu >> 6) & 3, F.vcu & 63, zq, zf, zi);
    for (int u = F.vcu; u < NB * 4 * NCH; u += F.G) {
        const int c = u & 63, h = (u >> 6) & 3, b = u >> 8; const int un = u + F.G;
        const int col = h * 128 + (F.tid & 127);
        float lbv = 0.f;
        if (layer == 1) { const float a0 = a.in[I_LB][col], a1 = a.in[I_LB][512 + col]; const float mx = fmaxf(a0, a1); const float e0 = fexp(a0 - mx), e1 = fexp(a1 - mx); lbv = e1 / (e0 + e1); }
        hgrn_b1_unit(F, b, h, c, zq, zf, zi, Lst, dvb, lbv, R, un < NB * 4 * NCH, un >> 8, (un >> 6) & 3, un & 63);
    }
}
typedef float f32x4v __attribute__((ext_vector_type(4)));
constexpr int SQ_RING = 16384, SQ_SLOT = 20480, SQ_NSLOT = 5, SQ_LOFF = 16384;
__device__ __forceinline__ void hgrn_seq_unit(Frame& F, int b, int h, int vs, const bf16* QE, bf16* O, const bf16* Lst, const bf16* dvb) {
    const int lane = F.lane, wave = F.wave;
    const size_t bh = (size_t)b * 4 + h;
    LAS unsigned char* lds = F.lds + RING_OFF;
    {
        const GAS v4u* src = (const GAS v4u*)(dvb + bh * NCH * 128); LAS v4u* dst = (LAS v4u*)lds;
        for (int i = F.tid; i < 1024; i += NTHR) dst[i] = src[i];
        LDS_WAIT(); __syncthreads();
    }
#define SQ_BAR() do { asm volatile("s_waitcnt lgkmcnt(0)" ::: "memory"); __builtin_amdgcn_s_barrier(); asm volatile("" ::: "memory"); } while (0)
    if (wave >= 4) {
        const int pw = wave - 4;
        const char* srcq[4]; unsigned dstq[4];
#pragma unroll
        for (int j = 0; j < 4; ++j) { const int q = pw * 4 + j, row = 4 * q + (lane >> 4), gch = (lane & 15) ^ (row & 15);
            srcq[j] = (const char*)(QE + ((size_t)b * SEQ + row) * 512 + h * 128) + gch * 16; dstq[j] = (unsigned)(q * 1024); }
        const char* srcl = (const char*)(Lst + (bh * NCH * 8 + vs) * 2048 + lane * 32 + pw * 8);
#define SQ_ISSUE(cc) do { LAS unsigned char* sl_ = lds + SQ_RING + ((cc) % SQ_NSLOT) * SQ_SLOT + wave * 0; \
        _Pragma("unroll") for (int j = 0; j < 4; ++j) __builtin_amdgcn_global_load_lds((const unsigned*)(srcq[j] + (size_t)(cc) * (64 * 1024)), (LAS unsigned*)(sl_ + dstq[j]), 16, 0, 0); \
        __builtin_amdgcn_global_load_lds((const unsigned*)(srcl + (size_t)(cc) * (8 * 4096)), (LAS unsigned*)(sl_ + SQ_LOFF + pw * 1024), 16, 0, 0); } while (0)
        SQ_ISSUE(0); SQ_ISSUE(1); SQ_ISSUE(2); SQ_ISSUE(3);
        asm volatile("s_waitcnt vmcnt(15)" ::: "memory");
        SQ_BAR();
        for (int c = 0; c < NCH; ++c) {
            if (c + 4 < NCH) { SQ_ISSUE(c + 4); asm volatile("s_waitcnt vmcnt(15)" ::: "memory"); }
            else asm volatile("s_waitcnt vmcnt(0)" ::: "memory");
            SQ_BAR();
        }
#undef SQ_ISSUE
        return;
    }
    const int v16 = lane & 15, g = lane >> 4, tb = wave;
    float S8[8];
#pragma unroll
    for (int i = 0; i < 8; ++i) S8[i] = 0.f;
    const int rowl = tb * 16 + v16;
    const LAS unsigned char* pd = lds + g * 64 + tb * 16;
    char* pw_ = (char*)(O + ((size_t)b * SEQ + tb * 16 + ((lane >> 1) & 15)) * 512 + h * 128 + vs * 16 + (lane & 1) * 8);
    LAS unsigned char* ost = lds + SQ_RING + SQ_NSLOT * SQ_SLOT + 8192 + tb * 512;
    LAS unsigned char* sbuf = lds + SQ_RING + SQ_NSLOT * SQ_SLOT;
    { LAS v4u* z = (LAS v4u*)sbuf; unsigned z0 = 0u; asm volatile("" : "+v"(z0)); for (int i = F.tid; i < 512; i += 256) z[i] = (v4u){z0, z0, z0, z0}; }
    struct SqOps { v2u qa[4][2]; v4u lw, dd; };
#define SQ_LOAD(R, cc) do { const LAS unsigned char* sl_ = lds + SQ_RING + ((cc) % SQ_NSLOT) * SQ_SLOT; \
        _Pragma("unroll") for (int ks = 0; ks < 4; ++ks) { R.qa[ks][0] = *(const LAS v2u*)(sl_ + rowl * 256 + (((ks * 4 + (g >> 1)) ^ (rowl & 15)) * 16) + 8 * (g & 1)); R.qa[ks][1] = *(const LAS v2u*)(sl_ + rowl * 256 + (((ks * 4 + 2 + (g >> 1)) ^ (rowl & 15)) * 16) + 8 * (g & 1)); } \
        R.lw = *(const LAS v4u*)(sl_ + SQ_LOFF + tb * 1024 + lane * 16); R.dd = *(const LAS v4u*)(pd + (cc) * 256); } while (0)
#define SQ_STEP(R, cc) do { f32x4v acc = (f32x4v){0.f, 0.f, 0.f, 0.f}; \
        const LAS unsigned char* sr_ = sbuf + ((((cc) + 1) & 1) * 4096) + lane * 16; \
        _Pragma("unroll") for (int ks = 0; ks < 4; ++ks) { \
            const v4u bw = *(const LAS v4u*)(sr_ + ks * 1024); \
            const v4u aw = (v4u){R.qa[ks][0].x, R.qa[ks][0].y, R.qa[ks][1].x, R.qa[ks][1].y}; \
            acc = __builtin_amdgcn_mfma_f32_16x16x32_bf16(__builtin_bit_cast(bf16x8, aw), __builtin_bit_cast(bf16x8, bw), acc, 0, 0, 0); } \
        _Pragma("unroll") for (int dt = 0; dt < 2; ++dt) { \
            const unsigned w0 = R.lw[dt * 2], w1 = R.lw[dt * 2 + 1], d0 = R.dd[dt * 2], d1 = R.dd[dt * 2 + 1]; \
            S8[4 * dt + 0] = bflo(d0) * S8[4 * dt + 0] + bflo(w0); S8[4 * dt + 1] = bfhi(d0) * S8[4 * dt + 1] + bfhi(w0); \
            S8[4 * dt + 2] = bflo(d1) * S8[4 * dt + 2] + bflo(w1); S8[4 * dt + 3] = bfhi(d1) * S8[4 * dt + 3] + bfhi(w1); } \
        *(LAS v4u*)(sbuf + (((cc) & 1) * 4096) + tb * 1024 + lane * 16) = (v4u){pk2(S8[0], S8[1]), pk2(S8[2], S8[3]), pk2(S8[4], S8[5]), pk2(S8[6], S8[7])}; \
        _Pragma("unroll") for (int r = 0; r < 4; ++r) *(LAS unsigned short*)(ost + (4 * g + r) * 32 + v16 * 2) = (unsigned short)f2bf(acc[r]); \
        asm volatile("s_waitcnt lgkmcnt(0)" ::: "memory"); \
        if (lane < 32) *(GAS v4u*)pw_ = *(const LAS v4u*)(ost + lane * 16); \
        pw_ += 64 * 1024; } while (0)
    SQ_BAR();
    SqOps RA;
    for (int c = 0; c < NCH; ++c) {
        SQ_LOAD(RA, c);
        SQ_STEP(RA, c);
        SQ_BAR();
    }
#undef SQ_LOAD
#undef SQ_STEP
#undef SQ_BAR
}
__device__ __forceinline__ void hgrn_seq_phase(Frame& F, const Args& a) {
    const bf16* zq = (const bf16*)(a.ws + WS_Z); bf16* zi = (bf16*)(a.ws + WS_Z) + (size_t)1 * T * 512;
    const bf16* Lst = (const bf16*)(a.ws + WS_XN); const bf16* dvb = (const bf16*)(a.ws + WS_MISC + MS_DVEC);
    for (int u = F.vcu; u < NB * 32; u += F.G) hgrn_seq_unit(F, u >> 5, (u >> 3) & 3, u & 7, zq, zi, Lst, dvb);
}

__device__ __forceinline__ void mix_finalize(Frame& F, const Args& a, int layer) {
    const int gw = F.vcu * NWAVES + F.wave, NGW = F.G * NWAVES, lane = F.lane;
    const bf16* oh = (const bf16*)(a.ws + WS_Z) + (size_t)2 * T * 512; const bf16* oi = (const bf16*)(a.ws + WS_Z) + (size_t)1 * T * 512; const bf16* zg = (const bf16*)(a.ws + WS_Z) + (size_t)3 * T * 512;
    const bf16* OA = (const bf16*)(a.ws + WS_OA); bf16* mix = (bf16*)(a.ws + WS_Z) + (size_t)4 * T * 512;
    const float lam_init = 0.8f - 0.6f * fexp(-0.3f * (float)layer);
    const float la = wave_sum(a.in[I_LQ1][layer * 64 + lane] * a.in[I_LK1][layer * 64 + lane]), lb = wave_sum(a.in[I_LQ2][layer * 64 + lane] * a.in[I_LK2][layer * 64 + lane]);
    const float lam = fexp(la) - fexp(lb) + lam_init;
    const int c0 = (lane & 15) * 8;
    float gh[8], gs[8];
#pragma unroll
    for (int j = 0; j < 8; ++j) { gh[j] = a.in[I_HON][layer * 128 + c0 + j]; gs[j] = a.in[I_SUBLN][layer * 128 + c0 + j] * (1.f - lam_init); }
    struct DRow { v4u xo, xi, xg, x0, x1; };
    auto ld = [&](int m) { DRow r; r.xo = *((const GAS v4u*)(oh + (size_t)m * 512) + lane); r.xi = *((const GAS v4u*)(oi + (size_t)m * 512) + lane); r.xg = *((const GAS v4u*)(zg + (size_t)m * 512) + lane);
        r.x0 = *((const GAS v4u*)(OA + (size_t)m * 1024) + lane); r.x1 = *((const GAS v4u*)(OA + (size_t)m * 1024 + 512) + lane); return r; };
    auto fin = [&](int m, const DRow& R) {
        const v4u xo = R.xo, xi = R.xi, xg = R.xg, x0 = R.x0, x1 = R.x1;
        float o[8] = {bflo(xo.x) + bflo(xi.x), bfhi(xo.x) + bfhi(xi.x), bflo(xo.y) + bflo(xi.y), bfhi(xo.y) + bfhi(xi.y), bflo(xo.z) + bflo(xi.z), bfhi(xo.z) + bfhi(xi.z), bflo(xo.w) + bflo(xi.w), bfhi(xo.w) + bfhi(xi.w)};
        float gt[8] = {bflo(xg.x), bfhi(xg.x), bflo(xg.y), bfhi(xg.y), bflo(xg.z), bfhi(xg.z), bflo(xg.w), bfhi(xg.w)};
        float d0[8] = {bflo(x0.x), bfhi(x0.x), bflo(x0.y), bfhi(x0.y), bflo(x0.z), bfhi(x0.z), bflo(x0.w), bfhi(x0.w)};
        float d1[8] = {bflo(x1.x), bfhi(x1.x), bflo(x1.y), bfhi(x1.y), bflo(x1.z), bfhi(x1.z), bflo(x1.w), bfhi(x1.w)};
        float s = 0.f, s2 = 0.f;
#pragma unroll
        for (int j = 0; j < 8; ++j) { s += o[j] * o[j]; d0[j] -= lam * d1[j]; s2 += d0[j] * d0[j]; }
#pragma unroll
        for (int k = 1; k < 16; k <<= 1) { s += __shfl_xor(s, k); s2 += __shfl_xor(s2, k); }
        const float r = rsqrtf(s * (1.f / 128.f) + EPSN), r2 = rsqrtf(s2 * (1.f / 128.f) + EPSN);
        float y[8], z[8];
#pragma unroll
        for (int j = 0; j < 8; ++j) { y[j] = o[j] * r * gh[j] * (gt[j] * frcp(1.f + fexp(-gt[j]))); z[j] = d0[j] * r2 * gs[j]; }
        *((GAS v4u*)(mix + (size_t)m * 1024) + lane) = (v4u){pk2(y[0], y[1]), pk2(y[2], y[3]), pk2(y[4], y[5]), pk2(y[6], y[7])};
        *((GAS v4u*)(mix + (size_t)m * 1024 + 512) + lane) = (v4u){pk2(z[0], z[1]), pk2(z[2], z[3]), pk2(z[4], z[5]), pk2(z[6], z[7])};
    };
    for (int m = gw; m < T; m += 2 * NGW) {
        const int m2 = (m + NGW < T) ? m + NGW : m;
        const DRow A = ld(m), B = ld(m2);
        fin(m, A); fin(m2, B);
    }
}

__device__ __forceinline__ void router_phase(Frame& F, const Args& a, int layer) {
    const int tid = F.tid, lane = F.lane, wave = F.wave;
    LAS unsigned char* lds = F.lds + RING_OFF;
    LAS unsigned* w3 = (LAS unsigned*)lds; LAS float* stg = (LAS float*)(lds + 99328) + wave * 272;
    LAS int* le = (LAS int*)(lds + 108032); LAS float* lw = (LAS float*)(lds + 109056); LAS float* lrs = (LAS float*)(lds + 110080); LAS int* lrank = (LAS int*)(lds + 111104);
    LAS int* lcnt = (LAS int*)(lds + 112128); LAS int* lbase = (LAS int*)(lds + 112192);
    const bf16* h = (const bf16*)a.out; const float* gain = a.in[I_FFNN] + layer * 1024;
    int* etok = (int*)(a.ws + WS_MISC + MS_ETOK); float* er = (float*)(a.ws + WS_MISC + MS_EW); int* tpos = (int*)(a.ws + WS_MISC + MS_TPOS); float* tw = (float*)(a.ws + WS_MISC + MS_TW);
    unsigned* gcnt = F.ctl + CW_ECNT + (F.g * 2 + layer) * 16 * 64;
    const int t16 = lane & 15, kq = lane >> 4;
#define RT_LOADW(it0) _Pragma("unroll") for (int it = 0; it < 8; ++it) { const int j = tid + ((it0) + it) * NTHR, e = j & 15, kp = j >> 4; wa[it] = a.in[I_WR][(2 * kp) * 16 + e]; wb[it] = a.in[I_WR][(2 * kp + 1) * 16 + e]; gg[it] = *(const v2f*)(gain + 2 * kp); }
#define RT_PUTW(it0) _Pragma("unroll") for (int it = 0; it < 8; ++it) { const int j = tid + ((it0) + it) * NTHR, e = j & 15, kp = j >> 4; \
            const float w0 = wa[it] * gg[it].x, w1 = wb[it] * gg[it].y; \
            const unsigned u0 = pk2(w0, w1); const float r0 = w0 - bflo(u0), r1 = w1 - bfhi(u0); \
            const unsigned u1 = pk2(r0, r1); const float q0 = r0 - bflo(u1), q1 = r1 - bfhi(u1); \
            const unsigned u2 = pk2(q0, q1); \
            w3[e * 516 + kp] = u0; w3[(16 + e) * 516 + kp] = u1; w3[(32 + e) * 516 + kp] = u2; }
    { float wa[8], wb[8]; v2f gg[8];
      RT_LOADW(0); RT_PUTW(0);
      RT_LOADW(8); RT_PUTW(8); }
#undef RT_LOADW
#undef RT_PUTW
    const GAS f32x4* psrc = (const GAS f32x4*)(a.in[I_P] + (size_t)layer * TFULL * 256); GAS v2u* pdst = (GAS v2u*)(a.ws + WS_MISC + MS_PB);
    const bool one = (F.G * 128 == T);
    f32x4 pq[16];
    for (int tb0 = F.vcu * 128; tb0 < T; tb0 += F.G * 128) {
        v4u hv[32];
        { const GAS v4u* hp = (const GAS v4u*)(h + (size_t)(tb0 + wave * 16 + t16) * 1024) + kq;
#pragma unroll
          for (int c = 0; c < 32; ++c) hv[c] = hp[4 * c]; }
        if (tid < 16) lcnt[tid] = 0;
        LDS_WAIT(); __syncthreads();
        {
            const LAS pg8::bf16x8* wp = (const LAS pg8::bf16x8*)(w3 + t16 * 516) + kq;
            f32x4 ac0 = (f32x4){0.f, 0.f, 0.f, 0.f}, ac1 = ac0, ac2 = ac0; float ss = 0.f;
#pragma unroll
            for (int c = 0; c < 32; ++c) {
                const v4u hw = hv[c]; const pg8::bf16x8 a8 = __builtin_bit_cast(pg8::bf16x8, hw);
                const float x0 = bflo(hw.x), x1 = bfhi(hw.x), x2 = bflo(hw.y), x3 = bfhi(hw.y), x4 = bflo(hw.z), x5 = bfhi(hw.z), x6 = bflo(hw.w), x7 = bfhi(hw.w);
                ss += ((x0 * x0 + x1 * x1) + (x2 * x2 + x3 * x3)) + ((x4 * x4 + x5 * x5) + (x6 * x6 + x7 * x7));
                ac0 = __builtin_amdgcn_mfma_f32_16x16x32_bf16(a8, wp[4 * c], ac0, 0, 0, 0);
                ac1 = __builtin_amdgcn_mfma_f32_16x16x32_bf16(a8, wp[4 * c + 16 * 129], ac1, 0, 0, 0);
                ac2 = __builtin_amdgcn_mfma_f32_16x16x32_bf16(a8, wp[4 * c + 32 * 129], ac2, 0, 0, 0);
            }
            if (one) {
#pragma unroll
                for (int j = 0; j < 16; ++j) pq[j] = psrc[(size_t)tb0 * 4 + tid + (size_t)j * F.G * NTHR]; }
            ss += __shfl_xor(ss, 16); ss += __shfl_xor(ss, 32);
            const float rs = rsqrtf(ss * (1.f / 1024.f) + EPSN);
#pragma unroll
            for (int r = 0; r < 4; ++r) stg[(4 * kq + r) * 17 + t16] = ac0[r] + (ac1[r] + ac2[r]);
            LDS_WAIT();
            if (lane < 16) {
                float lg[16];
#pragma unroll
                for (int e = 0; e < 16; ++e) lg[e] = stg[lane * 17 + e] * rs;
                float mx = lg[0];
#pragma unroll
                for (int e = 1; e < 16; ++e) mx = fmaxf(mx, lg[e]);
                float sum = 0.f;
#pragma unroll
                for (int e = 0; e < 16; ++e) { lg[e] = __expf(lg[e] - mx); sum += lg[e]; }
                const float inv = 1.f / sum;
#pragma unroll
                for (int e = 0; e < 16; ++e) lg[e] *= inv;
                float bestg = -1.f; int gs = 0, bi1 = 0, bi2 = 1; float bv1 = 0.f, bv2 = 0.f;
#pragma unroll
                for (int gq = 0; gq < 4; ++gq) {
                    int i1 = 0; float v1 = lg[4 * gq];
#pragma unroll
                    for (int jj = 1; jj < 4; ++jj) if (lg[4 * gq + jj] > v1) { v1 = lg[4 * gq + jj]; i1 = jj; }
                    int i2 = -1; float v2 = -1.f;
#pragma unroll
                    for (int jj = 0; jj < 4; ++jj) if (jj != i1 && lg[4 * gq + jj] > v2) { v2 = lg[4 * gq + jj]; i2 = jj; }
                    const float sc = v1 + v2;
                    if (sc > bestg) { bestg = sc; gs = gq; bi1 = i1; bi2 = i2; bv1 = v1; bv2 = v2; }
                }
                const float si = 1.f / (bv1 + bv2); const int aidx = (wave * 16 + lane) * 2;
                le[aidx] = gs * 4 + bi1; le[aidx + 1] = gs * 4 + bi2; lw[aidx] = bv1 * si; lw[aidx + 1] = bv2 * si; lrs[aidx] = rs; lrs[aidx + 1] = rs;
            }
        }
        LDS_WAIT(); __syncthreads();
        if (tid < 256) lrank[tid] = __hip_atomic_fetch_add(&lcnt[le[tid]], 1, __ATOMIC_RELAXED, __HIP_MEMORY_SCOPE_WORKGROUP);
        LDS_WAIT(); __syncthreads();
        if (tid < 16) lbase[tid] = (int)__hip_atomic_fetch_add(gcnt + tid * 64, (unsigned)lcnt[tid], RLX_AGENT);
        LDS_WAIT(); __syncthreads();
        if (tid < 256) { const int e = le[tid], pos = lbase[e] + lrank[tid]; etok[(size_t)e * T + pos] = tb0 + (tid >> 1); er[(size_t)e * T + pos] = lrs[tid]; tpos[(size_t)tb0 * 2 + tid] = (e << 20) | pos; tw[(size_t)tb0 * 2 + tid] = lw[tid]; }
        __syncthreads();
    }
    if (one) {
#pragma unroll
        for (int j = 0; j < 16; ++j) { const f32x4 v = pq[j]; v2u w; w.x = pk2(v.x, v.y); w.y = pk2(v.z, v.w); pdst[(size_t)F.vcu * NTHR + tid + (size_t)j * F.G * NTHR] = w; }
    } else {
        for (size_t i = (size_t)F.vcu * NTHR + tid; i < (size_t)T * 64; i += (size_t)F.G * NTHR) { const f32x4 v = psrc[i]; v2u w; w.x = pk2(v.x, v.y); w.y = pk2(v.z, v.w); pdst[i] = w; }
    }
}

struct MoeTab { const LAS int* tb; const LAS int* cnt; };
constexpr int MOE_CS = 16, MOE_NS = 8;
__device__ __forceinline__ void moe_table(Frame& F, int layer) {
    LAS int* tb = (LAS int*)(F.lds + LDSCTL_OFF); LAS int* cnt = tb + 20; LAS int* ts = tb + 40; LAS int* lp = tb + 52;
    if (F.tid == 0) { int s = 0; for (int e = 0; e < 16; ++e) { const int c = (int)__hip_atomic_load(F.ctl + CW_ECNT + ((F.g * 2 + layer) * 16 + e) * 64, RLX_AGENT); cnt[e] = c; tb[e] = s; s += (c + 255) >> 8; } tb[16] = s;
        int l = 0; for (int x = 0; x <= MOE_NS; ++x) { ts[x] = (s * x) / MOE_NS; if (x > 0) { lp[x - 1] = l; l += MOE_CS - ((4 * (ts[x] - ts[x - 1])) % MOE_CS); } } lp[MOE_NS] = l; }
    LDS_WAIT(); __syncthreads();
}
struct MoeOrder {
    const LAS int* tb; int G, c;
    __device__ __forceinline__ bool next(int i, pg8::Unit& u) const {
        int tile, pn;
        if (G == MOE_CS * MOE_NS) { const LAS int* ts = tb + 40; const int x = c / MOE_CS, j = i * MOE_CS + (c % MOE_CS), t0 = ts[x]; if (j >= 4 * (ts[x + 1] - t0)) return false; tile = t0 + (j >> 2); pn = j & 3; }
        else { const int L = i * G + c, nt = tb[16]; if (L >= nt * 4) return false; tile = L >> 2; pn = L & 3; }
        int e = 0;
#pragma unroll
        for (int j = 1; j < 16; ++j) e += (tile >= tb[j]) ? 1 : 0;
        u.pm = tile; u.pn = pn; u.e = __builtin_amdgcn_readfirstlane(e); return true;
    }
};
__device__ __forceinline__ int moe_light(const LAS int* tb, int G, int c, int& nl) {
    if (G == MOE_CS * MOE_NS) { const LAS int* ts = tb + 40; const LAS int* lp = tb + 52; const int x = c / MOE_CS, r = c % MOE_CS, hv = (4 * (ts[x + 1] - ts[x])) % MOE_CS; nl = lp[MOE_NS]; return (r >= hv) ? lp[x] + (r - hv) : -1; }
    const int n5 = (tb[16] * 4) % G; nl = G - n5; return (c >= n5) ? c - n5 : -1;
}
struct MoeGather {
    const LAS int* tb; const LAS int* cnt; const int* etok;
    __device__ __forceinline__ unsigned operator()(const pg8::Unit& u, int r) const {
        const int pos = (u.pm - tb[u.e]) * 256 + r; const unsigned tok = (unsigned)etok[(size_t)u.e * T + pos];
        return (pos < cnt[u.e]) ? tok : 0u;
    }
};
struct EpiMoeScatter {
    static constexpr bool PERM = false;
    float* H; const LAS int* tb; const LAS int* cnt; const int* etok; const float* ew;
    __device__ __forceinline__ void operator()(const pg8::f32x4 (&acc)[2][2][4][2], const pg8::Unit& u, int wr, int wc, int fr, int fq) const {
        const int col0 = u.pn * 256 + wc * 32 + 4 * fq; const int p0 = (u.pm - tb[u.e]) * 256, n = cnt[u.e];
#pragma unroll
        for (int ai = 0; ai < 2; ++ai)
#pragma unroll
            for (int m = 0; m < 4; ++m) { const int pos = p0 + ai * 128 + wr * 64 + m * 16 + fr;
                if (pos < n) { const int tok = etok[(size_t)u.e * T + pos]; const float w = ew[(size_t)u.e * T + pos]; float* hp = H + (size_t)tok * 1024 + col0;
#pragma unroll
                    for (int bj = 0; bj < 2; ++bj)
#pragma unroll
                        for (int nn = 0; nn < 2; ++nn)
#pragma unroll
                            for (int i = 0; i < 4; ++i) __hip_atomic_fetch_add(hp + bj * 128 + nn * 16 + i, w * acc[ai][bj][m][nn][i], RLX_AGENT); } }
    }
};

__device__ __forceinline__ void rows_to_bf16(Frame& F, const float* src, bf16* dst) {
    const GAS f32x4* ps = (const GAS f32x4*)src; GAS v2u* pd = (GAS v2u*)dst;
    for (size_t i = (size_t)F.vcu * NTHR + F.tid; i < (size_t)T * 256; i += (size_t)F.G * NTHR) { const f32x4 v = ps[i]; v2u w; w.x = pk2(v.x, v.y); w.y = pk2(v.z, v.w); pd[i] = w; }
}
__device__ __forceinline__ void moe_combine(Frame& F, const Args& a) {
    const int gw = F.vcu * NWAVES + F.wave, NGW = F.G * NWAVES, lane = F.lane;
    const LAS int* tb = (const LAS int*)(F.lds + LDSCTL_OFF);
    const int* tpos = (const int*)(a.ws + WS_MISC + MS_TPOS); const float* tw = (const float*)(a.ws + WS_MISC + MS_TW);
    const bf16* Y = (const bf16*)(a.ws + WS_Z + WS_YOFF); bf16* h2b = (bf16*)(a.ws + WS_XN);
    for (int m = gw; m < T; m += 2 * NGW) {
        const int mm[2] = {m, (m + NGW < T) ? m + NGW : m};
        int pp[2][2]; float ww[2][2];
#pragma unroll
        for (int q = 0; q < 2; ++q) { pp[q][0] = tpos[2 * mm[q]]; pp[q][1] = tpos[2 * mm[q] + 1]; ww[q][0] = tw[2 * mm[q]]; ww[q][1] = tw[2 * mm[q] + 1]; }
        v4u y0[2][2], y1[2][2], hx[2][2];
#pragma unroll
        for (int q = 0; q < 2; ++q) {
            const size_t r0 = (size_t)tb[pp[q][0] >> 20] * 256 + (pp[q][0] & 0xfffff), r1 = (size_t)tb[pp[q][1] >> 20] * 256 + (pp[q][1] & 0xfffff);
#pragma unroll
            for (int j = 0; j < 2; ++j) { y0[q][j] = *((const GAS v4u*)(Y + r0 * 1024) + lane + 64 * j); y1[q][j] = *((const GAS v4u*)(Y + r1 * 1024) + lane + 64 * j);
                hx[q][j] = *((const GAS v4u*)((const bf16*)a.out + (size_t)mm[q] * 1024) + lane + 64 * j); } }
#pragma unroll
        for (int q = 0; q < 2; ++q)
#pragma unroll
            for (int j = 0; j < 2; ++j) { const float w0 = ww[q][0], w1 = ww[q][1]; const v4u a0 = y0[q][j], a1 = y1[q][j], hh = hx[q][j];
                f32x4 ha = (f32x4){bflo(hh.x), bfhi(hh.x), bflo(hh.y), bfhi(hh.y)}, hb = (f32x4){bflo(hh.z), bfhi(hh.z), bflo(hh.w), bfhi(hh.w)};
                ha.x = (ha.x + w0 * bflo(a0.x)) + w1 * bflo(a1.x); ha.y = (ha.y + w0 * bfhi(a0.x)) + w1 * bfhi(a1.x); ha.z = (ha.z + w0 * bflo(a0.y)) + w1 * bflo(a1.y); ha.w = (ha.w + w0 * bfhi(a0.y)) + w1 * bfhi(a1.y);
                hb.x = (hb.x + w0 * bflo(a0.z)) + w1 * bflo(a1.z); hb.y = (hb.y + w0 * bfhi(a0.z)) + w1 * bfhi(a1.z); hb.z = (hb.z + w0 * bflo(a0.w)) + w1 * bflo(a1.w); hb.w = (hb.w + w0 * bfhi(a0.w)) + w1 * bfhi(a1.w);
                *((GAS v4u*)(h2b + (size_t)mm[q] * 1024) + lane + 64 * j) = (v4u){pk2(ha.x, ha.y), pk2(ha.z, ha.w), pk2(hb.x, hb.y), pk2(hb.z, hb.w)}; }
    }
}
__device__ __forceinline__ void rows_sumsq(Frame& F, const bf16* P, float* rowss, int vcu, int ncu) {
    const int gw = vcu * NWAVES + F.wave, NGW = ncu * NWAVES;
    for (int m = gw; m < T; m += 4 * NGW) {
        int mm[4]; v4u x[4][2];
#pragma unroll
        for (int q = 0; q < 4; ++q) { mm[q] = (m + q * NGW < T) ? m + q * NGW : m;
#pragma unroll
            for (int j = 0; j < 2; ++j) x[q][j] = *((const GAS v4u*)(P + (size_t)mm[q] * 1024) + F.lane + 64 * j); }
#pragma unroll
        for (int q = 0; q < 4; ++q) { float s = 0.f;
#pragma unroll
            for (int j = 0; j < 2; ++j) { const v4u w = x[q][j];
                const float a0 = bflo(w.x), a1 = bfhi(w.x), a2 = bflo(w.y), a3 = bfhi(w.y), a4 = bflo(w.z), a5 = bfhi(w.z), a6 = bflo(w.w), a7 = bfhi(w.w);
                s += (a0 * a0 + a1 * a1) + (a2 * a2 + a3 * a3) + (a4 * a4 + a5 * a5) + (a6 * a6 + a7 * a7); }
            s = wave_sum(s); if (F.lane == 0) rowss[mm[q]] = s; }
    }
}
__device__ __forceinline__ void rows_rms_to_bf16(Frame& F, const float* src, const float* gain, bf16* dst) {
    const int gw = F.vcu * NWAVES + F.wave, NGW = F.G * NWAVES;
    for (int m = gw; m < T; m += NGW) rms_row_to_bf16(src + (size_t)m * D, gain, dst + (size_t)m * D, F.lane);
}

__device__ __forceinline__ void rows_rms_b2b(Frame& F, const bf16* src, const float* gain, bf16* dst) {
    const int gw = F.vcu * NWAVES + F.wave, NGW = F.G * NWAVES, lane = F.lane;
    for (int m = gw; m < T; m += 4 * NGW) {
        int mm[4]; v4u x[4][2];
#pragma unroll
        for (int q = 0; q < 4; ++q) { mm[q] = (m + q * NGW < T) ? m + q * NGW : m;
#pragma unroll
            for (int j = 0; j < 2; ++j) x[q][j] = *((const GAS v4u*)(src + (size_t)mm[q] * 1024) + lane + 64 * j); }
#pragma unroll
        for (int q = 0; q < 4; ++q) {
            float v[16]; float s = 0.f;
#pragma unroll
            for (int j = 0; j < 2; ++j) { v[8 * j + 0] = bflo(x[q][j].x); v[8 * j + 1] = bfhi(x[q][j].x); v[8 * j + 2] = bflo(x[q][j].y); v[8 * j + 3] = bfhi(x[q][j].y); v[8 * j + 4] = bflo(x[q][j].z); v[8 * j + 5] = bfhi(x[q][j].z); v[8 * j + 6] = bflo(x[q][j].w); v[8 * j + 7] = bfhi(x[q][j].w); }
#pragma unroll
            for (int i = 0; i < 16; ++i) s += v[i] * v[i];
            const float r = rsqrtf(wave_sum(s) * (1.f / 1024.f) + EPSN);
#pragma unroll
            for (int j = 0; j < 2; ++j) { const f32x4 g0 = *((const f32x4*)gain + 2 * (lane + 64 * j)), g1 = *((const f32x4*)gain + 2 * (lane + 64 * j) + 1);
                *((GAS v4u*)(dst + (size_t)mm[q] * 1024) + lane + 64 * j) = (v4u){pk2(v[8 * j] * r * g0.x, v[8 * j + 1] * r * g0.y), pk2(v[8 * j + 2] * r * g0.z, v[8 * j + 3] * r * g0.w), pk2(v[8 * j + 4] * r * g1.x, v[8 * j + 5] * r * g1.y), pk2(v[8 * j + 6] * r * g1.z, v[8 * j + 7] * r * g1.w)}; }
        }
    }
}
enum { PH_A = 0, PH_B, PH_C, PH_D, PH_E, PH_F, PH_H, PH_I, PH_J, PH_K, PH_L, NPH };
#ifndef MK_PHMASK
#define MK_PHMASK 0xFFFF
#endif
#define PHON(p) ((MK_PHMASK >> (p)) & 1)
#ifndef MK_SKIP_SEQ
#define MK_SKIP_SEQ 0
#endif
#ifndef MK_H_PART
#define MK_H_PART 3
#endif
#ifndef MK_SKIP_ATTN
#define MK_SKIP_ATTN 0
#endif
#ifndef MK_SKIP_HGRN
#define MK_SKIP_HGRN 0
#endif
__global__ void __launch_bounds__(NTHR, 2) mk_fwd(Args args) {
    extern __shared__ __attribute__((aligned(16))) unsigned char lds_raw[];
    Frame F;
    F.lds = (LAS unsigned char*)lds_raw; F.MISC = (volatile LAS unsigned*)(F.lds + MISC_OFF);
    F.tid = threadIdx.x; F.lane = F.tid & 63; F.wave = __builtin_amdgcn_readfirstlane(F.tid >> 6);
    { const int Gall = gridDim.x, bx = blockIdx.x;
      if (Gall % 16 == 0) { const int hb = Gall / 2, r = bx % hb; F.g = bx / hb; F.G = hb; F.vcu = (r & 7) * (Gall / 16) + (r >> 3); F.bi = r; }
      else { F.g = bx & 1; F.G = (Gall + 1 - F.g) / 2; F.vcu = bx >> 1; F.bi = bx >> 1; } }
    unsigned char* wsw = args.ws;
    Args ga = args;
    ga.in[I_X] = args.in[I_X] + (size_t)F.g * T * 1024; ga.in[I_P] = args.in[I_P] + (size_t)F.g * T * 256; ga.out = args.out + (size_t)F.g * T * 1024; ga.ws = args.ws + (size_t)F.g * WS_GSTRIDE;
    unsigned char* ws = ga.ws;
    F.ctl = (unsigned*)(wsw + WS_CTL);
    for (int u = F.tid; u < (LDS_BYTES - LDSCTL_OFF) / 4; u += NTHR) ((LAS unsigned*)(F.lds + LDSCTL_OFF))[u] = 0u;
    __syncthreads();
    XcdBarrier bar = xcd_barrier_post(F.ctl + CW_BAR + F.g * 4096, F.MISC + 8, (unsigned)F.G);
    const bool use_slice = (F.G == MOE_CS * MOE_NS);
    XcdBarrier sbar = xcd_barrier_post(F.ctl + CW_SBAR + (F.g * MOE_NS + (use_slice ? F.vcu / MOE_CS : 0)) * 4096, F.MISC + 12, use_slice ? (unsigned)MOE_CS : (unsigned)F.G);
    const int lo = args.ph_lo, hi = args.ph_hi;
#ifdef PROBE_PH
    unsigned long long probe_last = __builtin_amdgcn_s_memrealtime(), probe_acc = 0;
#endif
#define IN(k) (lo <= (k) && (k) < hi)
#define PHB() do { const int t_ = opaque_tid(); F.tid = t_; F.lane = t_ & 63; F.wave = __builtin_amdgcn_readfirstlane(t_ >> 6); } while (0)
#ifdef PROBE_PH
#define PROBE_MID(id) do { if (blockIdx.x == 0 && threadIdx.x == 0) { const unsigned long long t_ = __builtin_amdgcn_s_memrealtime(); if ((id) == PROBE_PH) probe_acc += t_ - probe_last; probe_last = t_; } } while (0)
#define SEAM(k) do { if ((k) + 1 < hi) xcd_barrier(bar); if (blockIdx.x == 0 && threadIdx.x == 0) { const unsigned long long t_ = __builtin_amdgcn_s_memrealtime(); const int pp_ = ((k) == 0) ? 15 : (((k) - 1) % NPH); if (pp_ == PROBE_PH) probe_acc += t_ - probe_last; probe_last = t_; } } while (0)
#else
#define PROBE_MID(id) do { } while (0)
#define SEAM(k) do { if ((k) + 1 < hi) xcd_barrier(bar); } while (0)
#endif
#define FLAGSET(k) do { if (F.tid == 0) __hip_atomic_store(F.ctl + CW_FLAG + 64 * (k), 1u, RLX_AGENT); } while (0)
#define FLAGWAIT(k) do { if (F.tid == 0) { unsigned sp_ = 0; while (__hip_atomic_load(F.ctl + CW_FLAG + 64 * (k), RLX_AGENT) == 0u && ++sp_ < (1u << 18)) __builtin_amdgcn_s_sleep(2); \
        __builtin_amdgcn_fence(__ATOMIC_ACQUIRE, "agent"); asm volatile("s_waitcnt vmcnt(0)" ::: "memory"); } __syncthreads(); } while (0)
    if (PHON(15) && IN(0)) { PHB(); p0_prologue(F, ga, wsw); SEAM(0); FLAGSET(F.g); }
    for (int layer = 0; layer < 2; ++layer) {
        const int g0 = 1 + layer * NPH;
        bf16* zbase = (bf16*)(ws + WS_Z);
        bf16* h1b = (bf16*)ga.out; bf16* h3b = (bf16*)ga.out + (size_t)T * 1024;
        if (PHON(PH_A) && IN(g0 + PH_A)) { PHB();
            if (layer == 0) FLAGWAIT(0);
            pg8::Gemm g{(const pg8::bf16_t*)(ws + WS_XN), (const pg8::bf16_t*)(wsw + WS_WIN) + (size_t)layer * 3584 * 1024, 1024, 0};
            pg8::StaticOrder S; S.init(T, 3584, F.G, F.bi);
            { LAS float* gq = (LAS float*)(F.lds + LDSCTL_OFF + 2048) + 2048; if (F.tid < 64) gq[F.tid] = args.in[I_QN][layer * 64 + F.tid]; else if (F.tid < 128) gq[F.tid] = args.in[I_KN][layer * 64 + F.tid - 64]; LDS_WAIT(); __syncthreads(); }
            pg8::EpiInProjQK E{zbase, (size_t)T * 512, (LAS float*)(F.lds + LDSCTL_OFF + 2048)};
            pg8::gemm_phase<pg8::EpiInProjQK, pg8::StaticOrder, pg8::RowIdent, true>(F.lds + RING_OFF, g, S, E, pg8::RowIdent{});
            SEAM(g0 + PH_A);
        }
        if (PHON(PH_B) && IN(g0 + PH_B)) { PHB();
            PROBE_MID(12);
            if (!MK_SKIP_HGRN) hgrn_b1_phase(F, ga, layer);
            SEAM(g0 + PH_B);
        }
        if (PHON(PH_C) && IN(g0 + PH_C)) { PHB();
            if (!MK_SKIP_HGRN && !MK_SKIP_SEQ) { hgrn_seq_phase(F, ga); VM_WAIT(); __syncthreads(); }
            PROBE_MID(11);
            if (!MK_SKIP_ATTN) {
                const attn_body::AttnTensors AT{(const attn_body::bf16*)(zbase + (size_t)4 * T * 512), (const attn_body::bf16*)(zbase + (size_t)5 * T * 512), (const attn_body::bf16*)(zbase + (size_t)6 * T * 512), (attn_body::bf16*)(ws + WS_OA)};
                attn_body::attn_phase<8>((char*)lds_raw + RING_OFF, AT, F.vcu, F.G);
            }
            SEAM(g0 + PH_C);
        }
        if (PHON(PH_D) && IN(g0 + PH_D)) { PHB(); mix_finalize(F, ga, layer); SEAM(g0 + PH_D); }
        if (PHON(PH_E) && IN(g0 + PH_E)) { PHB();
            if (layer == 0) FLAGWAIT(1);
            pg8::Gemm g{(const pg8::bf16_t*)(zbase + (size_t)4 * T * 512), (const pg8::bf16_t*)(wsw + WS_WOUT) + (size_t)layer * 1024 * 1024, 1024, 0};
            pg8::StaticOrder S; S.init(T, 1024, F.G, F.bi);
            pg8::EpiResB E{layer == 0 ? ga.in[I_X] : nullptr, layer == 0 ? nullptr : (const pg8::bf16_t*)h3b, (pg8::bf16_t*)h1b};
            pg8::gemm_phase<pg8::EpiResB, pg8::StaticOrder, pg8::RowIdent, true>(F.lds + RING_OFF, g, S, E, pg8::RowIdent{});
            SEAM(g0 + PH_E);
        }
        if (PHON(PH_F) && IN(g0 + PH_F)) { PHB(); router_phase(F, ga, layer); SEAM(g0 + PH_F); }
        if (PHON(PH_H) && IN(g0 + PH_H)) { PHB();
            moe_table(F, layer);
            const LAS int* tb = (const LAS int*)(F.lds + LDSCTL_OFF);
            if (MK_H_PART & 1) {
                pg8::Gemm g{(const pg8::bf16_t*)h1b, (const pg8::bf16_t*)(wsw + WS_WGU) + (size_t)layer * 16 * 1024 * 1024, 1024, (size_t)1024 * 1024 * 2};
                MoeOrder S{tb, F.G, F.vcu}; MoeGather RM{tb, tb + 20, (const int*)(ws + WS_MISC + MS_ETOK)};
                pg8::EpiSiluMul E{(pg8::bf16_t*)zbase, tb, tb + 20, (const float*)(ws + WS_MISC + MS_EW)};
                pg8::gemm_phase<pg8::EpiSiluMul, MoeOrder, MoeGather, true>(F.lds + RING_OFF, g, S, E, RM);
            }
            if (MK_H_PART & 2) {
                pg8::Gemm g{(const pg8::bf16_t*)(ws + WS_MISC + MS_PB), (const pg8::bf16_t*)(wsw + WS_WPP) + (size_t)layer * 1024 * 256, 256, 0};
                int nl; const int li = __builtin_amdgcn_readfirstlane(moe_light(tb, F.G, F.vcu, nl)); nl = __builtin_amdgcn_readfirstlane(nl); const bool bal = 3 * nl >= 2 * F.G;
                pg8::StaticOrder S; S.init(T, 1024, bal ? nl : F.G, bal ? (li >= 0 ? li : 1 << 20) : F.bi);
                pg8::EpiBf16 E{(pg8::bf16_t*)(ws + WS_OA), 1024, 0, 0};
                pg8::gemm_phase<pg8::EpiBf16, pg8::StaticOrder, pg8::RowIdent, true>(F.lds + RING_OFF, g, S, E, pg8::RowIdent{});
            }
            if (use_slice) xcd_barrier(sbar); else SEAM(g0 + PH_H);
        }
        if (PHON(PH_I) && IN(g0 + PH_I)) { PHB();
            moe_table(F, layer);
            const LAS int* tb = (const LAS int*)(F.lds + LDSCTL_OFF);
            pg8::Gemm g{(const pg8::bf16_t*)zbase, (const pg8::bf16_t*)(wsw + WS_WDN) + (size_t)layer * 16 * 1024 * 512, 512, (size_t)1024 * 512 * 2};
            MoeOrder S{tb, F.G, F.vcu};
            pg8::EpiBf16 E{(pg8::bf16_t*)(ws + WS_Z + WS_YOFF), 1024, 0, 0};
            pg8::gemm_phase<pg8::EpiBf16, MoeOrder, pg8::RowIdent, true>(F.lds + RING_OFF, g, S, E, pg8::RowIdent{});
            SEAM(g0 + PH_I);
        }
        if (PHON(PH_J) && IN(g0 + PH_J)) { PHB(); moe_table(F, layer);
            moe_combine(F, ga); rows_sumsq(F, (const bf16*)(ws + WS_OA), (float*)(F.ctl + CW_ROWSS) + (size_t)(F.g * 2 + layer) * T, F.vcu, F.G); SEAM(g0 + PH_J); }
        if (PHON(PH_K) && IN(g0 + PH_K)) { PHB();
            pg8::Gemm g{(const pg8::bf16_t*)(ws + WS_XN), (const pg8::bf16_t*)(wsw + WS_WPG) + (size_t)layer * 1024 * 1024, 1024, 0};
            pg8::StaticOrder S; S.init(T, 1024, F.G, F.bi);
            pg8::EpiPleGate E{layer == 1 ? ga.out : nullptr, layer == 1 ? nullptr : (pg8::bf16_t*)h3b, (const pg8::bf16_t*)(ws + WS_XN), (const pg8::bf16_t*)(ws + WS_OA), (const float*)(F.ctl + CW_ROWSS) + (size_t)(F.g * 2 + layer) * T, args.in[I_PLEN] + layer * 1024};
            pg8::gemm_phase<pg8::EpiPleGate, pg8::StaticOrder, pg8::RowIdent, true>(F.lds + RING_OFF, g, S, E, pg8::RowIdent{});
            if (layer == 0) SEAM(g0 + PH_K);
        }
        if (PHON(PH_L) && IN(g0 + PH_L)) { PHB(); if (layer == 0) rows_rms_b2b(F, h3b, args.in[I_MIXN] + 1024, (bf16*)(ws + WS_XN)); SEAM(g0 + PH_L); }
    }
#ifdef PROBE_PH
    if (blockIdx.x == 0 && threadIdx.x == 0) { probe_acc += ((volatile LAS unsigned long long*)(F.lds + MISC_OFF + 64))[0]; const unsigned long long t0_ = __builtin_amdgcn_s_memrealtime(); while (__builtin_amdgcn_s_memrealtime() - t0_ < probe_acc * PROBE_MUL) __builtin_amdgcn_s_sleep(8); }
#endif
#undef IN
#undef SEAM
}
constexpr int N_PHASES = 1 + 2 * NPH;

static int launch_mk(void* const* d_in, void* d_out, void* d_ws, size_t ws_size, hipStream_t stream, int ph_lo, int ph_hi, bool do_memset) {
    static int grid = 0;
    if (grid == 0) {
        if (ws_size < WS_END) { fprintf(stderr, "kernel_launch: workspace too small (%zu < %zu)\n", ws_size, (size_t)WS_END); grid = -1; return -1; }
        int dev = 0, cus = 0, per_cu = 0;
        if (hipGetDevice(&dev) != hipSuccess || hipDeviceGetAttribute(&cus, hipDeviceAttributeMultiprocessorCount, dev) != hipSuccess) { grid = -1; return -1; }
        if (hipFuncSetAttribute((const void*)mk_fwd, hipFuncAttributeMaxDynamicSharedMemorySize, LDS_BYTES) != hipSuccess) { fprintf(stderr, "kernel_launch: hipFuncSetAttribute failed\n"); grid = -1; return -1; }
        if (hipOccupancyMaxActiveBlocksPerMultiprocessor(&per_cu, (const void*)mk_fwd, NTHR, LDS_BYTES) != hipSuccess || per_cu < 1) fprintf(stderr, "kernel_launch: occupancy query reports %d blocks per CU\n", per_cu);
        (void)hipGetLastError();
        grid = cus;
    }
    if (grid < 0) return -1;
    if (do_memset) (void)hipMemsetAsync((char*)d_ws + WS_CTL, 0, CTL_ZERO_BYTES, stream);
    Args a{};
    for (int i = 0; i < 22; ++i) a.in[i] = (const float*)d_in[i];
    a.out = (float*)d_out; a.ws = (unsigned char*)d_ws; a.ph_lo = ph_lo; a.ph_hi = ph_hi;
    hipLaunchKernelGGL(mk_fwd, dim3(grid), dim3(NTHR), LDS_BYTES, stream, a);
    return 0;
}
}

extern "C" void kernel_launch(void* const* d_in, const int* in_sizes, int n_in, void* d_out, int out_size, void* d_ws, size_t ws_size, hipStream_t stream) {
    (void)in_sizes; (void)n_in; (void)out_size;
    (void)mk::launch_mk(d_in, d_out, d_ws, ws_size, stream, 0, mk::N_PHASES, true);
}
```
